# Optimizing an MI355X kernel written in HIP

```python
import jax, jax.numpy as jnp
from jax import lax
import numpy as np

D_MODEL = 1024
BATCH = 16
SEQ = 4096
DEPTH = 1

HEAD_DIM = 64
NSA_HEADS = 8
NSA_KV_HEADS = 2
NSA_WIDTH = NSA_HEADS * HEAD_DIM
KV_WIDTH = NSA_KV_HEADS * HEAD_DIM
N_GATES = 3 * NSA_HEADS
GMLP_WIDTH = D_MODEL - NSA_WIDTH
GMLP_GROUPS = 8
GMLP_GROUP_DIM = GMLP_WIDTH // GMLP_GROUPS
GMLP_CHUNK = 128
CMP_BLOCK = 32
CMP_STRIDE = 16
CMP_HIDDEN = 128
SEL_BLOCK = 64
SEL_TOP_N = 16
WINDOW = 512
Q_BLOCK = 64
NORM_EPS = 1e-6
NEG_INF = -1e30
FORCE_BONUS = 1e4
SPLIT_SIZES = (NSA_WIDTH,
               KV_WIDTH, KV_WIDTH,
               KV_WIDTH, KV_WIDTH,
               KV_WIDTH, KV_WIDTH,
               N_GATES,
               NSA_WIDTH,
               GMLP_WIDTH, GMLP_WIDTH,
               GMLP_WIDTH)
IN_WIDTH = sum(SPLIT_SIZES)

kernel_name = "hybrid_nsa_gmlp_parallel_heads"


def rms_norm(x, g):
    xf = x.astype(jnp.float32)
    y = xf * lax.rsqrt(jnp.mean(xf * xf, axis=-1, keepdims=True) + NORM_EPS)
    return (y * g.astype(jnp.float32)).astype(x.dtype)


def split_columns(proj):
    parts, off = [], 0
    for size in SPLIT_SIZES:
        parts.append(proj[..., off:off + size])
        off += size
    return parts


def compress_blocks(k, w1, w2, pe):
    T = k.shape[1]
    n_cmp = (T - CMP_BLOCK) // CMP_STRIDE + 1
    idx = jnp.arange(n_cmp)[:, None] * CMP_STRIDE + jnp.arange(CMP_BLOCK)[None, :]
    blocks = k[:, idx] + pe[:, None, :]
    w1r = w1.reshape(CMP_BLOCK, HEAD_DIM, CMP_HIDDEN)
    hid = jax.nn.gelu(jnp.einsum('bnlgd,lde->bnge', blocks, w1r))
    return jnp.einsum('bnge,ef->bngf', hid, w2)


def nsa_attention(q, k_cmp, v_cmp, k_sel, v_sel, k_win, v_win, gates):
    f32 = jnp.float32
    B, T, H, dh = q.shape
    G = k_sel.shape[2]
    Hg = H // G
    n_cmp = k_cmp.shape[1]
    n_blk = T // SEL_BLOCK
    top_n = min(SEL_TOP_N, n_blk)
    n_chunks = T // Q_BLOCK
    n_win = WINDOW + Q_BLOCK

    qf = q.astype(f32) * (dh ** -0.5)
    kcf, vcf = k_cmp.astype(f32), v_cmp.astype(f32)
    gf = gates.astype(f32)
    cmp_start = jnp.arange(n_cmp) * CMP_STRIDE
    cmp_end = cmp_start + CMP_BLOCK - 1
    blk_ids = jnp.arange(n_blk)
    overlap = ((cmp_start[:, None] < (blk_ids[None, :] + 1) * SEL_BLOCK)
               & (cmp_end[:, None] >= blk_ids[None, :] * SEL_BLOCK)).astype(f32)
    kb = k_sel.reshape(B, n_blk, SEL_BLOCK, G, dh).transpose(0, 3, 1, 2, 4).reshape(B, G, n_blk, SEL_BLOCK * dh)
    vb = v_sel.reshape(B, n_blk, SEL_BLOCK, G, dh).transpose(0, 3, 1, 2, 4).reshape(B, G, n_blk, SEL_BLOCK * dh)
    pad = ((0, 0), (WINDOW, 0), (0, 0), (0, 0))
    kw = jnp.pad(k_win.astype(f32), pad)
    vw = jnp.pad(v_win.astype(f32), pad)

    def chunk(c):
        start = c * Q_BLOCK
        t = start + jnp.arange(Q_BLOCK)
        qc = lax.dynamic_slice_in_dim(qf, start, Q_BLOCK, axis=1).reshape(B, Q_BLOCK, G, Hg, dh)
        valid_c = cmp_end[None, :] <= t[:, None]
        s_c = jnp.where(valid_c, jnp.einsum('bqghd,bngd->bghqn', qc, kcf), NEG_INF)
        has_c = jnp.any(valid_c, axis=-1).astype(f32)[:, None]
        p_c = jax.nn.softmax(s_c, axis=-1) * has_c
        o_c = jnp.einsum('bghqn,bngd->bqghd', p_c, vcf)
        imp = jnp.einsum('bghqn,nj->bgqj', p_c, overlap)
        cur = t // SEL_BLOCK
        forced = (blk_ids[None, :] == 0) | (blk_ids[None, :] == cur[:, None]) | (blk_ids[None, :] == cur[:, None] - 1)
        valid_b = blk_ids[None, :] <= cur[:, None]
        score = jnp.where(valid_b, jnp.where(forced, imp + FORCE_BONUS, imp), -1.0)
        top_vals, top_idx = lax.top_k(score, top_n)
        sel_ok = top_vals >= 0.0
        gidx = top_idx.reshape(B, G, Q_BLOCK * top_n)[..., None]
        kg = jnp.take_along_axis(kb, gidx, axis=2).astype(f32).reshape(B, G, Q_BLOCK, top_n, SEL_BLOCK, dh)
        vg = jnp.take_along_axis(vb, gidx, axis=2).astype(f32).reshape(B, G, Q_BLOCK, top_n, SEL_BLOCK, dh)
        tok_pos = top_idx[..., None] * SEL_BLOCK + jnp.arange(SEL_BLOCK)
        m_s = sel_ok[..., None] & (tok_pos <= t[:, None, None])
        s_s = jnp.where(m_s[:, :, None], jnp.einsum('bqghd,bgqnsd->bghqns', qc, kg), NEG_INF)
        p_s = jax.nn.softmax(s_s.reshape(B, G, Hg, Q_BLOCK, top_n * SEL_BLOCK), axis=-1)
        p_s = p_s.reshape(B, G, Hg, Q_BLOCK, top_n, SEL_BLOCK)
        o_s = jnp.einsum('bghqns,bgqnsd->bqghd', p_s, vg)
        kwc = lax.dynamic_slice_in_dim(kw, start, n_win, axis=1)
        vwc = lax.dynamic_slice_in_dim(vw, start, n_win, axis=1)
        pos = start - WINDOW + jnp.arange(n_win)
        m_w = (pos[None, :] >= 0) & (pos[None, :] <= t[:, None]) & (pos[None, :] > t[:, None] - WINDOW)
        s_w = jnp.where(m_w, jnp.einsum('bqghd,bkgd->bghqk', qc, kwc), NEG_INF)
        p_w = jax.nn.softmax(s_w, axis=-1)
        o_w = jnp.einsum('bghqk,bkgd->bqghd', p_w, vwc)
        gc = lax.dynamic_slice_in_dim(gf, start, Q_BLOCK, axis=1).reshape(B, Q_BLOCK, G, Hg, 3)
        o = gc[..., 0:1] * o_c + gc[..., 1:2] * o_s + gc[..., 2:3] * o_w
        return o.reshape(B, Q_BLOCK, H * dh)

    outs = lax.map(chunk, jnp.arange(n_chunks))
    return outs.transpose(1, 0, 2, 3).reshape(B, T, H * dh).astype(q.dtype)


def spatial_gating(u, v, ln_g, ln_b, w_s, b_s):
    f32 = jnp.float32
    B, T, _ = u.shape
    C = T // GMLP_CHUNK
    shp = (B, C, GMLP_CHUNK, GMLP_GROUPS, GMLP_GROUP_DIM)
    vf = v.astype(f32).reshape(shp)
    mu = jnp.mean(vf, axis=-1, keepdims=True)
    var = jnp.mean(jnp.square(vf - mu), axis=-1, keepdims=True)
    vn = (vf - mu) * lax.rsqrt(var + NORM_EPS) * ln_g.astype(f32) + ln_b.astype(f32)
    causal = jnp.tril(jnp.ones((GMLP_CHUNK, GMLP_CHUNK), dtype=bool))
    w = jnp.where(causal, w_s.astype(f32), 0.0)
    mixed = jnp.einsum('gts,bcsgd->bctgd', w, vn) + b_s.astype(f32).T[:, :, None]
    return (u.astype(f32).reshape(shp) * mixed).reshape(B, T, GMLP_WIDTH).astype(u.dtype)


def setup_inputs(seed: int = 0) -> dict:
    key = jax.random.key(seed)
    ks = jax.random.split(key, 16)
    f32 = jnp.float32
    nrm = lambda k, s, sc: jax.random.normal(k, s, f32) * sc
    return {
        "x": jax.random.normal(ks[0], (BATCH, SEQ, D_MODEL), f32),
        "norm_in_g": 1.0 + nrm(ks[1], (DEPTH, D_MODEL), 0.01),
        "w_in": nrm(ks[2], (DEPTH, D_MODEL, IN_WIDTH), D_MODEL ** -0.5),
        "w_cmp_k1": nrm(ks[3], (DEPTH, CMP_BLOCK * HEAD_DIM, CMP_HIDDEN), (CMP_BLOCK * HEAD_DIM) ** -0.5),
        "w_cmp_k2": nrm(ks[4], (DEPTH, CMP_HIDDEN, HEAD_DIM), CMP_HIDDEN ** -0.5),
        "pe_cmp_k": nrm(ks[5], (DEPTH, CMP_BLOCK, HEAD_DIM), 0.1),
        "w_cmp_v1": nrm(ks[6], (DEPTH, CMP_BLOCK * HEAD_DIM, CMP_HIDDEN), (CMP_BLOCK * HEAD_DIM) ** -0.5),
        "w_cmp_v2": nrm(ks[7], (DEPTH, CMP_HIDDEN, HEAD_DIM), CMP_HIDDEN ** -0.5),
        "pe_cmp_v": nrm(ks[8], (DEPTH, CMP_BLOCK, HEAD_DIM), 0.1),
        "gmlp_ln_g": 1.0 + nrm(ks[9], (DEPTH, GMLP_GROUPS, GMLP_GROUP_DIM), 0.01),
        "gmlp_ln_b": nrm(ks[10], (DEPTH, GMLP_GROUPS, GMLP_GROUP_DIM), 0.01),
        "w_spatial": nrm(ks[11], (DEPTH, GMLP_GROUPS, GMLP_CHUNK, GMLP_CHUNK), GMLP_CHUNK ** -0.5),
        "b_spatial": 1.0 + nrm(ks[12], (DEPTH, GMLP_GROUPS, GMLP_CHUNK), 0.01),
        "w_out": nrm(ks[13], (DEPTH, D_MODEL, D_MODEL), D_MODEL ** -0.5),
        "norm_f_g": 1.0 + nrm(ks[14], (D_MODEL,), 0.01),
    }


def reference(x, norm_in_g, w_in, w_cmp_k1, w_cmp_k2, pe_cmp_k, w_cmp_v1, w_cmp_v2, pe_cmp_v,
              gmlp_ln_g, gmlp_ln_b, w_spatial, b_spatial, w_out, norm_f_g):
    B, T, _ = x.shape
    G, dh = NSA_KV_HEADS, HEAD_DIM
    h = x
    for l in range(DEPTH):
        hn = rms_norm(h, norm_in_g[l])
        proj = hn @ w_in[l]
        (q, kc, vc, ksl, vsl, kwn, vwn, gate_logits, z_nsa, u, v, z_gmlp) = split_columns(proj)
        k_cmp = compress_blocks(kc.reshape(B, T, G, dh), w_cmp_k1[l], w_cmp_k2[l], pe_cmp_k[l])
        v_cmp = compress_blocks(vc.reshape(B, T, G, dh), w_cmp_v1[l], w_cmp_v2[l], pe_cmp_v[l])
        gates = jax.nn.sigmoid(gate_logits).reshape(B, T, NSA_HEADS, 3)
        o_nsa = nsa_attention(q.reshape(B, T, NSA_HEADS, dh), k_cmp, v_cmp,
                              ksl.reshape(B, T, G, dh), vsl.reshape(B, T, G, dh),
                              kwn.reshape(B, T, G, dh), vwn.reshape(B, T, G, dh), gates)
        o_nsa = o_nsa * jax.nn.silu(z_nsa)
        o_gmlp = spatial_gating(jax.nn.gelu(u), jax.nn.gelu(v), gmlp_ln_g[l], gmlp_ln_b[l],
                                w_spatial[l], b_spatial[l]) * jax.nn.silu(z_gmlp)
        mix = jnp.concatenate([o_nsa, o_gmlp], axis=-1)
        h = h + mix @ w_out[l]
    return rms_norm(h, norm_f_g)
```

```cpp
#include <hip/hip_runtime.h>
#include <hip/hip_cooperative_groups.h>
#include <cstdio>
namespace cg = cooperative_groups;

#define DI __device__ __forceinline__
typedef unsigned short bf16_t;
typedef unsigned long long u64;
typedef __attribute__((ext_vector_type(8))) short s16x8;
typedef __attribute__((ext_vector_type(4))) short s16x4;
typedef __attribute__((ext_vector_type(16))) float f32x16;
typedef __attribute__((ext_vector_type(4))) unsigned u32x4;
typedef __attribute__((ext_vector_type(2))) unsigned u32x2;
typedef __bf16 bf2_t __attribute__((ext_vector_type(2)));
typedef float f2_t __attribute__((ext_vector_type(2)));

#define MFMA32(a, b, c) __builtin_amdgcn_mfma_f32_32x32x16_bf16((a), (b), (c), 0, 0, 0)

constexpr int NTOK = 65536;
constexpr int TSEQ = 4096;
constexpr float L2E = 1.4426950408889634f;

constexpr size_t OFF_HN    = 0;
constexpr size_t OFF_WTIN  = OFF_HN    + (size_t)NTOK * 1024 * 2;
constexpr size_t OFF_WTOUT = OFF_WTIN  + (size_t)3456 * 1024 * 2;
constexpr size_t OFF_W1TK  = OFF_WTOUT + (size_t)1024 * 1024 * 2;
constexpr size_t OFF_W1TV  = OFF_W1TK  + (size_t)128 * 2048 * 2;
constexpr size_t OFF_BIAS  = OFF_W1TV  + (size_t)128 * 2048 * 2;
constexpr size_t OFF_WSP   = OFF_BIAS  + 1024;
constexpr size_t OFF_Q     = OFF_WSP   + (size_t)8 * 128 * 128 * 2;
constexpr size_t OFF_KC    = OFF_Q     + (size_t)NTOK * 512 * 2;
constexpr size_t OFF_VC    = OFF_KC    + (size_t)NTOK * 128 * 2;
constexpr size_t OFF_KS    = OFF_VC    + (size_t)NTOK * 128 * 2;
constexpr size_t OFF_KW    = OFF_KS    + (size_t)NTOK * 128 * 2;
constexpr size_t OFF_VST   = OFF_KW    + (size_t)NTOK * 128 * 2;
constexpr size_t OFF_VWT   = OFF_VST   + (size_t)NTOK * 128 * 2;
constexpr size_t OFF_ZN    = OFF_VWT   + (size_t)NTOK * 128 * 2;
constexpr size_t OFF_U     = OFF_ZN    + (size_t)NTOK * 512 * 2;
constexpr size_t OFF_V     = OFF_U     + (size_t)NTOK * 512 * 2;
constexpr size_t OFF_ZG    = OFF_V     + (size_t)NTOK * 512 * 2;
constexpr size_t OFF_GATES = OFF_ZG    + (size_t)NTOK * 512 * 2;
constexpr size_t OFF_KCMP  = OFF_GATES + (size_t)NTOK * 24 * 4;
constexpr size_t OFF_VCMPT = OFF_KCMP  + (size_t)32 * 256 * 64 * 2;
constexpr size_t OFF_MIX   = OFF_VCMPT + (size_t)32 * 256 * 64 * 2;
constexpr size_t WS_END    = OFF_MIX   + (size_t)NTOK * 1024 * 2;

constexpr int SMEM_BYTES = 74240;

struct Params {
  const float *x, *norm_in_g, *w_in, *w_k1, *w_k2, *pe_k, *w_v1, *w_v2, *pe_v, *ln_g, *ln_b, *w_sp, *b_sp, *w_out, *norm_f_g;
  float* out;
  char* ws;
};

DI unsigned pack2(float a, float b) {
  f2_t v = {a, b};
  bf2_t r = __builtin_convertvector(v, bf2_t);
  return __builtin_bit_cast(unsigned, r);
}
DI bf16_t f2bf(float a) { return (bf16_t)(pack2(a, 0.f) & 0xffffu); }
DI float bflo(unsigned u) { return __uint_as_float(u << 16); }
DI float bfhi(unsigned u) { return __uint_as_float(u & 0xffff0000u); }
DI float wave_sum(float v) {
#pragma unroll
  for (int o = 32; o >= 1; o >>= 1) v += __shfl_xor(v, o);
  return v;
}
DI float gelu_t(float x) {
  float y = 0.7978845608028654f * (x + 0.044715f * x * x * x);
  float e = __expf(2.f * y);
  float th = 1.f - 2.f / (1.f + e);
  return 0.5f * x * (1.f + th);
}
DI float sigmoid_f(float x) { return 1.f / (1.f + __expf(-x)); }
DI float silu_f(float x) { return x / (1.f + __expf(-x)); }
DI int crow(int i, int h) { return (i & 3) + 8 * (i >> 2) + 4 * h; }

DI void transpose_w(const float* __restrict__ src, int src_ld, bf16_t* __restrict__ dst, int Np, int K, int mode,
                    int gtid, int gthreads) {
  const int nchunks = K >> 3;
  const long total = (long)nchunks * Np;
  for (long id = gtid; id < total; id += gthreads) {
    const int n = (int)(id % Np), kc = (int)(id / Np);
    int sn = n;
    if (mode == 1) {
      if (n < 1280) sn = n;
      else if (n < 3328) sn = n + 24;
      else if (n < 3352) sn = n - 3328 + 1280;
      else sn = -1;
    }
    u32x4 o = {0u, 0u, 0u, 0u};
    if (sn >= 0) {
      float f[8];
#pragma unroll
      for (int j = 0; j < 8; ++j) f[j] = src[(size_t)(kc * 8 + j) * src_ld + sn];
      o[0] = pack2(f[0], f[1]); o[1] = pack2(f[2], f[3]); o[2] = pack2(f[4], f[5]); o[3] = pack2(f[6], f[7]);
    }
    *(u32x4*)(dst + (size_t)n * K + kc * 8) = o;
  }
}

DI void phase0(const Params& p) {
  const int tid = threadIdx.x, lane = tid & 63, wave = tid >> 6;
  const int gthreads = gridDim.x * 256, gtid = blockIdx.x * 256 + tid;
  const int gwaves = gridDim.x * 4, gwave = blockIdx.x * 4 + wave;
  bf16_t* HN = (bf16_t*)(p.ws + OFF_HN);
  for (int row = gwave; row < NTOK; row += gwaves) {
    const float4* xr = (const float4*)(p.x + (size_t)row * 1024);
    float4 v[4];
    float ss = 0.f;
#pragma unroll
    for (int i = 0; i < 4; ++i) {
      v[i] = xr[i * 64 + lane];
      ss += v[i].x * v[i].x + v[i].y * v[i].y + v[i].z * v[i].z + v[i].w * v[i].w;
    }
    ss = wave_sum(ss);
    const float rstd = rsqrtf(ss * (1.f / 1024.f) + 1e-6f);
#pragma unroll
    for (int i = 0; i < 4; ++i) {
      const float4 g = ((const float4*)p.norm_in_g)[i * 64 + lane];
      u32x2 o;
      o[0] = pack2(v[i].x * rstd * g.x, v[i].y * rstd * g.y);
      o[1] = pack2(v[i].z * rstd * g.z, v[i].w * rstd * g.w);
      *(u32x2*)(HN + (size_t)row * 1024 + (i * 64 + lane) * 4) = o;
    }
  }
  transpose_w(p.w_in, 3352, (bf16_t*)(p.ws + OFF_WTIN), 3456, 1024, 1, gtid, gthreads);
  transpose_w(p.w_out, 1024, (bf16_t*)(p.ws + OFF_WTOUT), 1024, 1024, 0, gtid, gthreads);
  transpose_w(p.w_k1, 128, (bf16_t*)(p.ws + OFF_W1TK), 128, 2048, 0, gtid, gthreads);
  transpose_w(p.w_v1, 128, (bf16_t*)(p.ws + OFF_W1TV), 128, 2048, 0, gtid, gthreads);
  float* BIAS = (float*)(p.ws + OFF_BIAS);
  for (int it = gwave; it < 256; it += gwaves) {
    const int kv = it >> 7, e = it & 127;
    const float* w1 = kv ? p.w_v1 : p.w_k1;
    const float* pe = kv ? p.pe_v : p.pe_k;
    float s = 0.f;
    for (int kk = lane; kk < 2048; kk += 64) s += pe[kk] * w1[(size_t)kk * 128 + e];
    s = wave_sum(s);
    if (lane == 0) BIAS[it] = s;
  }
  bf16_t* WSP = (bf16_t*)(p.ws + OFF_WSP);
  for (int id = gtid; id < 8 * 128 * 128; id += gthreads) {
    const int t = (id >> 7) & 127, s = id & 127;
    WSP[id] = (s <= t) ? f2bf(p.w_sp[id]) : (bf16_t)0;
  }
}

DI void gemm_mainloop(const bf16_t* __restrict__ Ag, int lda, const bf16_t* __restrict__ Bg, int ldb, int K,
                      char* smem, f32x16 (&acc)[2][2]) {
  const int tid = threadIdx.x, lane = tid & 63, wave = tid >> 6, wm = wave >> 1, wn = wave & 1;
  const int r = lane & 31, h = lane >> 5;
  const int lrow = tid >> 3, lcc = tid & 7;
  u32x4 ra[4], rb[4];
  const int nk = K >> 6;
  const bf16_t* ap = Ag + (size_t)lrow * lda + lcc * 8;
  const bf16_t* bp = Bg + (size_t)lrow * ldb + lcc * 8;
#pragma unroll
  for (int q = 0; q < 4; ++q) {
    ra[q] = *(const u32x4*)(ap + (size_t)(32 * q) * lda);
    rb[q] = *(const u32x4*)(bp + (size_t)(32 * q) * ldb);
  }
#pragma unroll
  for (int q = 0; q < 4; ++q) {
    *(u32x4*)(smem + (lrow + 32 * q) * 144 + lcc * 16) = ra[q];
    *(u32x4*)(smem + 18432 + (lrow + 32 * q) * 144 + lcc * 16) = rb[q];
  }
  __syncthreads();
  for (int kt = 0; kt < nk; ++kt) {
    const bool more = (kt + 1 < nk);
    if (more) {
#pragma unroll
      for (int q = 0; q < 4; ++q) {
        ra[q] = *(const u32x4*)(ap + (size_t)(32 * q) * lda + (kt + 1) * 64);
        rb[q] = *(const u32x4*)(bp + (size_t)(32 * q) * ldb + (kt + 1) * 64);
      }
    }
    const char* As = smem + (kt & 1) * 36864;
    const char* Bs = As + 18432;
#pragma unroll
    for (int s = 0; s < 4; ++s) {
      s16x8 af[2], bfr[2];
#pragma unroll
      for (int t = 0; t < 2; ++t) {
        af[t] = *(const s16x8*)(As + (wm * 64 + t * 32 + r) * 144 + s * 32 + h * 16);
        bfr[t] = *(const s16x8*)(Bs + (wn * 64 + t * 32 + r) * 144 + s * 32 + h * 16);
      }
#pragma unroll
      for (int rt = 0; rt < 2; ++rt)
#pragma unroll
        for (int ct = 0; ct < 2; ++ct) acc[rt][ct] = MFMA32(af[rt], bfr[ct], acc[rt][ct]);
    }
    if (more) {
      char* Ad = smem + ((kt + 1) & 1) * 36864;
#pragma unroll
      for (int q = 0; q < 4; ++q) {
        *(u32x4*)(Ad + (lrow + 32 * q) * 144 + lcc * 16) = ra[q];
        *(u32x4*)(Ad + 18432 + (lrow + 32 * q) * 144 + lcc * 16) = rb[q];
      }
    }
    __syncthreads();
  }
}

DI void phase1_tile(const Params& p, char* smem, int mt, int nt) {
  const int tid = threadIdx.x, lane = tid & 63, wave = tid >> 6, wm = wave >> 1, wn = wave & 1;
  const int r = lane & 31, h = lane >> 5;
  const bf16_t* HN = (const bf16_t*)(p.ws + OFF_HN);
  const bf16_t* WT = (const bf16_t*)(p.ws + OFF_WTIN);
  f32x16 acc[2][2];
#pragma unroll
  for (int a = 0; a < 2; ++a)
#pragma unroll
    for (int b = 0; b < 2; ++b)
#pragma unroll
      for (int i = 0; i < 16; ++i) acc[a][b][i] = 0.f;
  gemm_mainloop(HN + (size_t)mt * 128 * 1024, 1024, WT + (size_t)nt * 128 * 1024, 1024, 1024, smem, acc);

  const int m0 = mt * 128;
  bf16_t* dst = nullptr;
  int ld = 512, colbase = 0, act = 0;
  bool transposed = false, gates = false;
  if (nt < 4) { dst = (bf16_t*)(p.ws + OFF_Q); ld = 512; colbase = nt * 128; act = 1; }
  else if (nt == 4) { dst = (bf16_t*)(p.ws + OFF_KC); ld = 128; }
  else if (nt == 5) { dst = (bf16_t*)(p.ws + OFF_VC); ld = 128; }
  else if (nt == 6) { dst = (bf16_t*)(p.ws + OFF_KS); ld = 128; }
  else if (nt == 7) { dst = (bf16_t*)(p.ws + OFF_VST); transposed = true; }
  else if (nt == 8) { dst = (bf16_t*)(p.ws + OFF_KW); ld = 128; }
  else if (nt == 9) { dst = (bf16_t*)(p.ws + OFF_VWT); transposed = true; }
  else if (nt < 14) { dst = (bf16_t*)(p.ws + OFF_ZN); colbase = (nt - 10) * 128; act = 2; }
  else if (nt < 18) { dst = (bf16_t*)(p.ws + OFF_U); colbase = (nt - 14) * 128; act = 3; }
  else if (nt < 22) { dst = (bf16_t*)(p.ws + OFF_V); colbase = (nt - 18) * 128; act = 3; }
  else if (nt < 26) { dst = (bf16_t*)(p.ws + OFF_ZG); colbase = (nt - 22) * 128; act = 2; }
  else gates = true;

  if (gates) {
    float* G = (float*)(p.ws + OFF_GATES);
#pragma unroll
    for (int rt = 0; rt < 2; ++rt)
#pragma unroll
      for (int ct = 0; ct < 2; ++ct) {
        const int cn = wn * 64 + ct * 32 + r;
        if (cn < 24) {
#pragma unroll
          for (int i = 0; i < 16; ++i) {
            const int m = m0 + wm * 64 + rt * 32 + crow(i, h);
            G[(size_t)m * 24 + cn] = sigmoid_f(acc[rt][ct][i]);
          }
        }
      }
  } else if (transposed) {
    const int b = m0 >> 12, t0 = m0 & 4095;
#pragma unroll
    for (int rt = 0; rt < 2; ++rt)
#pragma unroll
      for (int ct = 0; ct < 2; ++ct) {
        const int cn = wn * 64 + ct * 32 + r;
        bf16_t* drow = dst + ((size_t)((b * 2 + (cn >> 6)) * 64 + (cn & 63))) * 4096 + t0 + wm * 64 + rt * 32 + 4 * h;
#pragma unroll
        for (int gi = 0; gi < 4; ++gi) {
          u32x2 o;
          o[0] = pack2(acc[rt][ct][4 * gi + 0], acc[rt][ct][4 * gi + 1]);
          o[1] = pack2(acc[rt][ct][4 * gi + 2], acc[rt][ct][4 * gi + 3]);
          *(u32x2*)(drow + 8 * gi) = o;
        }
      }
  } else {
#pragma unroll
    for (int rt = 0; rt < 2; ++rt)
#pragma unroll
      for (int ct = 0; ct < 2; ++ct) {
        const int cn = wn * 64 + ct * 32 + r;
#pragma unroll
        for (int i = 0; i < 16; ++i) {
          const int m = m0 + wm * 64 + rt * 32 + crow(i, h);
          float v = acc[rt][ct][i];
          if (act == 1) v *= 0.125f;
          else if (act == 2) v = silu_f(v);
          else if (act == 3) v = gelu_t(v);
          dst[(size_t)m * ld + colbase + cn] = f2bf(v);
        }
      }
  }
}

DI void phase1(const Params& p, char* smem) {
  const int xcd = blockIdx.x & 7, j = blockIdx.x >> 3, per = gridDim.x >> 3;
  for (int s = j; s < 64 * 27; s += per) {
    const int mg = s / 216, rem = s % 216;
    const int nt = rem >> 3, mt = xcd * 64 + mg * 8 + (rem & 7);
    phase1_tile(p, smem, mt, nt);
  }
}

DI void compress_item(const Params& p, char* smem, int it) {
  const int tid = threadIdx.x, lane = tid & 63, wave = tid >> 6;
  const int r = lane & 31, h = lane >> 5;
  const int kv = it >> 8, b = (it >> 4) & 15, g = (it >> 3) & 1, n0 = (it & 7) * 32;
  const bf16_t* src = (const bf16_t*)(p.ws + (kv ? OFF_VC : OFF_KC));
  const bf16_t* w1t = (const bf16_t*)(p.ws + (kv ? OFF_W1TV : OFF_W1TK));
  const float* bias = (const float*)(p.ws + OFF_BIAS) + kv * 128;
  const float* w2 = kv ? p.w_v2 : p.w_k2;
  float* hidL = (float*)smem;
  f32x16 acc;
#pragma unroll
  for (int i = 0; i < 16; ++i) acc[i] = 0.f;
  const int n = n0 + r;
  const bf16_t* brow = w1t + (size_t)(32 * wave + r) * 2048 + h * 8;
#pragma unroll 2
  for (int l = 0; l < 32; ++l) {
    int tok = 16 * n + l;
    tok = tok > 4095 ? 4095 : tok;
    const bf16_t* arow = src + ((size_t)b * 4096 + tok) * 128 + g * 64 + h * 8;
#pragma unroll
    for (int s = 0; s < 4; ++s) {
      const s16x8 af = *(const s16x8*)(arow + s * 16);
      const s16x8 bfr = *(const s16x8*)(brow + l * 64 + s * 16);
      acc = MFMA32(af, bfr, acc);
    }
  }
  {
    const int e = 32 * wave + r;
    const float be = bias[e];
#pragma unroll
    for (int i = 0; i < 16; ++i) hidL[crow(i, h) * 132 + e] = gelu_t(acc[i] + be);
  }
  __syncthreads();
  {
    const int f = tid & 63, ng = tid >> 6;
    float o[8];
#pragma unroll
    for (int k = 0; k < 8; ++k) o[k] = 0.f;
    for (int e = 0; e < 128; ++e) {
      const float wv = w2[e * 64 + f];
#pragma unroll
      for (int k = 0; k < 8; ++k) o[k] += hidL[(ng * 8 + k) * 132 + e] * wv;
    }
    const int bg = b * 2 + g;
#pragma unroll
    for (int k = 0; k < 8; ++k) {
      const int nn = n0 + ng * 8 + k;
      const float val = (nn < 255) ? o[k] : 0.f;
      if (kv == 0) ((bf16_t*)(p.ws + OFF_KCMP))[((size_t)bg * 256 + nn) * 64 + f] = f2bf(val);
      else ((bf16_t*)(p.ws + OFF_VCMPT))[((size_t)bg * 64 + f) * 256 + nn] = f2bf(val);
    }
  }
  __syncthreads();
}

DI void gmlp_item(const Params& p, char* smem, int it) {
  const int tid = threadIdx.x, lane = tid & 63, wave = tid >> 6;
  const int r = lane & 31, h = lane >> 5;
  const int gg = it & 7, ck = (it >> 3) & 31, b = it >> 8;
  const size_t tokbase = (size_t)b * 4096 + ck * 128;
  const bf16_t* V = (const bf16_t*)(p.ws + OFF_V);
  const bf16_t* U = (const bf16_t*)(p.ws + OFF_U);
  const bf16_t* ZG = (const bf16_t*)(p.ws + OFF_ZG);
  const bf16_t* WSP = (const bf16_t*)(p.ws + OFF_WSP);
  bf16_t* MIX = (bf16_t*)(p.ws + OFF_MIX);
  char* vnT = smem;
  float* mxl = (float*)(smem + 17408);
  const int tl = tid >> 1, half = tid & 1, d0 = half * 32;
  {
    float v[32];
    const bf16_t* vp = V + (tokbase + tl) * 512 + gg * 64 + d0;
#pragma unroll
    for (int q = 0; q < 4; ++q) {
      const u32x4 w = *(const u32x4*)(vp + q * 8);
#pragma unroll
      for (int k = 0; k < 4; ++k) { v[q * 8 + 2 * k] = bflo(w[k]); v[q * 8 + 2 * k + 1] = bfhi(w[k]); }
    }
    float s1 = 0.f;
#pragma unroll
    for (int j = 0; j < 32; ++j) s1 += v[j];
    s1 += __shfl_xor(s1, 1);
    const float mu = s1 * (1.f / 64.f);
    float s2 = 0.f;
#pragma unroll
    for (int j = 0; j < 32; ++j) { const float d = v[j] - mu; s2 += d * d; }
    s2 += __shfl_xor(s2, 1);
    const float rstd = rsqrtf(s2 * (1.f / 64.f) + 1e-6f);
#pragma unroll
    for (int j = 0; j < 32; ++j) {
      const float vn = (v[j] - mu) * rstd * p.ln_g[gg * 64 + d0 + j] + p.ln_b[gg * 64 + d0 + j];
      *(bf16_t*)(vnT + (d0 + j) * 272 + tl * 2) = f2bf(vn);
    }
  }
  __syncthreads();
  {
    f32x16 acc[2];
#pragma unroll
    for (int c = 0; c < 2; ++c)
#pragma unroll
      for (int i = 0; i < 16; ++i) acc[c][i] = 0.f;
    const bf16_t* arow = WSP + ((size_t)gg * 128 + 32 * wave + r) * 128 + h * 8;
    const int nks = 2 * (wave + 1);
    for (int ks = 0; ks < nks; ++ks) {
      const s16x8 af = *(const s16x8*)(arow + ks * 16);
#pragma unroll
      for (int c = 0; c < 2; ++c) {
        const s16x8 bfr = *(const s16x8*)(vnT + (c * 32 + r) * 272 + (ks * 16 + h * 8) * 2);
        acc[c] = MFMA32(af, bfr, acc[c]);
      }
    }
#pragma unroll
    for (int i = 0; i < 16; ++i) {
      const int t = 32 * wave + crow(i, h);
      const float bs = p.b_sp[gg * 128 + t];
#pragma unroll
      for (int c = 0; c < 2; ++c) mxl[t * 68 + c * 32 + r] = acc[c][i] + bs;
    }
  }
  __syncthreads();
  {
    const size_t off = (tokbase + tl) * 512 + gg * 64 + d0;
    bf16_t* op = MIX + (tokbase + tl) * 1024 + 512 + gg * 64 + d0;
#pragma unroll
    for (int q = 0; q < 4; ++q) {
      const u32x4 uu = *(const u32x4*)(U + off + q * 8);
      const u32x4 zz = *(const u32x4*)(ZG + off + q * 8);
      const float4 m0 = *(const float4*)(mxl + tl * 68 + d0 + q * 8);
      const float4 m1 = *(const float4*)(mxl + tl * 68 + d0 + q * 8 + 4);
      u32x4 o;
      o[0] = pack2(bflo(uu[0]) * m0.x * bflo(zz[0]), bfhi(uu[0]) * m0.y * bfhi(zz[0]));
      o[1] = pack2(bflo(uu[1]) * m0.z * bflo(zz[1]), bfhi(uu[1]) * m0.w * bfhi(zz[1]));
      o[2] = pack2(bflo(uu[2]) * m1.x * bflo(zz[2]), bfhi(uu[2]) * m1.y * bfhi(zz[2]));
      o[3] = pack2(bflo(uu[3]) * m1.z * bflo(zz[3]), bfhi(uu[3]) * m1.w * bfhi(zz[3]));
      *(u32x4*)(op + q * 8) = o;
    }
  }
  __syncthreads();
}

DI void load_tile64(char* dst, const bf16_t* __restrict__ src, size_t pitch, int tid) {
#pragma unroll
  for (int q = 0; q < 2; ++q) {
    const int chunk = tid + 256 * q, row = chunk >> 3, cc = chunk & 7;
    const u32x4 v = *(const u32x4*)(src + (size_t)row * pitch + cc * 8);
    *(u32x4*)(dst + row * 144 + cc * 16) = v;
  }
}

DI void qk_tile(const char* Kl, const s16x8 (&qf)[2][4], f32x16 (&S)[2][2], int r, int h) {
#pragma unroll
  for (int a = 0; a < 2; ++a)
#pragma unroll
    for (int b = 0; b < 2; ++b)
#pragma unroll
      for (int i = 0; i < 16; ++i) S[a][b][i] = 0.f;
#pragma unroll
  for (int kt2 = 0; kt2 < 2; ++kt2)
#pragma unroll
    for (int s = 0; s < 4; ++s) {
      const s16x8 kf = *(const s16x8*)(Kl + (kt2 * 32 + r) * 144 + s * 32 + h * 16);
#pragma unroll
      for (int qt = 0; qt < 2; ++qt) S[kt2][qt] = MFMA32(kf, qf[qt][s], S[kt2][qt]);
    }
}

DI void pv_tile(const char* Vl, const f32x16 (&S)[2][2], f32x16 (&O)[2][2], int r, int h) {
#pragma unroll
  for (int kt2 = 0; kt2 < 2; ++kt2)
#pragma unroll
    for (int s2 = 0; s2 < 2; ++s2) {
      s16x8 pf[2];
#pragma unroll
      for (int qt = 0; qt < 2; ++qt) {
        u32x4 pk;
        pk[0] = pack2(S[kt2][qt][8 * s2 + 0], S[kt2][qt][8 * s2 + 1]);
        pk[1] = pack2(S[kt2][qt][8 * s2 + 2], S[kt2][qt][8 * s2 + 3]);
        pk[2] = pack2(S[kt2][qt][8 * s2 + 4], S[kt2][qt][8 * s2 + 5]);
        pk[3] = pack2(S[kt2][qt][8 * s2 + 6], S[kt2][qt][8 * s2 + 7]);
        pf[qt] = __builtin_bit_cast(s16x8, pk);
      }
#pragma unroll
      for (int dt = 0; dt < 2; ++dt) {
        const char* vp = Vl + (dt * 32 + r) * 144 + (kt2 * 32 + 16 * s2 + 4 * h) * 2;
        const s16x4 lo = *(const s16x4*)(vp);
        const s16x4 hi = *(const s16x4*)(vp + 16);
        const s16x8 vf = __builtin_shufflevector(lo, hi, 0, 1, 2, 3, 4, 5, 6, 7);
#pragma unroll
        for (int qt = 0; qt < 2; ++qt) O[dt][qt] = MFMA32(vf, pf[qt], O[dt][qt]);
      }
    }
}

DI void softmax_tile(f32x16 (&S)[2][2], int kbase, const int (&lo)[2], const int (&hi)[2], float (&m)[2],
                     float (&l)[2], f32x16 (&O)[2][2], int h) {
#pragma unroll
  for (int qt = 0; qt < 2; ++qt) {
    float mx = -1e30f;
#pragma unroll
    for (int kt2 = 0; kt2 < 2; ++kt2)
#pragma unroll
      for (int i = 0; i < 16; ++i) {
        const int kp = kbase + kt2 * 32 + crow(i, h);
        const bool valid = (kp >= lo[qt]) && (kp <= hi[qt]);
        mx = valid ? fmaxf(mx, S[kt2][qt][i]) : mx;
      }
    mx = fmaxf(mx, __shfl_xor(mx, 32));
    const float mnew = fmaxf(m[qt], mx);
    const float alpha = __builtin_amdgcn_exp2f((m[qt] - mnew) * L2E);
    const float mL = mnew * L2E;
    float sum = 0.f;
#pragma unroll
    for (int kt2 = 0; kt2 < 2; ++kt2)
#pragma unroll
      for (int i = 0; i < 16; ++i) {
        const int kp = kbase + kt2 * 32 + crow(i, h);
        const bool valid = (kp >= lo[qt]) && (kp <= hi[qt]);
        const float pv = valid ? __builtin_amdgcn_exp2f(__builtin_fmaf(S[kt2][qt][i], L2E, -mL)) : 0.f;
        S[kt2][qt][i] = pv;
        sum += pv;
      }
    l[qt] = l[qt] * alpha + sum;
    m[qt] = mnew;
#pragma unroll
    for (int dt = 0; dt < 2; ++dt)
#pragma unroll
      for (int i = 0; i < 16; ++i) O[dt][qt][i] *= alpha;
  }
}

DI void attn_item(const Params& p, char* smem, int c, int b, int g) {
  const int tid = threadIdx.x, lane = tid & 63, wave = tid >> 6;
  const int r = lane & 31, h = lane >> 5;
  const int hd = g * 4 + wave, bg = b * 2 + g;
  const size_t tok0 = (size_t)b * 4096 + c * 64;
  char* Kl = smem;
  char* Vl = smem + 9216;
  float* imp = (float*)(smem + 18432);
  unsigned short* selm = (unsigned short*)(smem + 34816);
  const bf16_t* Q = (const bf16_t*)(p.ws + OFF_Q);
  const float* GATES = (const float*)(p.ws + OFF_GATES);
  const bf16_t* KCMP = (const bf16_t*)(p.ws + OFF_KCMP) + (size_t)bg * 256 * 64;
  const bf16_t* VCMPT = (const bf16_t*)(p.ws + OFF_VCMPT) + (size_t)bg * 64 * 256;
  const bf16_t* KS = (const bf16_t*)(p.ws + OFF_KS) + (size_t)b * 4096 * 128 + g * 64;
  const bf16_t* KW = (const bf16_t*)(p.ws + OFF_KW) + (size_t)b * 4096 * 128 + g * 64;
  const bf16_t* VST = (const bf16_t*)(p.ws + OFF_VST) + (size_t)bg * 64 * 4096;
  const bf16_t* VWT = (const bf16_t*)(p.ws + OFF_VWT) + (size_t)bg * 64 * 4096;

  s16x8 qf[2][4];
  float gate[2][3];
#pragma unroll
  for (int qt = 0; qt < 2; ++qt) {
    const size_t tok = tok0 + qt * 32 + r;
#pragma unroll
    for (int s = 0; s < 4; ++s) qf[qt][s] = *(const s16x8*)(Q + tok * 512 + hd * 64 + s * 16 + h * 8);
#pragma unroll
    for (int k = 0; k < 3; ++k) gate[qt][k] = GATES[tok * 24 + hd * 3 + k];
  }
  unsigned* stash = (unsigned*)(smem + 35328);
  for (int i = tid; i < 4096; i += 256) imp[i] = 0.f;

  int tq[2] = {c * 64 + r, c * 64 + 32 + r};
  f32x16 S[2][2], O[2][2];
  float m[2], l[2];
  int lo[2], hi[2];

  {
    const int nct = ((4 * c + 2) >> 6) + 1;
    lo[0] = lo[1] = 0;
    hi[0] = (tq[0] - 31) >> 4;
    hi[1] = (tq[1] - 31) >> 4;
    m[0] = m[1] = -1e30f;
    l[0] = l[1] = 0.f;
    for (int ct = 0; ct < nct; ++ct) {
      __syncthreads();
      load_tile64(Kl, KCMP + (size_t)ct * 64 * 64, 64, tid);
      __syncthreads();
      qk_tile(Kl, qf, S, r, h);
#pragma unroll
      for (int qt = 0; qt < 2; ++qt) {
        float mx = -1e30f;
#pragma unroll
        for (int kt2 = 0; kt2 < 2; ++kt2)
#pragma unroll
          for (int i = 0; i < 16; ++i) {
            const int kp = ct * 64 + kt2 * 32 + crow(i, h);
            mx = (kp <= hi[qt]) ? fmaxf(mx, S[kt2][qt][i]) : mx;
          }
        mx = fmaxf(mx, __shfl_xor(mx, 32));
        const float mnew = fmaxf(m[qt], mx);
        const float alpha = __builtin_amdgcn_exp2f((m[qt] - mnew) * L2E);
        const float mL = mnew * L2E;
        float sum = 0.f;
#pragma unroll
        for (int kt2 = 0; kt2 < 2; ++kt2)
#pragma unroll
          for (int i = 0; i < 16; ++i) {
            const int kp = ct * 64 + kt2 * 32 + crow(i, h);
            sum += (kp <= hi[qt]) ? __builtin_amdgcn_exp2f(__builtin_fmaf(S[kt2][qt][i], L2E, -mL)) : 0.f;
          }
        l[qt] = l[qt] * alpha + sum;
        m[qt] = mnew;
      }
    }
    float inv[2];
#pragma unroll
    for (int qt = 0; qt < 2; ++qt) {
      const float lt = l[qt] + __shfl_xor(l[qt], 32);
      inv[qt] = (hi[qt] >= 0 && lt > 0.f) ? 1.f / lt : 0.f;
    }
#pragma unroll
    for (int a = 0; a < 2; ++a)
#pragma unroll
      for (int bb = 0; bb < 2; ++bb)
#pragma unroll
        for (int i = 0; i < 16; ++i) O[a][bb][i] = 0.f;
    for (int ct = 0; ct < nct; ++ct) {
      __syncthreads();
      load_tile64(Kl, KCMP + (size_t)ct * 64 * 64, 64, tid);
      load_tile64(Vl, VCMPT + ct * 64, 256, tid);
      __syncthreads();
      qk_tile(Kl, qf, S, r, h);
#pragma unroll
      for (int qt = 0; qt < 2; ++qt) {
        const float mL = m[qt] * L2E;
#pragma unroll
        for (int kt2 = 0; kt2 < 2; ++kt2)
#pragma unroll
          for (int i = 0; i < 16; ++i) {
            const int kp = ct * 64 + kt2 * 32 + crow(i, h);
            S[kt2][qt][i] = (kp <= hi[qt]) ? __builtin_amdgcn_exp2f(__builtin_fmaf(S[kt2][qt][i], L2E, -mL)) * inv[qt] : 0.f;
          }
        if (c >= 16) {
          float* irow = imp + (qt * 32 + r) * 64;
#pragma unroll
          for (int kt2 = 0; kt2 < 2; ++kt2)
#pragma unroll
            for (int gi = 0; gi < 4; ++gi) {
              const int jb = ct * 16 + kt2 * 8 + 2 * gi + h;
              const float a4 = (S[kt2][qt][4 * gi] + S[kt2][qt][4 * gi + 1]) + (S[kt2][qt][4 * gi + 2] + S[kt2][qt][4 * gi + 3]);
              __hip_atomic_fetch_add(irow + jb, a4, __ATOMIC_RELAXED, __HIP_MEMORY_SCOPE_WORKGROUP);
              if (jb + 1 < 64)
                __hip_atomic_fetch_add(irow + jb + 1, S[kt2][qt][4 * gi + 3], __ATOMIC_RELAXED, __HIP_MEMORY_SCOPE_WORKGROUP);
            }
        }
      }
      pv_tile(Vl, S, O, r, h);
    }
#pragma unroll
    for (int dt = 0; dt < 2; ++dt)
#pragma unroll
      for (int qt = 0; qt < 2; ++qt)
#pragma unroll
        for (int ip = 0; ip < 8; ++ip)
          stash[((dt * 2 + qt) * 8 + ip) * 256 + tid] =
              pack2(gate[qt][0] * O[dt][qt][2 * ip], gate[qt][0] * O[dt][qt][2 * ip + 1]);
  }
  __syncthreads();
  {
    const int q = tid >> 2, part = tid & 3;
    unsigned bits = 0;
    if (c >= 16) {
      unsigned key[16];
#pragma unroll
      for (int k = 0; k < 16; ++k) {
        const int j = part * 16 + k;
        const unsigned u = __float_as_uint(imp[q * 64 + j]);
        key[k] = (j >= 1 && j <= c - 2) ? ((u & ~63u) | (unsigned)(63 - j)) : 0u;
      }
      for (int rd = 0; rd < 13; ++rd) {
        unsigned lm = key[0];
#pragma unroll
        for (int k = 1; k < 16; ++k) lm = lm > key[k] ? lm : key[k];
        unsigned o1 = (unsigned)__shfl_xor((int)lm, 1);
        lm = lm > o1 ? lm : o1;
        unsigned o2 = (unsigned)__shfl_xor((int)lm, 2);
        lm = lm > o2 ? lm : o2;
#pragma unroll
        for (int k = 0; k < 16; ++k) {
          const bool hit = (key[k] == lm) && (lm != 0u);
          bits |= hit ? (1u << k) : 0u;
          key[k] = hit ? 0u : key[k];
        }
      }
#pragma unroll
      for (int k = 0; k < 16; ++k) {
        const int j = part * 16 + k;
        if (j == 0 || j == c || j == c - 1) bits |= (1u << k);
      }
    } else {
#pragma unroll
      for (int k = 0; k < 16; ++k) {
        const int j = part * 16 + k;
        if (j <= c) bits |= (1u << k);
      }
    }
    selm[q * 4 + part] = (unsigned short)bits;
  }
  __syncthreads();
  u64 sm[2];
#pragma unroll
  for (int qt = 0; qt < 2; ++qt) sm[qt] = *(const u64*)(selm + (qt * 32 + r) * 4);

  {
    m[0] = m[1] = -1e30f;
    l[0] = l[1] = 0.f;
#pragma unroll
    for (int a = 0; a < 2; ++a)
#pragma unroll
      for (int bb = 0; bb < 2; ++bb)
#pragma unroll
        for (int i = 0; i < 16; ++i) O[a][bb][i] = 0.f;
    lo[0] = lo[1] = 0;
    for (int j = 0; j <= c; ++j) {
      __syncthreads();
      load_tile64(Kl, KS + (size_t)j * 64 * 128, 128, tid);
      load_tile64(Vl, VST + j * 64, 4096, tid);
      __syncthreads();
      qk_tile(Kl, qf, S, r, h);
      hi[0] = ((sm[0] >> j) & 1ull) ? tq[0] : -1;
      hi[1] = ((sm[1] >> j) & 1ull) ? tq[1] : -1;
      softmax_tile(S, j * 64, lo, hi, m, l, O, h);
      pv_tile(Vl, S, O, r, h);
    }
#pragma unroll
    for (int qt = 0; qt < 2; ++qt) {
      const float lt = l[qt] + __shfl_xor(l[qt], 32);
      const float sc = gate[qt][1] / lt;
#pragma unroll
      for (int dt = 0; dt < 2; ++dt)
#pragma unroll
        for (int ip = 0; ip < 8; ++ip) {
          unsigned* sp = stash + ((dt * 2 + qt) * 8 + ip) * 256 + tid;
          const unsigned pr = *sp;
          *sp = pack2(bflo(pr) + sc * O[dt][qt][2 * ip], bfhi(pr) + sc * O[dt][qt][2 * ip + 1]);
        }
    }
  }
  {
    m[0] = m[1] = -1e30f;
    l[0] = l[1] = 0.f;
#pragma unroll
    for (int a = 0; a < 2; ++a)
#pragma unroll
      for (int bb = 0; bb < 2; ++bb)
#pragma unroll
        for (int i = 0; i < 16; ++i) O[a][bb][i] = 0.f;
    lo[0] = tq[0] - 511; lo[1] = tq[1] - 511;
    hi[0] = tq[0]; hi[1] = tq[1];
    const int j0 = c >= 8 ? c - 8 : 0;
    for (int j = j0; j <= c; ++j) {
      __syncthreads();
      load_tile64(Kl, KW + (size_t)j * 64 * 128, 128, tid);
      load_tile64(Vl, VWT + j * 64, 4096, tid);
      __syncthreads();
      qk_tile(Kl, qf, S, r, h);
      softmax_tile(S, j * 64, lo, hi, m, l, O, h);
      pv_tile(Vl, S, O, r, h);
    }
#pragma unroll
    for (int qt = 0; qt < 2; ++qt) {
      const float lt = l[qt] + __shfl_xor(l[qt], 32);
      const float sc = gate[qt][2] / lt;
#pragma unroll
      for (int dt = 0; dt < 2; ++dt)
#pragma unroll
        for (int ip = 0; ip < 8; ++ip) {
          const unsigned pr = stash[((dt * 2 + qt) * 8 + ip) * 256 + tid];
          O[dt][qt][2 * ip] = bflo(pr) + sc * O[dt][qt][2 * ip];
          O[dt][qt][2 * ip + 1] = bfhi(pr) + sc * O[dt][qt][2 * ip + 1];
        }
    }
  }
  {
    const bf16_t* ZN = (const bf16_t*)(p.ws + OFF_ZN);
    bf16_t* MIX = (bf16_t*)(p.ws + OFF_MIX);
#pragma unroll
    for (int qt = 0; qt < 2; ++qt) {
      const size_t tok = tok0 + qt * 32 + r;
#pragma unroll
      for (int dt = 0; dt < 2; ++dt)
#pragma unroll
        for (int gi = 0; gi < 4; ++gi) {
          const int d = dt * 32 + 8 * gi + 4 * h;
          const u32x2 z = *(const u32x2*)(ZN + tok * 512 + hd * 64 + d);
          u32x2 o;
          o[0] = pack2(O[dt][qt][4 * gi + 0] * bflo(z[0]), O[dt][qt][4 * gi + 1] * bfhi(z[0]));
          o[1] = pack2(O[dt][qt][4 * gi + 2] * bflo(z[1]), O[dt][qt][4 * gi + 3] * bfhi(z[1]));
          *(u32x2*)(MIX + tok * 1024 + hd * 64 + d) = o;
        }
    }
  }
  __syncthreads();
}

DI void phase3(const Params& p, char* smem) {
  const int G = gridDim.x;
  for (int k = 0; k * G < 2048; ++k) {
    const int i = (k & 1) ? (G - 1 - (int)blockIdx.x) : (int)blockIdx.x;
    const int idx = k * G + i;
    if (idx < 2048) {
      const int c = 63 - (idx >> 5), bgi = idx & 31;
      attn_item(p, smem, c, bgi >> 1, bgi & 1);
    }
  }
}

DI void phase4_item(const Params& p, char* smem, int mt) {
  const int tid = threadIdx.x, lane = tid & 63, wave = tid >> 6, wm = wave >> 1, wn = wave & 1;
  const int r = lane & 31, h = lane >> 5;
  const bf16_t* MIX = (const bf16_t*)(p.ws + OFF_MIX);
  const bf16_t* WT = (const bf16_t*)(p.ws + OFF_WTOUT);
  float* rowss = (float*)(smem + 73728);
  const int m0 = mt * 128;
  if (tid < 128) rowss[tid] = 0.f;
  float ss[2][16];
#pragma unroll
  for (int a = 0; a < 2; ++a)
#pragma unroll
    for (int i = 0; i < 16; ++i) ss[a][i] = 0.f;
  for (int nt = 0; nt < 8; ++nt) {
    f32x16 acc[2][2];
#pragma unroll
    for (int a = 0; a < 2; ++a)
#pragma unroll
      for (int b = 0; b < 2; ++b)
#pragma unroll
        for (int i = 0; i < 16; ++i) acc[a][b][i] = 0.f;
    gemm_mainloop(MIX + (size_t)m0 * 1024, 1024, WT + (size_t)nt * 128 * 1024, 1024, 1024, smem, acc);
#pragma unroll
    for (int rt = 0; rt < 2; ++rt)
#pragma unroll
      for (int ct = 0; ct < 2; ++ct) {
        const int n = nt * 128 + wn * 64 + ct * 32 + r;
#pragma unroll
        for (int i = 0; i < 16; ++i) {
          const size_t m = (size_t)m0 + wm * 64 + rt * 32 + crow(i, h);
          const float v = acc[rt][ct][i] + p.x[m * 1024 + n];
          p.out[m * 1024 + n] = v;
          ss[rt][i] += v * v;
        }
      }
  }
#pragma unroll
  for (int rt = 0; rt < 2; ++rt)
#pragma unroll
    for (int i = 0; i < 16; ++i) {
      float v = ss[rt][i];
#pragma unroll
      for (int o = 16; o >= 1; o >>= 1) v += __shfl_xor(v, o);
      if (r == 0) __hip_atomic_fetch_add(rowss + wm * 64 + rt * 32 + crow(i, h), v, __ATOMIC_RELAXED, __HIP_MEMORY_SCOPE_WORKGROUP);
    }
  __threadfence();
  __syncthreads();
  for (int rr = 0; rr < 32; ++rr) {
    const int row = wave * 32 + rr;
    const float rstd = rsqrtf(rowss[row] * (1.f / 1024.f) + 1e-6f);
    float4* orow = (float4*)(p.out + ((size_t)m0 + row) * 1024);
#pragma unroll
    for (int i = 0; i < 4; ++i) {
      float4 v = orow[i * 64 + lane];
      const float4 g = ((const float4*)p.norm_f_g)[i * 64 + lane];
      v.x *= rstd * g.x; v.y *= rstd * g.y; v.z *= rstd * g.z; v.w *= rstd * g.w;
      orow[i * 64 + lane] = v;
    }
  }
  __syncthreads();
}

__global__ void __launch_bounds__(256, 1) nsa_gmlp_megakernel(Params p) {
  __shared__ __attribute__((aligned(16))) char smem[SMEM_BYTES];
  cg::grid_group grid = cg::this_grid();
  phase0(p);
  grid.sync();
  phase1(p, smem);
  grid.sync();
  for (int it = blockIdx.x; it < 512; it += gridDim.x) compress_item(p, smem, it);
  for (int it = blockIdx.x; it < 4096; it += gridDim.x) gmlp_item(p, smem, it);
  grid.sync();
  phase3(p, smem);
  grid.sync();
  for (int mt = blockIdx.x; mt < 512; mt += gridDim.x) phase4_item(p, smem, mt);
}

extern "C" void kernel_launch(void* const* d_in, const int* in_sizes, int n_in, void* d_out, int out_size, void* d_ws,
                              size_t ws_size, hipStream_t stream) {
  static int grid_blocks = 0;
  if (!grid_blocks) {
    int dev = 0, cus = 0, per_cu = 0;
    hipGetDevice(&dev);
    hipDeviceGetAttribute(&cus, hipDeviceAttributeMultiprocessorCount, dev);
    hipOccupancyMaxActiveBlocksPerMultiprocessor(&per_cu, nsa_gmlp_megakernel, 256, 0);
    if (per_cu > 2) per_cu = 2;
    if (per_cu < 1) per_cu = 1;
    grid_blocks = cus * per_cu;
    grid_blocks -= grid_blocks % 8;
  }
  Params p{};
  p.x = (const float*)d_in[0];
  p.norm_in_g = (const float*)d_in[1];
  p.w_in = (const float*)d_in[2];
  p.w_k1 = (const float*)d_in[3];
  p.w_k2 = (const float*)d_in[4];
  p.pe_k = (const float*)d_in[5];
  p.w_v1 = (const float*)d_in[6];
  p.w_v2 = (const float*)d_in[7];
  p.pe_v = (const float*)d_in[8];
  p.ln_g = (const float*)d_in[9];
  p.ln_b = (const float*)d_in[10];
  p.w_sp = (const float*)d_in[11];
  p.b_sp = (const float*)d_in[12];
  p.w_out = (const float*)d_in[13];
  p.norm_f_g = (const float*)d_in[14];
  p.out = (float*)d_out;
  p.ws = (char*)d_ws;
  void* args[] = {&p};
  hipError_t e = hipLaunchCooperativeKernel((void*)nsa_gmlp_megakernel, dim3(grid_blocks), dim3(256), args, 0, stream);
  if (e != hipSuccess) fprintf(stderr, "cooperative launch failed: %s (grid %d)\n", hipGetErrorString(e), grid_blocks);
}
```

```cpp
#include <hip/hip_runtime.h>
#include <hip/hip_cooperative_groups.h>
#include <cstdio>
namespace cg = cooperative_groups;

#define DI __device__ __forceinline__
typedef unsigned short bf16_t;
typedef unsigned long long u64;
typedef __attribute__((ext_vector_type(8))) short s16x8;
typedef __attribute__((ext_vector_type(4))) short s16x4;
typedef __attribute__((ext_vector_type(16))) float f32x16;
typedef __attribute__((ext_vector_type(4))) unsigned u32x4;
typedef __attribute__((ext_vector_type(2))) unsigned u32x2;
typedef __bf16 bf2_t __attribute__((ext_vector_type(2)));
typedef float f2_t __attribute__((ext_vector_type(2)));

#define MFMA32(a, b, c) __builtin_amdgcn_mfma_f32_32x32x16_bf16((a), (b), (c), 0, 0, 0)

constexpr int NTOK = 65536;
constexpr int NTHR = 512;
constexpr int NPAD = 3584;
constexpr float L2E = 1.4426950408889634f;

constexpr size_t OFF_HN    = 0;
constexpr size_t OFF_WTIN  = OFF_HN    + (size_t)NTOK * 1024 * 2;
constexpr size_t OFF_WTOUT = OFF_WTIN  + (size_t)NPAD * 1024 * 2;
constexpr size_t OFF_W1TK  = OFF_WTOUT + (size_t)1024 * 1024 * 2;
constexpr size_t OFF_W1TV  = OFF_W1TK  + (size_t)128 * 2048 * 2;
constexpr size_t OFF_BIAS  = OFF_W1TV  + (size_t)128 * 2048 * 2;
constexpr size_t OFF_WSP   = OFF_BIAS  + 1024;
constexpr size_t OFF_Q     = OFF_WSP   + (size_t)8 * 128 * 128 * 2;
constexpr size_t OFF_KC    = OFF_Q     + (size_t)NTOK * 512 * 2;
constexpr size_t OFF_VC    = OFF_KC    + (size_t)NTOK * 128 * 2;
constexpr size_t OFF_KS    = OFF_VC    + (size_t)NTOK * 128 * 2;
constexpr size_t OFF_KW    = OFF_KS    + (size_t)NTOK * 128 * 2;
constexpr size_t OFF_VST   = OFF_KW    + (size_t)NTOK * 128 * 2;
constexpr size_t OFF_VWT   = OFF_VST   + (size_t)NTOK * 128 * 2;
constexpr size_t OFF_ZN    = OFF_VWT   + (size_t)NTOK * 128 * 2;
constexpr size_t OFF_U     = OFF_ZN    + (size_t)NTOK * 512 * 2;
constexpr size_t OFF_V     = OFF_U     + (size_t)NTOK * 512 * 2;
constexpr size_t OFF_ZG    = OFF_V     + (size_t)NTOK * 512 * 2;
constexpr size_t OFF_GATES = OFF_ZG    + (size_t)NTOK * 512 * 2;
constexpr size_t OFF_KCMP  = OFF_GATES + (size_t)NTOK * 24 * 4;
constexpr size_t OFF_VCMPT = OFF_KCMP  + (size_t)32 * 256 * 64 * 2;
constexpr size_t OFF_MIX   = OFF_VCMPT + (size_t)32 * 256 * 64 * 2;
constexpr size_t OFF_SMALL = OFF_MIX   + (size_t)NTOK * 1024 * 2;
constexpr int SM_LNG = 0, SM_LNB = 512, SM_BSP = 1024, SM_W2K = 2048, SM_W2V = 2048 + 8192, SM_NFG = 2048 + 16384, SM_TOTAL = 2048 + 16384 + 1024;
constexpr size_t OFF_ROWSS = OFF_SMALL + (size_t)SM_TOTAL * 4;
constexpr size_t OFF_BAR   = OFF_ROWSS + (size_t)NTOK * 4;
constexpr size_t OFF_XBAR  = OFF_BAR + 256;
constexpr size_t OFF_PCNT  = OFF_XBAR + 3456 * 4;
constexpr size_t WS_END    = OFF_PCNT + 256 * 4;

constexpr int SMEM_BYTES = 135168;

struct Params {
  const float *x, *norm_in_g, *w_in, *w_k1, *w_k2, *pe_k, *w_v1, *w_v2, *pe_v, *ln_g, *ln_b, *w_sp, *b_sp, *w_out, *norm_f_g;
  float* out;
  char* ws;
};

DI unsigned pack2(float a, float b) {
  f2_t v = {a, b};
  bf2_t r = __builtin_convertvector(v, bf2_t);
  return __builtin_bit_cast(unsigned, r);
}
DI bf16_t f2bf(float a) { return (bf16_t)(pack2(a, 0.f) & 0xffffu); }
DI float bflo(unsigned u) { return __uint_as_float(u << 16); }
DI float bfhi(unsigned u) { return __uint_as_float(u & 0xffff0000u); }
DI float shx(float v, int mask, int lane) {
  return __builtin_bit_cast(float, __builtin_amdgcn_ds_bpermute((lane ^ mask) << 2, __builtin_bit_cast(int, v)));
}
DI unsigned shxu(unsigned v, int mask, int lane) {
  return (unsigned)__builtin_amdgcn_ds_bpermute((lane ^ mask) << 2, (int)v);
}
DI float wave_sum(float v, int lane) {
#pragma unroll
  for (int o = 32; o >= 1; o >>= 1) v += shx(v, o, lane);
  return v;
}
DI float gelu_t(float x) {
  const float y2 = x * __builtin_fmaf(0.044715f, x * x, 1.0f) * (-2.0f * 0.7978845608028654f * 1.4426950408889634f);
  return x * __builtin_amdgcn_rcpf(1.0f + __builtin_amdgcn_exp2f(y2));
}
DI float sigmoid_f(float x) { return __builtin_amdgcn_rcpf(1.0f + __builtin_amdgcn_exp2f(-1.4426950408889634f * x)); }
DI float silu_f(float x) { return x * __builtin_amdgcn_rcpf(1.0f + __builtin_amdgcn_exp2f(-1.4426950408889634f * x)); }
typedef float f2a __attribute__((ext_vector_type(2)));
DI f2a gelu2(f2a x) {
  const f2a t = x * x * 0.044715f + 1.0f;
  const f2a y2 = x * t * (-2.0f * 0.7978845608028654f * 1.4426950408889634f);
  f2a e = {__builtin_amdgcn_exp2f(y2.x), __builtin_amdgcn_exp2f(y2.y)};
  e = e + 1.0f;
  const f2a rinv = {__builtin_amdgcn_rcpf(e.x), __builtin_amdgcn_rcpf(e.y)};
  return x * rinv;
}
DI f2a silu2(f2a x) {
  const f2a a = x * (-1.4426950408889634f);
  f2a e = {__builtin_amdgcn_exp2f(a.x), __builtin_amdgcn_exp2f(a.y)};
  e = e + 1.0f;
  const f2a rinv = {__builtin_amdgcn_rcpf(e.x), __builtin_amdgcn_rcpf(e.y)};
  return x * rinv;
}
DI unsigned pack2v(f2a v) { return pack2(v.x, v.y); }
DI float xhalf_max(float v) {
  const auto r_ = __builtin_amdgcn_permlane32_swap(__float_as_uint(v), __float_as_uint(v), false, false);
  return fmaxf(__uint_as_float(r_[0]), __uint_as_float(r_[1]));
}
DI float xhalf_sum(float v) {
  const auto r_ = __builtin_amdgcn_permlane32_swap(__float_as_uint(v), __float_as_uint(v), false, false);
  return __uint_as_float(r_[0]) + __uint_as_float(r_[1]);
}
DI int crow(int i, int h) { return (i & 3) + 8 * (i >> 2) + 4 * h; }
DI int opaque_tid() { int t = threadIdx.x; asm volatile("" : "+v"(t)); return t; }
DI int opaque_tid_w(int wid_s) {
  int t = (wid_s << 6) | (int)__builtin_amdgcn_mbcnt_hi(~0u, __builtin_amdgcn_mbcnt_lo(~0u, 0u));
  asm volatile("" : "+v"(t));
  return t;
}

#define XB_TMO      128
#define XB_XCNT(j)  (256  + 64 * (j))
#define XB_XSUB(j)  (1280 + 64 * (j))
#define XB_XGEN(j)  (2304 + 64 * (j))
#define XB_TOP      3328
#define XB_TOPGEN   3392
#define XCD_BAR_WORDS 3456
#define XB_SPIN_CAP (1u << 18)
#define XB_LAS __attribute__((address_space(3)))

__device__ __forceinline__ unsigned xb_ld(unsigned* p)              { return __hip_atomic_load(p, __ATOMIC_RELAXED, __HIP_MEMORY_SCOPE_AGENT); }
__device__ __forceinline__ unsigned xb_add(unsigned* p, unsigned v) { return __hip_atomic_fetch_add(p, v, __ATOMIC_RELAXED, __HIP_MEMORY_SCOPE_AGENT); }
__device__ __forceinline__ unsigned xb_xcc_id() { return (unsigned)__builtin_amdgcn_s_getreg((3 << 11) | 20) & 0xFu; }
#define XB_SPIN(cond, bar) do { unsigned _sp = 0; while (cond) { __builtin_amdgcn_s_sleep(1); \
    if ((++_sp & 255u) == 0u) { if (xb_ld(&(bar)[XB_TMO])) break; if (_sp > XB_SPIN_CAP) { atomicAdd(&(bar)[XB_TMO], 1u); break; } } } } while (0)

struct XcdBarrier {
    unsigned* bar; unsigned x;
    volatile XB_LAS unsigned* st;
};

__device__ __forceinline__ XcdBarrier xcd_barrier_post(unsigned* bar, volatile XB_LAS unsigned* st) {
    XcdBarrier b; b.bar = bar; b.x = xb_xcc_id(); b.st = st;
    if (threadIdx.x == 0) (void)xb_add(&bar[XB_XCNT(b.x)], 1u);
    return b;
}
__device__ __forceinline__ void xcd_barrier_complete(unsigned* bar, unsigned x, unsigned& nloc, unsigned& nx) {
    const unsigned G = gridDim.x * gridDim.y * gridDim.z;
    unsigned sum, cnt, mine, sp = 0u;
    for (;;) {
        sum = 0u; cnt = 0u; mine = 0u;
#pragma unroll
        for (unsigned j = 0; j < 16; ++j) { const unsigned c = xb_ld(&bar[XB_XCNT(j)]); sum += c; cnt += (c > 0u) ? 1u : 0u; mine = (j == x) ? c : mine; }
        if (sum == G) break;
        __builtin_amdgcn_s_sleep(1);
        if ((++sp & 255u) == 0u) { if (xb_ld(&bar[XB_TMO])) break; if (sp > XB_SPIN_CAP) { atomicAdd(&bar[XB_TMO], 1u); break; } }
    }
    nloc = mine > 0u ? mine : 1u; nx = cnt > 0u ? cnt : 1u;
}

__device__ __forceinline__ void xcd_barrier(const XcdBarrier& b) {
    asm volatile("s_waitcnt vmcnt(0)" ::: "memory");
    __syncthreads();
    if (threadIdx.x == 0) {
        unsigned* bar = b.bar;
        __builtin_amdgcn_s_waitcnt(0);
        unsigned nloc = b.st[0], nx = b.st[1];
        if (nloc == 0u) { xcd_barrier_complete(bar, b.x, nloc, nx); b.st[0] = nloc; b.st[1] = nx; }
        const unsigned old = xb_add(&bar[XB_XSUB(b.x)], 1u);
        const unsigned gen = old / nloc;
        if (old + 1u == (gen + 1u) * nloc) {
            __builtin_amdgcn_fence(__ATOMIC_RELEASE, "agent");
            asm volatile("s_waitcnt vmcnt(0)" ::: "memory");
            const unsigned og = xb_add(&bar[XB_TOP], 1u);
            const unsigned tg = og / nx;
            if (og + 1u == (tg + 1u) * nx) xb_add(&bar[XB_TOPGEN], 1u);
            else XB_SPIN(xb_ld(&bar[XB_TOPGEN]) == tg, bar);
            __builtin_amdgcn_fence(__ATOMIC_ACQUIRE, "agent");
            xb_add(&bar[XB_XGEN(b.x)], 1u);
            asm volatile("s_waitcnt vmcnt(0)" ::: "memory");
        } else {
            XB_SPIN(xb_ld(&bar[XB_XGEN(b.x)]) == gen, bar);
            __builtin_amdgcn_fence(__ATOMIC_ACQUIRE, "agent");
            asm volatile("s_waitcnt vmcnt(0)" ::: "memory");
        }
    }
    __syncthreads();
}

DI void grid_bar(unsigned* ctr, unsigned target, bool leader) {
  asm volatile("s_waitcnt vmcnt(0) lgkmcnt(0)" ::: "memory");
  __syncthreads();
  if (leader) {
    __builtin_amdgcn_fence(__ATOMIC_RELEASE, "agent");
    asm volatile("s_waitcnt vmcnt(0)" ::: "memory");
    __hip_atomic_fetch_add(ctr, 1u, __ATOMIC_RELAXED, __HIP_MEMORY_SCOPE_AGENT);
    while (__hip_atomic_load(ctr, __ATOMIC_RELAXED, __HIP_MEMORY_SCOPE_AGENT) < target) __builtin_amdgcn_s_sleep(2);
    __builtin_amdgcn_fence(__ATOMIC_ACQUIRE, "agent");
    asm volatile("s_waitcnt vmcnt(0)" ::: "memory");
  }
  __syncthreads();
}

DI void transpose_w(const float* __restrict__ src, int src_ld, bf16_t* __restrict__ dst, int Np, int K, int mode,
                    int gtid, int gthreads) {
  const int nchunks = K >> 3;
  const long total = (long)nchunks * Np;
  for (long id = gtid; id < total; id += gthreads) {
    const int n = (int)(id % Np), kc = (int)(id / Np);
    int sn = n;
    if (mode == 1) {
      if (n < 1280) sn = n;
      else if (n < 3328) sn = n + 24;
      else if (n < 3352) sn = n - 3328 + 1280;
      else sn = -1;
    }
    u32x4 o = {0u, 0u, 0u, 0u};
    if (sn >= 0) {
      float f[8];
#pragma unroll
      for (int j = 0; j < 8; ++j) f[j] = src[(size_t)(kc * 8 + j) * src_ld + sn];
      o[0] = pack2(f[0], f[1]); o[1] = pack2(f[2], f[3]); o[2] = pack2(f[4], f[5]); o[3] = pack2(f[6], f[7]);
    }
    *(u32x4*)(dst + (size_t)n * K + kc * 8) = o;
  }
}

DI void phase0(const Params& p) {
  const int tid = opaque_tid(), lane = tid & 63, wave = tid >> 6;
  const int gthreads = gridDim.x * NTHR, gtid = blockIdx.x * NTHR + tid;
  const int gwaves = gridDim.x * 8, gwave = blockIdx.x * 8 + wave;
  bf16_t* HN = (bf16_t*)(p.ws + OFF_HN);
  for (int row = gwave; row < NTOK; row += gwaves) {
    const float4* xr = (const float4*)(p.x + (size_t)row * 1024);
    float4 v[4];
    float ss = 0.f;
#pragma unroll
    for (int i = 0; i < 4; ++i) {
      v[i] = xr[i * 64 + lane];
      ss += v[i].x * v[i].x + v[i].y * v[i].y + v[i].z * v[i].z + v[i].w * v[i].w;
    }
    ss = wave_sum(ss, lane);
    const float rstd = rsqrtf(ss * (1.f / 1024.f) + 1e-6f);
#pragma unroll
    for (int i = 0; i < 4; ++i) {
      const float4 g = ((const float4*)p.norm_in_g)[i * 64 + lane];
      u32x2 o;
      o[0] = pack2(v[i].x * rstd * g.x, v[i].y * rstd * g.y);
      o[1] = pack2(v[i].z * rstd * g.z, v[i].w * rstd * g.w);
      *(u32x2*)(HN + (size_t)row * 1024 + (i * 64 + lane) * 4) = o;
    }
  }
  transpose_w(p.w_in, 3352, (bf16_t*)(p.ws + OFF_WTIN), NPAD, 1024, 1, gtid, gthreads);
  transpose_w(p.w_out, 1024, (bf16_t*)(p.ws + OFF_WTOUT), 1024, 1024, 0, gtid, gthreads);
  transpose_w(p.w_k1, 128, (bf16_t*)(p.ws + OFF_W1TK), 128, 2048, 0, gtid, gthreads);
  transpose_w(p.w_v1, 128, (bf16_t*)(p.ws + OFF_W1TV), 128, 2048, 0, gtid, gthreads);
  float* BIAS = (float*)(p.ws + OFF_BIAS);
  for (int it = gwave; it < 256; it += gwaves) {
    const int kv = it >> 7, e = it & 127;
    const float* w1 = kv ? p.w_v1 : p.w_k1;
    const float* pe = kv ? p.pe_v : p.pe_k;
    float s = 0.f;
    for (int kk = lane; kk < 2048; kk += 64) s += pe[kk] * w1[(size_t)kk * 128 + e];
    s = wave_sum(s, lane);
    if (lane == 0) BIAS[it] = s;
  }
  if (gtid == 0) *(unsigned*)(p.ws + OFF_BAR) = 0u;
  {
    float* RS = (float*)(p.ws + OFF_ROWSS);
    for (int id = gtid; id < NTOK; id += gthreads) RS[id] = 0.f;
    if (gtid < 256) ((unsigned*)(p.ws + OFF_PCNT))[gtid] = 0u;
  }
  {
    float* SMALL = (float*)(p.ws + OFF_SMALL);
    for (int id = gtid; id < SM_TOTAL; id += gthreads) {
      float v;
      if (id < SM_LNB) v = p.ln_g[id - SM_LNG];
      else if (id < SM_BSP) v = p.ln_b[id - SM_LNB];
      else if (id < SM_W2K) v = p.b_sp[id - SM_BSP];
      else if (id < SM_W2V) v = p.w_k2[id - SM_W2K];
      else if (id < SM_NFG) v = p.w_v2[id - SM_W2V];
      else v = p.norm_f_g[id - SM_NFG];
      SMALL[id] = v;
    }
  }
  bf16_t* WSP = (bf16_t*)(p.ws + OFF_WSP);
  for (int id = gtid; id < 8 * 128 * 128; id += gthreads) {
    const int t = (id >> 7) & 127, s = id & 127;
    WSP[id] = (s <= t) ? f2bf(p.w_sp[id]) : (bf16_t)0;
  }
}

namespace pg8 {
#define PG8_LAS __attribute__((address_space(3)))
typedef unsigned short bf16_t;
typedef short bf16x8 __attribute__((ext_vector_type(8)));
typedef float f32x4 __attribute__((ext_vector_type(4)));
typedef unsigned u32x4 __attribute__((ext_vector_type(4)));
constexpr int BM = 256, BK = 64, HALF = 128, HTB = HALF * BK * 2  , STAGE_BYTES = 8 * HTB, NXCD = 8, WGM = 4;

__host__ __device__ __forceinline__ int lds_byte(int r, int c) { const int st = (r >> 4) * 2 + (c >> 5), rr = r & 15, cc = c & 31, ob = rr * 64 + cc * 2; return st * 1024 + (ob ^ (((ob >> 9) & 1) << 5)); }
__host__ __device__ __forceinline__ void stage_rc(int b, int& R, int& C) { const int st = b / 1024, sb = b % 1024, swz = sb ^ (((sb >> 9) & 1) << 5); R = (st >> 1) * 16 + swz / 64; C = (st & 1) * 32 + (swz % 64) / 2; }
__host__ __device__ __forceinline__ int perm32(int rho) { const int n = rho >> 4, i = rho & 15; return 8 * (i >> 2) + 4 * n + (i & 3); }

struct Unit { int pm, pn; };
struct Gemm { const bf16_t* A; const bf16_t* Bt; int M, N, K; };

struct StaticOrder {
    int nM, nN, nwg, G, c;
    __host__ __device__ void init(int M, int N, int G_, int c_) { nM = M / BM; nN = N / BM; nwg = nM * nN; G = G_; c = c_; }
    __host__ __device__ bool next(int i, Unit& u) const {
        const long L = (long)i * G + c; if (L >= nwg) return false;
        int wgid = (int)L; { const int q = nwg / NXCD, r = nwg % NXCD, xcd = wgid % NXCD, off = wgid / NXCD; wgid = (xcd < r ? xcd * (q + 1) : r * (q + 1) + (xcd - r) * q) + off; }
        const int nig = WGM * nN, gid = wgid / nig, fm = gid * WGM, gsz = (nM - fm) < WGM ? (nM - fm) : WGM;
        u.pm = fm + ((wgid % nig) % gsz); u.pn = (wgid % nig) / gsz; return true;
    }
    __device__ __forceinline__ void a_ready(const Unit&) const {}
    __device__ __forceinline__ void done(const Unit&) const {}
};

template <class Epi, class Sched, bool STAMP = false>
__device__ __forceinline__ void gemm_phase(PG8_LAS unsigned char* lds, const Gemm g, const Sched& S, const Epi& E, unsigned long long* stamps, const int tid_in) {
    const int tid = tid_in, wid = __builtin_amdgcn_readfirstlane(tid >> 6), lane = tid & 63, wr = wid >> 2, wc = wid & 3, fr = lane & 15, fq = lane >> 4;
    const int K = g.K, nt = K / BK;
    int ts_lo = 0, ts_hi = 0, nts = 0; const unsigned long long rt_entry = STAMP ? (unsigned long long)wall_clock64() : 0ull;
#define PG8_STAMP() do { if (STAMP && wid == 0 && nts < 64) { const unsigned long long _c = (unsigned long long)clock64(); \
        ts_lo = (lane == nts) ? (int)(unsigned)_c : ts_lo; ts_hi = (lane == nts) ? (int)(unsigned)(_c >> 32) : ts_hi; ++nts; } } while (0)
    PG8_STAMP();
    unsigned voffA[2], voffB[2];
#pragma unroll
    for (int i = 0; i < 2; ++i) { int R, C; stage_rc(tid * 16 + i * 8192, R, C); const int Rb = Epi::PERM ? ((R & ~31) + perm32(R & 31)) : R;
        voffA[i] = (unsigned)(R * K + C) * 2u; voffB[i] = (unsigned)(Rb * K + C) * 2u; }
    const size_t kstep = (size_t)(BK * 2);
    const size_t hstep = (size_t)HALF * K * 2;
    const size_t tstep = 2 * hstep;
    const unsigned ldsw = (unsigned)wid * 1024u;
    const int aoff = lds_byte(wr * 64 + fr, fq * 8), boff = lds_byte(wc * 32 + fr, fq * 8);
#define PG8_SA(b, h) (((b) * 2 + (h)) * HTB)
#define PG8_SB(b, h) ((4 + (b) * 2 + (h)) * HTB)
#define PG8_STAGE(bufoff, gbase, voff) do { _Pragma("unroll") for (int _i = 0; _i < 2; ++_i) \
        __builtin_amdgcn_global_load_lds((const unsigned*)((const char*)(gbase) + (voff)[_i]), (PG8_LAS unsigned*)(lds + (bufoff) + ldsw + _i * 8192), 16, 0, 0); } while (0)
#define PG8_LDA(dst, b, h) do { _Pragma("unroll") for (int m = 0; m < 4; ++m) _Pragma("unroll") for (int k = 0; k < 2; ++k) dst[m][k] = *(const PG8_LAS bf16x8*)(lds + PG8_SA(b, h) + aoff + m * 2048 + k * 1024); } while (0)
#define PG8_LDB(dst, b, h) do { _Pragma("unroll") for (int n = 0; n < 2; ++n) _Pragma("unroll") for (int k = 0; k < 2; ++k) dst[n][k] = *(const PG8_LAS bf16x8*)(lds + PG8_SB(b, h) + boff + n * 2048 + k * 1024); } while (0)
#define PG8_MMA(ai, bj, At, Bt) do { __builtin_amdgcn_s_setprio(1); _Pragma("unroll") for (int m = 0; m < 4; ++m) _Pragma("unroll") for (int n = 0; n < 2; ++n) _Pragma("unroll") for (int k = 0; k < 2; ++k) \
        acc[ai][bj][m][n] = __builtin_amdgcn_mfma_f32_16x16x32_bf16(Bt[n][k], At[m][k], acc[ai][bj][m][n], 0, 0, 0); __builtin_amdgcn_s_setprio(0); } while (0)
#define PG8_WAIT_V(n) asm volatile("s_waitcnt vmcnt(" #n ")" ::: "memory")
#define PG8_WAIT_L(n) asm volatile("s_waitcnt lgkmcnt(" #n ")" ::: "memory")
#define PG8_BAR __builtin_amdgcn_s_barrier()
#define PG8_SCHED __builtin_amdgcn_sched_barrier(0)
    Unit cur, nxt; int ui = 0;
    if (!S.next(0, cur)) return;
    f32x4 acc[2][2][4][2];
#pragma unroll
    for (int a = 0; a < 2; ++a)
#pragma unroll
        for (int b = 0; b < 2; ++b)
#pragma unroll
            for (int m = 0; m < 4; ++m)
#pragma unroll
                for (int n = 0; n < 2; ++n) acc[a][b][m][n] = (f32x4){0.f, 0.f, 0.f, 0.f};
    bf16x8 At[4][2], B0[2][2], B1[2][2];
    const char* cA = (const char*)g.A + (size_t)cur.pm * tstep; const char* cB = (const char*)g.Bt + (size_t)cur.pn * tstep;
    S.a_ready(cur);
    PG8_STAGE(PG8_SB(0, 0), cB, voffB); PG8_STAGE(PG8_SA(0, 0), cA, voffA); PG8_STAGE(PG8_SB(0, 1), cB + hstep, voffB); PG8_STAGE(PG8_SA(0, 1), cA + hstep, voffA);
    if (wr == 1) PG8_BAR;
    PG8_WAIT_V(4); PG8_BAR;
    PG8_STAGE(PG8_SB(1, 0), cB + kstep, voffB); PG8_STAGE(PG8_SA(1, 0), cA + kstep, voffA); PG8_STAGE(PG8_SB(1, 1), cB + hstep + kstep, voffB);
    PG8_WAIT_V(6); PG8_BAR;
    PG8_STAMP();
    for (;;) {
        const bool has_next = S.next(ui + 1, nxt);
        const char* nA = has_next ? (const char*)g.A + (size_t)nxt.pm * tstep : cA; const char* nB = has_next ? (const char*)g.Bt + (size_t)nxt.pn * tstep : cB;
        for (int t = 0; t < nt; t += 2) {
            const bool last = (t == nt - 2);
            const char* a1 = cA + (size_t)(t + 1) * kstep;
            const char* a2 = last ? nA : cA + (size_t)(t + 2) * kstep; const char* b2 = last ? nB : cB + (size_t)(t + 2) * kstep;
            const char* a3 = a2 + kstep; const char* b3 = b2 + kstep;
            if (last && has_next) S.a_ready(nxt);
            PG8_LDB(B0, 0, 0); PG8_SCHED; PG8_LDA(At, 0, 0); PG8_STAGE(PG8_SA(1, 1), a1 + hstep, voffA);
            PG8_WAIT_L(8); PG8_BAR; PG8_WAIT_L(0); PG8_MMA(0, 0, At, B0); PG8_BAR; PG8_SCHED;
            PG8_LDB(B1, 0, 1); PG8_STAGE(PG8_SB(0, 0), b2, voffB);
            PG8_BAR; PG8_WAIT_L(0); PG8_MMA(0, 1, At, B1); PG8_BAR;
            PG8_LDA(At, 0, 1); PG8_STAGE(PG8_SA(0, 0), a2, voffA);
            PG8_BAR; PG8_WAIT_L(0); PG8_MMA(1, 0, At, B0); PG8_BAR; PG8_SCHED;
            PG8_STAGE(PG8_SB(0, 1), b2 + hstep, voffB);
            PG8_WAIT_V(6); PG8_BAR; PG8_MMA(1, 1, At, B1); PG8_BAR;
            PG8_LDB(B0, 1, 0); PG8_SCHED; PG8_LDA(At, 1, 0); PG8_STAGE(PG8_SA(0, 1), a2 + hstep, voffA);
            PG8_WAIT_L(8); PG8_BAR; PG8_WAIT_L(0); PG8_MMA(0, 0, At, B0); PG8_BAR; PG8_SCHED;
            PG8_LDB(B1, 1, 1); PG8_STAGE(PG8_SB(1, 0), b3, voffB);
            PG8_BAR; PG8_WAIT_L(0); PG8_MMA(0, 1, At, B1); PG8_BAR;
            PG8_LDA(At, 1, 1); PG8_STAGE(PG8_SA(1, 0), a3, voffA);
            PG8_BAR; PG8_WAIT_L(0); PG8_MMA(1, 0, At, B0); PG8_BAR; PG8_SCHED;
            PG8_STAGE(PG8_SB(1, 1), b3 + hstep, voffB);
            PG8_WAIT_V(6); PG8_BAR; PG8_MMA(1, 1, At, B1); PG8_BAR;
        }
        PG8_STAMP();
        if constexpr (!Epi::AFTER_DRAIN) { E(acc, cur, wr, wc, fr, fq); S.done(cur); }
        PG8_STAMP();
        if (!has_next) break;
#pragma unroll
        for (int a = 0; a < 2; ++a)
#pragma unroll
            for (int b = 0; b < 2; ++b)
#pragma unroll
                for (int m = 0; m < 4; ++m)
#pragma unroll
                    for (int n = 0; n < 2; ++n) acc[a][b][m][n] = (f32x4){0.f, 0.f, 0.f, 0.f};
        cur = nxt; cA = nA; cB = nB; ++ui;
    }
    PG8_WAIT_V(0);
    if (wr == 0) PG8_BAR;
    PG8_BAR;
    if constexpr (Epi::AFTER_DRAIN) { E.fused(acc, cur, wr, wc, fr, fq, lds, wid, lane); S.done(cur); }
    PG8_STAMP();
    if (STAMP && wid == 0) { stamps[lane] = lane < nts ? (((unsigned long long)(unsigned)ts_hi << 32) | (unsigned)ts_lo) : 0ull;
        if (lane == 62) stamps[62] = rt_entry; if (lane == 63) stamps[63] = (unsigned long long)wall_clock64(); }
#undef PG8_STAMP
#undef PG8_SA
#undef PG8_SB
#undef PG8_STAGE
#undef PG8_LDA
#undef PG8_LDB
#undef PG8_MMA
#undef PG8_WAIT_V
#undef PG8_WAIT_L
#undef PG8_BAR
#undef PG8_SCHED
}
}

struct PanelOrder {
  int c, npn;
  __device__ bool next(int i, pg8::Unit& u) const { if (i >= npn) return false; u.pm = c; u.pn = i; return true; }
  __device__ __forceinline__ void a_ready(const pg8::Unit&) const {}
  __device__ __forceinline__ void done(const pg8::Unit&) const {}
};

struct EpiP1 {
  static constexpr bool PERM = true, AFTER_DRAIN = false;
  char* ws;
  __device__ __forceinline__ void operator()(const pg8::f32x4 (&acc)[2][2][4][2], const pg8::Unit& u, int wr, int wc, int fr, int fq) const {
#pragma unroll
    for (int bj = 0; bj < 2; ++bj) {
      const int nt = u.pn * 2 + bj;
      if (nt >= 27) continue;
      const int cn0 = wc * 32 + fq * 8;
      bf16_t* dst = nullptr;
      int ld = 512, colbase = 0, act = 0;
      bool transposed = false;
      if (nt < 4) { dst = (bf16_t*)(ws + OFF_Q); colbase = nt * 128; act = 1; }
      else if (nt == 4) { dst = (bf16_t*)(ws + OFF_KC); ld = 128; }
      else if (nt == 5) { dst = (bf16_t*)(ws + OFF_VC); ld = 128; }
      else if (nt == 6) { dst = (bf16_t*)(ws + OFF_KS); ld = 128; }
      else if (nt == 7) { dst = (bf16_t*)(ws + OFF_VST); transposed = true; }
      else if (nt == 8) { dst = (bf16_t*)(ws + OFF_KW); ld = 128; }
      else if (nt == 9) { dst = (bf16_t*)(ws + OFF_VWT); transposed = true; }
      else if (nt < 14) { dst = (bf16_t*)(ws + OFF_ZN); colbase = (nt - 10) * 128; }
      else if (nt < 18) { dst = (bf16_t*)(ws + OFF_U); colbase = (nt - 14) * 128; }
      else if (nt < 22) { dst = (bf16_t*)(ws + OFF_V); colbase = (nt - 18) * 128; }
      else if (nt < 26) { dst = (bf16_t*)(ws + OFF_ZG); colbase = (nt - 22) * 128; }
#pragma unroll
      for (int ai = 0; ai < 2; ++ai)
#pragma unroll
        for (int m = 0; m < 4; ++m) {
          const int row = u.pm * 256 + ai * 128 + wr * 64 + m * 16 + fr;
          float v[8];
#pragma unroll
          for (int j = 0; j < 4; ++j) { v[j] = acc[ai][bj][m][0][j]; v[4 + j] = acc[ai][bj][m][1][j]; }
          if (nt == 26) {
            if (cn0 < 24) {
              float* G = (float*)(ws + OFF_GATES) + (size_t)row * 24 + cn0;
              float4 g0, g1;
              g0.x = sigmoid_f(v[0]); g0.y = sigmoid_f(v[1]); g0.z = sigmoid_f(v[2]); g0.w = sigmoid_f(v[3]);
              g1.x = sigmoid_f(v[4]); g1.y = sigmoid_f(v[5]); g1.z = sigmoid_f(v[6]); g1.w = sigmoid_f(v[7]);
              *(float4*)G = g0;
              *(float4*)(G + 4) = g1;
            }
          } else if (transposed) {
            const int b = row >> 12, t = row & 4095;
            bf16_t* dp = dst + ((size_t)((b * 2 + (cn0 >> 6)) * 64 + (cn0 & 63))) * 4096 + t;
#pragma unroll
            for (int j = 0; j < 8; ++j) dp[(size_t)j * 4096] = f2bf(v[j]);
          } else {
            if (act == 1) {
#pragma unroll
              for (int j = 0; j < 8; ++j) v[j] *= 0.125f;
            } else if (act == 2) {
#pragma unroll
              for (int j = 0; j < 8; ++j) v[j] = silu_f(v[j]);
            } else if (act == 3) {
#pragma unroll
              for (int j = 0; j < 8; ++j) v[j] = gelu_t(v[j]);
            }
            u32x4 o;
            o[0] = pack2(v[0], v[1]); o[1] = pack2(v[2], v[3]); o[2] = pack2(v[4], v[5]); o[3] = pack2(v[6], v[7]);
            *(u32x4*)(dst + (size_t)row * ld + colbase + cn0) = o;
          }
          __builtin_amdgcn_sched_barrier(0);
        }
    }
  }
};

struct EpiP4 {
  static constexpr bool PERM = true, AFTER_DRAIN = false;
  const float* x;
  bf16_t* hb;
  float* rowss;
  __device__ __forceinline__ void operator()(const pg8::f32x4 (&acc)[2][2][4][2], const pg8::Unit& u, int wr, int wc, int fr_in, int fq) const {
    int fr = fr_in;
    asm volatile("" : "+v"(fr));
    int pm_ = u.pm;
    asm volatile("" : "+s"(pm_));
#pragma unroll
    for (int ai = 0; ai < 2; ++ai)
#pragma unroll
      for (int m = 0; m < 4; ++m) {
        const int rl = ai * 128 + wr * 64 + m * 16 + fr;
        const size_t rowoff = ((size_t)pm_ * 256 + rl) * 1024;
        float4 xv[2][2];
#pragma unroll
        for (int bj = 0; bj < 2; ++bj) {
          const int col = u.pn * 256 + bj * 128 + wc * 32 + fq * 8;
          xv[bj][0] = *(const float4*)(x + rowoff + col);
          xv[bj][1] = *(const float4*)(x + rowoff + col + 4);
        }
        float ss = 0.f;
#pragma unroll
        for (int bj = 0; bj < 2; ++bj) {
          const int col = u.pn * 256 + bj * 128 + wc * 32 + fq * 8;
          float v[8];
          v[0] = acc[ai][bj][m][0][0] + xv[bj][0].x; v[1] = acc[ai][bj][m][0][1] + xv[bj][0].y;
          v[2] = acc[ai][bj][m][0][2] + xv[bj][0].z; v[3] = acc[ai][bj][m][0][3] + xv[bj][0].w;
          v[4] = acc[ai][bj][m][1][0] + xv[bj][1].x; v[5] = acc[ai][bj][m][1][1] + xv[bj][1].y;
          v[6] = acc[ai][bj][m][1][2] + xv[bj][1].z; v[7] = acc[ai][bj][m][1][3] + xv[bj][1].w;
#pragma unroll
          for (int j = 0; j < 8; ++j) ss += v[j] * v[j];
          u32x4 o;
          o[0] = pack2(v[0], v[1]); o[1] = pack2(v[2], v[3]); o[2] = pack2(v[4], v[5]); o[3] = pack2(v[6], v[7]);
          *(u32x4*)(hb + rowoff + col) = o;
        }
        ss += shx(ss, 16, fq * 16 + fr);
        ss += shx(ss, 32, fq * 16 + fr);
        if (fq == 0) __hip_atomic_fetch_add(rowss + (size_t)pm_ * 256 + rl, ss, __ATOMIC_RELAXED, __HIP_MEMORY_SCOPE_AGENT);
      }
  }
};

DI void compress_item(const Params& p, char* smem, int it, bool active) {
  const int tid = opaque_tid() & 255, lane = tid & 63, wave = tid >> 6;
  const int r = lane & 31, h = lane >> 5;
  const int kv = it >> 8, b = (it >> 4) & 15, g = (it >> 3) & 1, n0 = (it & 7) * 32;
  float* hidL = (float*)smem;
  if (active) {
    const bf16_t* src = (const bf16_t*)(p.ws + (kv ? OFF_VC : OFF_KC));
    const bf16_t* w1t = (const bf16_t*)(p.ws + (kv ? OFF_W1TV : OFF_W1TK));
    const float* bias = (const float*)(p.ws + OFF_BIAS) + kv * 128;
    f32x16 acc;
#pragma unroll
    for (int i = 0; i < 16; ++i) acc[i] = 0.f;
    const int n = n0 + r;
    const bf16_t* brow = w1t + (size_t)(32 * wave + r) * 2048 + h * 8;
#pragma unroll 2
    for (int l = 0; l < 32; ++l) {
      int tok = 16 * n + l;
      tok = tok > 4095 ? 4095 : tok;
      const bf16_t* arow = src + ((size_t)b * 4096 + tok) * 128 + g * 64 + h * 8;
#pragma unroll
      for (int s = 0; s < 4; ++s) {
        const s16x8 af = *(const s16x8*)(arow + s * 16);
        const s16x8 bfr = *(const s16x8*)(brow + l * 64 + s * 16);
        acc = MFMA32(af, bfr, acc);
      }
    }
    const int e = 32 * wave + r;
    const float be = bias[e];
#pragma unroll
    for (int i = 0; i < 16; ++i) hidL[crow(i, h) * 132 + e] = gelu_t(acc[i] + be);
  }
  __syncthreads();
  if (active) {
    const float* w2 = (const float*)(p.ws + OFF_SMALL) + (kv ? SM_W2V : SM_W2K);
    const int f = tid & 63, ng = tid >> 6;
    float o[8];
#pragma unroll
    for (int k = 0; k < 8; ++k) o[k] = 0.f;
    for (int e = 0; e < 128; ++e) {
      const float wv = w2[e * 64 + f];
#pragma unroll
      for (int k = 0; k < 8; ++k) o[k] += hidL[(ng * 8 + k) * 132 + e] * wv;
    }
    const int bg = b * 2 + g;
#pragma unroll
    for (int k = 0; k < 8; ++k) {
      const int nn = n0 + ng * 8 + k;
      const float val = (nn < 255) ? o[k] : 0.f;
      if (kv == 0) ((bf16_t*)(p.ws + OFF_KCMP))[((size_t)bg * 256 + nn) * 64 + f] = f2bf(val);
      else ((bf16_t*)(p.ws + OFF_VCMPT))[((size_t)bg * 64 + f) * 256 + nn] = f2bf(val);
    }
  }
  __syncthreads();
}

DI void gmlp_item(const Params& p, char* smem, int it, bool active) {
  const int tid = opaque_tid() & 255, lane = tid & 63, wave = tid >> 6;
  const int r = lane & 31, h = lane >> 5;
  const int gg = it & 7, ck = (it >> 3) & 31, b = it >> 8;
  const size_t tokbase = (size_t)b * 4096 + ck * 128;
  const bf16_t* V = (const bf16_t*)(p.ws + OFF_V);
  const bf16_t* U = (const bf16_t*)(p.ws + OFF_U);
  const bf16_t* ZG = (const bf16_t*)(p.ws + OFF_ZG);
  const bf16_t* WSP = (const bf16_t*)(p.ws + OFF_WSP);
  bf16_t* MIX = (bf16_t*)(p.ws + OFF_MIX);
  const float* SMALLP = (const float*)(p.ws + OFF_SMALL);
  char* vnT = smem;
  float* mxl = (float*)(smem + 17408);
  const int tl = tid >> 1, half = tid & 1, d0 = half * 32;
  u32x4 uu4[4], zz4[4];
  if (active) {
    const size_t off0 = (tokbase + tl) * 512 + gg * 64 + d0;
#pragma unroll
    for (int q = 0; q < 4; ++q) { uu4[q] = *(const u32x4*)(U + off0 + q * 8); zz4[q] = *(const u32x4*)(ZG + off0 + q * 8); }
  }
  if (active) {
    float v[32];
    const bf16_t* vp = V + (tokbase + tl) * 512 + gg * 64 + d0;
#pragma unroll
    for (int q = 0; q < 4; ++q) {
      const u32x4 w = *(const u32x4*)(vp + q * 8);
#pragma unroll
      for (int k = 0; k < 4; ++k) { const f2a g2 = gelu2((f2a){bflo(w[k]), bfhi(w[k])}); v[q * 8 + 2 * k] = g2.x; v[q * 8 + 2 * k + 1] = g2.y; }
    }
    float s1 = 0.f;
#pragma unroll
    for (int j = 0; j < 32; ++j) s1 += v[j];
    s1 += shx(s1, 1, lane);
    const float mu = s1 * (1.f / 64.f);
    float s2 = 0.f;
#pragma unroll
    for (int j = 0; j < 32; ++j) { const float d = v[j] - mu; s2 += d * d; }
    s2 += shx(s2, 1, lane);
    const float rstd = rsqrtf(s2 * (1.f / 64.f) + 1e-6f);
#pragma unroll
    for (int j = 0; j < 32; ++j) {
      const float vn = (v[j] - mu) * rstd * SMALLP[SM_LNG + gg * 64 + d0 + j] + SMALLP[SM_LNB + gg * 64 + d0 + j];
      *(bf16_t*)(vnT + (d0 + j) * 272 + tl * 2) = f2bf(vn);
    }
  }
  __syncthreads();
  if (active) {
    f32x16 acc[2];
#pragma unroll
    for (int c = 0; c < 2; ++c)
#pragma unroll
      for (int i = 0; i < 16; ++i) acc[c][i] = 0.f;
    const bf16_t* arow = WSP + ((size_t)gg * 128 + 32 * wave + r) * 128 + h * 8;
    const int nks = 2 * (wave + 1);
    for (int ks = 0; ks < nks; ++ks) {
      const s16x8 af = *(const s16x8*)(arow + ks * 16);
#pragma unroll
      for (int c = 0; c < 2; ++c) {
        const s16x8 bfr = *(const s16x8*)(vnT + (c * 32 + r) * 272 + (ks * 16 + h * 8) * 2);
        acc[c] = MFMA32(af, bfr, acc[c]);
      }
    }
#pragma unroll
    for (int i = 0; i < 16; ++i) {
      const int t = 32 * wave + crow(i, h);
      const float bs = SMALLP[SM_BSP + gg * 128 + t];
#pragma unroll
      for (int c = 0; c < 2; ++c) mxl[t * 68 + c * 32 + r] = acc[c][i] + bs;
    }
  }
  __syncthreads();
  if (active) {
    const size_t off = (tokbase + tl) * 512 + gg * 64 + d0;
    bf16_t* op = MIX + (tokbase + tl) * 1024 + 512 + gg * 64 + d0;
#pragma unroll
    for (int q = 0; q < 4; ++q) {
      const u32x4 uu = uu4[q];
      const u32x4 zz = zz4[q];
      const float4 m0 = *(const float4*)(mxl + tl * 68 + d0 + q * 8);
      const float4 m1 = *(const float4*)(mxl + tl * 68 + d0 + q * 8 + 4);
      u32x4 o;
#define GM2_(uw, zw, ma, mb) pack2v(gelu2((f2a){bflo(uw), bfhi(uw)}) * (f2a){(ma), (mb)} * silu2((f2a){bflo(zw), bfhi(zw)}))
      o[0] = GM2_(uu[0], zz[0], m0.x, m0.y);
      o[1] = GM2_(uu[1], zz[1], m0.z, m0.w);
      o[2] = GM2_(uu[2], zz[2], m1.x, m1.y);
      o[3] = GM2_(uu[3], zz[3], m1.z, m1.w);
#undef GM2_
      *(u32x4*)(op + q * 8) = o;
    }
  }
  __syncthreads();
}

DI void qk1(const char* Kl, const s16x8 (&qf)[4], f32x16 (&S)[2], int r, int h) {
#pragma unroll
  for (int a = 0; a < 2; ++a)
#pragma unroll
    for (int i = 0; i < 16; ++i) S[a][i] = 0.f;
#pragma unroll
  for (int kt2 = 0; kt2 < 2; ++kt2)
#pragma unroll
    for (int s = 0; s < 4; ++s) {
      const s16x8 kf = *(const s16x8*)(Kl + (kt2 * 32 + r) * 144 + s * 32 + h * 16);
      S[kt2] = MFMA32(kf, qf[s], S[kt2]);
    }
}
DI void pv1(const char* Vl, const f32x16 (&S)[2], f32x16 (&O)[2], int r, int h) {
#pragma unroll
  for (int kt2 = 0; kt2 < 2; ++kt2)
#pragma unroll
    for (int s2 = 0; s2 < 2; ++s2) {
      u32x4 pk;
      pk[0] = pack2(S[kt2][8 * s2 + 0], S[kt2][8 * s2 + 1]);
      pk[1] = pack2(S[kt2][8 * s2 + 2], S[kt2][8 * s2 + 3]);
      pk[2] = pack2(S[kt2][8 * s2 + 4], S[kt2][8 * s2 + 5]);
      pk[3] = pack2(S[kt2][8 * s2 + 6], S[kt2][8 * s2 + 7]);
      const s16x8 pf = __builtin_bit_cast(s16x8, pk);
#pragma unroll
      for (int dt = 0; dt < 2; ++dt) {
        const char* vp = Vl + (dt * 32 + r) * 144 + (kt2 * 32 + 16 * s2 + 4 * h) * 2;
        const s16x4 lo = *(const s16x4*)(vp);
        const s16x4 hi = *(const s16x4*)(vp + 16);
        const s16x8 vf = __builtin_shufflevector(lo, hi, 0, 1, 2, 3, 4, 5, 6, 7);
        O[dt] = MFMA32(vf, pf, O[dt]);
      }
    }
}
DI float max3f(float a, float b, float c) {
  float d;
  asm("v_max3_f32 %0, %1, %2, %3" : "=v"(d) : "v"(a), "v"(b), "v"(c));
  return d;
}
typedef float f2v __attribute__((ext_vector_type(2)));
DI float max17f(float a, const f32x16& x) {
  float d;
  asm("v_max3_f32 %0, %1, %2, %3\n\t"
      "v_max3_f32 %0, %0, %4, %5\n\t"
      "v_max3_f32 %0, %0, %6, %7\n\t"
      "v_max3_f32 %0, %0, %8, %9\n\t"
      "v_max3_f32 %0, %0, %10, %11\n\t"
      "v_max3_f32 %0, %0, %12, %13\n\t"
      "v_max3_f32 %0, %0, %14, %15\n\t"
      "v_max3_f32 %0, %0, %16, %17"
      : "=&v"(d)
      : "v"(a), "v"(x[0]), "v"(x[1]), "v"(x[2]), "v"(x[3]), "v"(x[4]), "v"(x[5]), "v"(x[6]), "v"(x[7]), "v"(x[8]), "v"(x[9]),
        "v"(x[10]), "v"(x[11]), "v"(x[12]), "v"(x[13]), "v"(x[14]), "v"(x[15]));
  return d;
}

DI void softmax1(f32x16 (&S)[2], int kbase, int lo, int hi, bool fast, bool rowok, float& m, float& l,
                 f32x16 (&O)[2], int h, int lane) {
  float mx = -1e30f;
  const int lo2 = lo - kbase - 4 * h, hi2 = hi - kbase - 4 * h;
  if (fast) {
#pragma unroll
    for (int kt2 = 0; kt2 < 2; ++kt2) mx = max17f(mx, S[kt2]);
    mx = rowok ? mx : -1e30f;
  } else {
#pragma unroll
    for (int kt2 = 0; kt2 < 2; ++kt2)
#pragma unroll
      for (int i = 0; i < 16; ++i) {
        const int ci = kt2 * 32 + (i & 3) + 8 * (i >> 2);
        mx = (ci >= lo2 && ci <= hi2) ? fmaxf(mx, S[kt2][i]) : mx;
      }
  }
  mx = xhalf_max(mx);
  const bool need = __builtin_amdgcn_ballot_w64((mx - m) > 8.0f) != 0ull;
  const float mnew = need ? fmaxf(m, mx) : m;
  const float alpha = need ? __builtin_amdgcn_exp2f((m - mnew) * L2E) : 1.0f;
  const float mL = mnew * L2E;
  float sum = 0.f;
  if (fast) {
    const float mLe = rowok ? mL : 3.0e38f;
    f2v sumv = {0.f, 0.f};
#pragma unroll
    for (int kt2 = 0; kt2 < 2; ++kt2)
#pragma unroll
      for (int i = 0; i < 16; i += 2) {
        f2v t = {S[kt2][i], S[kt2][i + 1]};
        t = __builtin_elementwise_fma(t, (f2v){L2E, L2E}, (f2v){-mLe, -mLe});
        f2v pv2 = {__builtin_amdgcn_exp2f(t.x), __builtin_amdgcn_exp2f(t.y)};
        S[kt2][i] = pv2.x;
        S[kt2][i + 1] = pv2.y;
        sumv += pv2;
      }
    sum = sumv.x + sumv.y;
  } else {
#pragma unroll
    for (int kt2 = 0; kt2 < 2; ++kt2)
#pragma unroll
      for (int i = 0; i < 16; ++i) {
        const int ci = kt2 * 32 + (i & 3) + 8 * (i >> 2);
        const float pv = (ci >= lo2 && ci <= hi2) ? __builtin_amdgcn_exp2f(__builtin_fmaf(S[kt2][i], L2E, -mL)) : 0.f;
        S[kt2][i] = pv;
        sum += pv;
      }
  }
  l = l * alpha + sum;
  if (need) {
#pragma unroll
    for (int dt = 0; dt < 2; ++dt)
#pragma unroll
      for (int i = 0; i < 16; ++i) O[dt][i] *= alpha;
  }
  m = mnew;
}

DI void attn_item(const Params& p, char* smem, int c, int b, int g) {
  const int tid = opaque_tid(), lane = tid & 63, wave = tid >> 6;
  const int r = lane & 31, h = lane >> 5;
  const int hl = wave & 3, qt = wave >> 2;
  const int hd = g * 4 + hl, bg = b * 2 + g;
  const int ql = qt * 32 + r;
  const size_t tok = (size_t)b * 4096 + c * 64 + ql;
  const int tq = c * 64 + ql;
  float* imp = (float*)(smem + 36864);
  unsigned char* selm = (unsigned char*)(smem + 53248);
  const bf16_t* KCMP = (const bf16_t*)(p.ws + OFF_KCMP) + (size_t)bg * 256 * 64;
  const bf16_t* VCMPT = (const bf16_t*)(p.ws + OFF_VCMPT) + (size_t)bg * 64 * 256;
  const bf16_t* KS = (const bf16_t*)(p.ws + OFF_KS) + (size_t)b * 4096 * 128 + g * 64;
  const bf16_t* KW = (const bf16_t*)(p.ws + OFF_KW) + (size_t)b * 4096 * 128 + g * 64;
  const bf16_t* VST = (const bf16_t*)(p.ws + OFF_VST) + (size_t)bg * 64 * 4096;
  const bf16_t* VWT = (const bf16_t*)(p.ws + OFF_VWT) + (size_t)bg * 64 * 4096;

  s16x8 qf[4];
  {
    const bf16_t* qp = (const bf16_t*)(p.ws + OFF_Q) + tok * 512 + hd * 64 + h * 8;
#pragma unroll
    for (int s = 0; s < 4; ++s) qf[s] = *(const s16x8*)(qp + s * 16);
  }
  const float* gp = (const float*)(p.ws + OFF_GATES) + tok * 24 + hd * 3;
  const float gate0 = gp[0], gate1 = gp[1], gate2 = gp[2];

  const int nct = ((4 * c + 2) >> 6) + 1, nsel = c + 1, j0 = c >= 8 ? c - 8 : 0, nwin = c - j0 + 1;
  const int total = 2 * nct + nsel + nwin;
  const int srow = tid >> 3, scc = tid & 7;
  u32x4 kreg, vreg;
#define ATT_ISSUE(sidx)                                                                          \
  do {                                                                                           \
    const int s_ = (sidx);                                                                       \
    const bf16_t *kp_, *vp_;                                                                     \
    int kpi_, vpi_;                                                                              \
    if (s_ < 2 * nct) { const int ct_ = s_ < nct ? s_ : s_ - nct; kp_ = KCMP + ct_ * 4096; kpi_ = 64; vp_ = VCMPT + ct_ * 64; vpi_ = 256; } \
    else if (s_ < 2 * nct + nsel) { const int j_ = s_ - 2 * nct; kp_ = KS + (size_t)j_ * 8192; kpi_ = 128; vp_ = VST + j_ * 64; vpi_ = 4096; } \
    else { const int j_ = j0 + s_ - 2 * nct - nsel; kp_ = KW + (size_t)j_ * 8192; kpi_ = 128; vp_ = VWT + j_ * 64; vpi_ = 4096; } \
    kreg = *(const u32x4*)(kp_ + srow * kpi_ + scc * 8);                                         \
    vreg = *(const u32x4*)(vp_ + (size_t)srow * vpi_ + scc * 8);                                 \
  } while (0)
#define ATT_COMMIT(buf)                                                                          \
  do {                                                                                           \
    *(u32x4*)(smem + (buf) * 9216 + srow * 144 + scc * 16) = kreg;                               \
    *(u32x4*)(smem + 18432 + (buf) * 9216 + srow * 144 + scc * 16) = vreg;                       \
  } while (0)
#define ATT_PRE(s)  do { if ((s) + 1 < total) ATT_ISSUE((s) + 1); } while (0)
#define ATT_POST(s) do { if ((s) + 1 < total) ATT_COMMIT(((s) + 1) & 1); __syncthreads(); } while (0)

  ATT_ISSUE(0);
  ATT_COMMIT(0);
  for (int i = tid; i < 4096; i += NTHR) imp[i] = 0.f;
  __syncthreads();

  f32x16 S[2], O[2], Oout[2];
  float m, l;
  int s = 0;
  const int hic = (tq - 31) >> 4;
  m = -1e30f; l = 0.f;
  for (int ct = 0; ct < nct; ++ct, ++s) {
    ATT_PRE(s);
    qk1(smem + (s & 1) * 9216, qf, S, r, h);
    float mx = -1e30f;
    const int hi2 = hic - ct * 64 - 4 * h;
#pragma unroll
    for (int kt2 = 0; kt2 < 2; ++kt2)
#pragma unroll
      for (int i = 0; i < 16; ++i) {
        const int ci = kt2 * 32 + (i & 3) + 8 * (i >> 2);
        mx = (ci <= hi2) ? fmaxf(mx, S[kt2][i]) : mx;
      }
    mx = xhalf_max(mx);
    const float mnew = fmaxf(m, mx);
    const float alpha = __builtin_amdgcn_exp2f((m - mnew) * L2E);
    const float mL = mnew * L2E;
    float sum = 0.f;
#pragma unroll
    for (int kt2 = 0; kt2 < 2; ++kt2)
#pragma unroll
      for (int i = 0; i < 16; ++i) {
        const int ci = kt2 * 32 + (i & 3) + 8 * (i >> 2);
        sum += (ci <= hi2) ? __builtin_amdgcn_exp2f(__builtin_fmaf(S[kt2][i], L2E, -mL)) : 0.f;
      }
    l = l * alpha + sum;
    m = mnew;
    ATT_POST(s);
  }
  {
    const float lt = xhalf_sum(l);
    const float inv = (hic >= 0 && lt > 0.f) ? 1.f / lt : 0.f;
    const float mL = m * L2E;
#pragma unroll
    for (int a = 0; a < 2; ++a)
#pragma unroll
      for (int i = 0; i < 16; ++i) O[a][i] = 0.f;
    for (int ct = 0; ct < nct; ++ct, ++s) {
      ATT_PRE(s);
      qk1(smem + (s & 1) * 9216, qf, S, r, h);
      const int hi2 = hic - ct * 64 - 4 * h;
#pragma unroll
      for (int kt2 = 0; kt2 < 2; ++kt2)
#pragma unroll
        for (int i = 0; i < 16; ++i) {
          const int ci = kt2 * 32 + (i & 3) + 8 * (i >> 2);
          S[kt2][i] = (ci <= hi2) ? __builtin_amdgcn_exp2f(__builtin_fmaf(S[kt2][i], L2E, -mL)) * inv : 0.f;
        }
      if (c >= 16) {
        float* irow = imp + ql * 64;
#pragma unroll
        for (int kt2 = 0; kt2 < 2; ++kt2)
#pragma unroll
          for (int gi = 0; gi < 4; ++gi) {
            const int jb = ct * 16 + kt2 * 8 + 2 * gi + h;
            const float a4 = (S[kt2][4 * gi] + S[kt2][4 * gi + 1]) + (S[kt2][4 * gi + 2] + S[kt2][4 * gi + 3]);
            __hip_atomic_fetch_add(irow + jb, a4, __ATOMIC_RELAXED, __HIP_MEMORY_SCOPE_WORKGROUP);
            if (jb + 1 < 64)
              __hip_atomic_fetch_add(irow + jb + 1, S[kt2][4 * gi + 3], __ATOMIC_RELAXED, __HIP_MEMORY_SCOPE_WORKGROUP);
          }
      }
      pv1(smem + 18432 + (s & 1) * 9216, S, O, r, h);
      ATT_POST(s);
    }
#pragma unroll
    for (int dt = 0; dt < 2; ++dt)
#pragma unroll
      for (int i = 0; i < 16; ++i) Oout[dt][i] = gate0 * O[dt][i];
  }
  {
    const int tr_ = opaque_tid();
    const int q = tr_ >> 3, part = tr_ & 7;
    unsigned bits = 0;
    if (c >= 16) {
      unsigned key[8];
#pragma unroll
      for (int k = 0; k < 8; ++k) {
        const int j = part * 8 + k;
        const unsigned u = __float_as_uint(imp[q * 64 + j]);
        key[k] = (j >= 1 && j <= c - 2) ? ((u & ~63u) | (unsigned)(63 - j)) : 0u;
      }
      for (int rd = 0; rd < 13; ++rd) {
        unsigned lm = key[0];
#pragma unroll
        for (int k = 1; k < 8; ++k) lm = lm > key[k] ? lm : key[k];
#pragma unroll
        for (int o = 1; o <= 4; o <<= 1) {
          const unsigned ot = shxu(lm, o, tr_ & 63);
          lm = lm > ot ? lm : ot;
        }
#pragma unroll
        for (int k = 0; k < 8; ++k) {
          const bool hit = (key[k] == lm) && (lm != 0u);
          bits |= hit ? (1u << k) : 0u;
          key[k] = hit ? 0u : key[k];
        }
      }
#pragma unroll
      for (int k = 0; k < 8; ++k) {
        const int j = part * 8 + k;
        if (j == 0 || j == c || j == c - 1) bits |= (1u << k);
      }
    } else {
#pragma unroll
      for (int k = 0; k < 8; ++k) {
        const int j = part * 8 + k;
        if (j <= c) bits |= (1u << k);
      }
    }
    selm[q * 8 + part] = (unsigned char)bits;
  }
  __syncthreads();
  const u64 sm = *(const u64*)(selm + ql * 8);

  m = -1e30f; l = 0.f;
#pragma unroll
  for (int a = 0; a < 2; ++a)
#pragma unroll
    for (int i = 0; i < 16; ++i) O[a][i] = 0.f;
  for (int j = 0; j <= c; ++j, ++s) {
    {
      const bool more_ = j < c;
      const bf16_t* kp_ = more_ ? KS + (size_t)(j + 1) * 8192 : KW + (size_t)j0 * 8192;
      const bf16_t* vp_ = more_ ? VST + (j + 1) * 64 : VWT + j0 * 64;
      kreg = *(const u32x4*)(kp_ + srow * 128 + scc * 8);
      vreg = *(const u32x4*)(vp_ + (size_t)srow * 4096 + scc * 8);
    }
    qk1(smem + (s & 1) * 9216, qf, S, r, h);
    const bool selq = ((sm >> j) & 1ull) != 0ull;
    softmax1(S, j * 64, 0, selq ? tq : -1, j < c, selq, m, l, O, h, lane);
    pv1(smem + 18432 + (s & 1) * 9216, S, O, r, h);
    ATT_POST(s);
  }
  {
    const float lt = xhalf_sum(l);
    const float sc = gate1 / lt;
#pragma unroll
    for (int dt = 0; dt < 2; ++dt)
#pragma unroll
      for (int i = 0; i < 16; ++i) Oout[dt][i] += sc * O[dt][i];
  }
  m = -1e30f; l = 0.f;
#pragma unroll
  for (int a = 0; a < 2; ++a)
#pragma unroll
    for (int i = 0; i < 16; ++i) O[a][i] = 0.f;
  for (int j = j0; j <= c; ++j, ++s) {
    if (j < c) {
      kreg = *(const u32x4*)(KW + (size_t)(j + 1) * 8192 + srow * 128 + scc * 8);
      vreg = *(const u32x4*)(VWT + (j + 1) * 64 + (size_t)srow * 4096 + scc * 8);
    }
    qk1(smem + (s & 1) * 9216, qf, S, r, h);
    softmax1(S, j * 64, tq - 511, tq, (j >= c - 7) && (j < c), true, m, l, O, h, lane);
    pv1(smem + 18432 + (s & 1) * 9216, S, O, r, h);
    ATT_POST(s);
  }
  {
    const float lt = xhalf_sum(l);
    const float sc = gate2 / lt;
#pragma unroll
    for (int dt = 0; dt < 2; ++dt)
#pragma unroll
      for (int i = 0; i < 16; ++i) Oout[dt][i] += sc * O[dt][i];
  }
  {
    const bf16_t* ZN = (const bf16_t*)(p.ws + OFF_ZN) + tok * 512 + hd * 64;
    bf16_t* MIX = (bf16_t*)(p.ws + OFF_MIX) + tok * 1024 + hd * 64;
#pragma unroll
    for (int dt = 0; dt < 2; ++dt)
#pragma unroll
      for (int gi = 0; gi < 4; ++gi) {
        const int d = dt * 32 + 8 * gi + 4 * h;
        const u32x2 z = *(const u32x2*)(ZN + d);
        u32x2 o;
        o[0] = pack2(Oout[dt][4 * gi + 0] * silu_f(bflo(z[0])), Oout[dt][4 * gi + 1] * silu_f(bfhi(z[0])));
        o[1] = pack2(Oout[dt][4 * gi + 2] * silu_f(bflo(z[1])), Oout[dt][4 * gi + 3] * silu_f(bfhi(z[1])));
        *(u32x2*)(MIX + d) = o;
      }
  }
  __syncthreads();
#undef ATT_ISSUE
#undef ATT_COMMIT
#undef ATT_PRE
#undef ATT_POST
}

DI void phase3(const Params& p, char* smem) {
  const int G = gridDim.x;
  for (int k = 0; k * G < 2048; ++k) {
    const int i = (k & 1) ? (G - 1 - (int)blockIdx.x) : (int)blockIdx.x;
    const int idx = k * G + i;
    if (idx < 2048) {
      const int c = 63 - (idx >> 5), bgi = idx & 31;
      attn_item(p, smem, c, bgi >> 1, bgi & 1);
    }
  }
}

struct OneUnit {
  pg8::Unit u0;
  __device__ bool next(int i, pg8::Unit& u) const { if (i != 0) return false; u = u0; return true; }
  __device__ __forceinline__ void a_ready(const pg8::Unit&) const {}
  __device__ __forceinline__ void done(const pg8::Unit&) const {}
};
struct EpiP4F {
  static constexpr bool PERM = true, AFTER_DRAIN = true;
  const float* x;
  float* out;
  float* rowss;
  unsigned* pcnt;
  const float* gvec;
  __device__ __forceinline__ void operator()(const pg8::f32x4 (&)[2][2][4][2], const pg8::Unit&, int, int, int, int) const {}
  __device__ __forceinline__ void fused(const pg8::f32x4 (&acc_c)[2][2][4][2], const pg8::Unit& u, int wr, int wc, int fr, int fq,
                                        PG8_LAS unsigned char* lds, int wid, int lane) const {
    auto& acc = const_cast<pg8::f32x4 (&)[2][2][4][2]>(acc_c);
    PG8_LAS float* rl = (PG8_LAS float*)lds;
    const int tid = wid * 64 + lane;
    if (tid < 256) rl[tid] = 0.f;
    __syncthreads();
#pragma unroll
    for (int ai = 0; ai < 2; ++ai)
#pragma unroll
      for (int m = 0; m < 4; ++m) {
        const int row_l = ai * 128 + wr * 64 + m * 16 + fr;
        const size_t rowoff = ((size_t)u.pm * 256 + row_l) * 1024;
        float ss = 0.f;
#pragma unroll
        for (int bj = 0; bj < 2; ++bj) {
          const int col = u.pn * 256 + bj * 128 + wc * 32 + fq * 8;
          const float4 x0 = *(const float4*)(x + rowoff + col);
          const float4 x1 = *(const float4*)(x + rowoff + col + 4);
          acc[ai][bj][m][0][0] += x0.x; acc[ai][bj][m][0][1] += x0.y; acc[ai][bj][m][0][2] += x0.z; acc[ai][bj][m][0][3] += x0.w;
          acc[ai][bj][m][1][0] += x1.x; acc[ai][bj][m][1][1] += x1.y; acc[ai][bj][m][1][2] += x1.z; acc[ai][bj][m][1][3] += x1.w;
#pragma unroll
          for (int n = 0; n < 2; ++n)
#pragma unroll
            for (int j = 0; j < 4; ++j) ss += acc[ai][bj][m][n][j] * acc[ai][bj][m][n][j];
        }
        ss += shx(ss, 16, lane);
        ss += shx(ss, 32, lane);
        if (fq == 0) __hip_atomic_fetch_add(rl + row_l, ss, __ATOMIC_RELAXED, __HIP_MEMORY_SCOPE_WORKGROUP);
      }
    __syncthreads();
    if (tid < 256) __hip_atomic_fetch_add(rowss + (size_t)u.pm * 256 + tid, rl[tid], __ATOMIC_RELAXED, __HIP_MEMORY_SCOPE_AGENT);
    asm volatile("s_waitcnt vmcnt(0)" ::: "memory");
    __syncthreads();
    if (tid == 0) {
      __builtin_amdgcn_fence(__ATOMIC_RELEASE, "agent");
      asm volatile("s_waitcnt vmcnt(0)" ::: "memory");
      __hip_atomic_fetch_add(pcnt + u.pm, 1u, __ATOMIC_RELAXED, __HIP_MEMORY_SCOPE_AGENT);
      unsigned spins = 0;
      while (__hip_atomic_load(pcnt + u.pm, __ATOMIC_RELAXED, __HIP_MEMORY_SCOPE_AGENT) < 4u && ++spins < (1u << 22)) __builtin_amdgcn_s_sleep(2);
      __builtin_amdgcn_fence(__ATOMIC_ACQUIRE, "agent");
      asm volatile("s_waitcnt vmcnt(0)" ::: "memory");
    }
    __syncthreads();
    if (tid < 256) {
      const float rs = __hip_atomic_load(rowss + (size_t)u.pm * 256 + tid, __ATOMIC_RELAXED, __HIP_MEMORY_SCOPE_AGENT);
      rl[256 + tid] = rsqrtf(rs * (1.f / 1024.f) + 1e-6f);
    }
    __syncthreads();
    float4 g0[2], g1[2];
#pragma unroll
    for (int bj = 0; bj < 2; ++bj) {
      const int col = u.pn * 256 + bj * 128 + wc * 32 + fq * 8;
      g0[bj] = *(const float4*)(gvec + col);
      g1[bj] = *(const float4*)(gvec + col + 4);
    }
#pragma unroll
    for (int ai = 0; ai < 2; ++ai)
#pragma unroll
      for (int m = 0; m < 4; ++m) {
        const int row_l = ai * 128 + wr * 64 + m * 16 + fr;
        const size_t rowoff = ((size_t)u.pm * 256 + row_l) * 1024;
        const float rstd = rl[256 + row_l];
#pragma unroll
        for (int bj = 0; bj < 2; ++bj) {
          const int col = u.pn * 256 + bj * 128 + wc * 32 + fq * 8;
          float4 o0, o1;
          o0.x = acc[ai][bj][m][0][0] * rstd * g0[bj].x; o0.y = acc[ai][bj][m][0][1] * rstd * g0[bj].y;
          o0.z = acc[ai][bj][m][0][2] * rstd * g0[bj].z; o0.w = acc[ai][bj][m][0][3] * rstd * g0[bj].w;
          o1.x = acc[ai][bj][m][1][0] * rstd * g1[bj].x; o1.y = acc[ai][bj][m][1][1] * rstd * g1[bj].y;
          o1.z = acc[ai][bj][m][1][2] * rstd * g1[bj].z; o1.w = acc[ai][bj][m][1][3] * rstd * g1[bj].w;
          *(float4*)(out + rowoff + col) = o0;
          *(float4*)(out + rowoff + col + 4) = o1;
        }
      }
    __syncthreads();
  }
};

DI void phase4_fused(const Params& p, unsigned char* smem, const int wid_s) {
  pg8::Gemm g;
  g.A = (const bf16_t*)(p.ws + OFF_MIX); g.Bt = (const bf16_t*)(p.ws + OFF_WTOUT); g.M = NTOK; g.N = 1024; g.K = 1024;
  pg8::StaticOrder S; S.init(NTOK, 1024, (int)gridDim.x, (int)blockIdx.x);
  EpiP4F E; E.x = p.x; E.out = p.out; E.rowss = (float*)(p.ws + OFF_ROWSS); E.pcnt = (unsigned*)(p.ws + OFF_PCNT);
  E.gvec = (const float*)(p.ws + OFF_SMALL) + SM_NFG;
  for (int i = 0; i < 4; ++i) {
    OneUnit O1;
    if (!S.next(i, O1.u0)) break;
    pg8::gemm_phase<EpiP4F, OneUnit, false>((PG8_LAS unsigned char*)smem, g, O1, E, nullptr, opaque_tid_w(wid_s));
    __syncthreads();
  }
}

DI void phase4(const Params& p, unsigned char* smem, const int wid_s) {
  pg8::Gemm g;
  g.A = (const bf16_t*)(p.ws + OFF_MIX); g.Bt = (const bf16_t*)(p.ws + OFF_WTOUT); g.M = NTOK; g.N = 1024; g.K = 1024;
  pg8::StaticOrder S; S.init(NTOK, 1024, (int)gridDim.x, (int)blockIdx.x);
  EpiP4 E; E.x = p.x; E.hb = (bf16_t*)(p.ws + OFF_HN); E.rowss = (float*)(p.ws + OFF_ROWSS);
  pg8::gemm_phase<EpiP4, pg8::StaticOrder, false>((PG8_LAS unsigned char*)smem, g, S, E, nullptr, opaque_tid_w(wid_s));
  __syncthreads();
}

DI void phase5(const Params& p, const int wid_s) {
  const int t2 = opaque_tid_w(wid_s), lane = t2 & 63, wave = t2 >> 6;
  const bf16_t* HB = (const bf16_t*)(p.ws + OFF_HN);
  const float* RS = (const float*)(p.ws + OFF_ROWSS);
  float4 gf[2][2];
#pragma unroll
  for (int ch = 0; ch < 2; ++ch)
#pragma unroll
    for (int q = 0; q < 2; ++q) gf[ch][q] = *(const float4*)(p.ws + OFF_SMALL + (size_t)(SM_NFG + ch * 512 + lane * 8 + q * 4) * 4);
  const int gw = blockIdx.x * 8 + wave, ngw = gridDim.x * 8;
  for (int r0 = gw * 4; r0 < NTOK; r0 += ngw * 4) {
    u32x4 hv[4][2];
    float rs[4];
#pragma unroll
    for (int k = 0; k < 4; ++k) {
      const bf16_t* hrow = HB + (size_t)(r0 + k) * 1024;
#pragma unroll
      for (int ch = 0; ch < 2; ++ch) hv[k][ch] = *(const u32x4*)(hrow + ch * 512 + lane * 8);
      rs[k] = RS[r0 + k];
    }
#pragma unroll
    for (int k = 0; k < 4; ++k) {
      const float rstd = rsqrtf(rs[k] * (1.f / 1024.f) + 1e-6f);
      float* orow = p.out + (size_t)(r0 + k) * 1024;
#pragma unroll
      for (int ch = 0; ch < 2; ++ch) {
        float4 o0, o1;
        o0.x = bflo(hv[k][ch][0]) * rstd * gf[ch][0].x; o0.y = bfhi(hv[k][ch][0]) * rstd * gf[ch][0].y;
        o0.z = bflo(hv[k][ch][1]) * rstd * gf[ch][0].z; o0.w = bfhi(hv[k][ch][1]) * rstd * gf[ch][0].w;
        o1.x = bflo(hv[k][ch][2]) * rstd * gf[ch][1].x; o1.y = bfhi(hv[k][ch][2]) * rstd * gf[ch][1].y;
        o1.z = bflo(hv[k][ch][3]) * rstd * gf[ch][1].z; o1.w = bfhi(hv[k][ch][3]) * rstd * gf[ch][1].w;
        *(float4*)(orow + ch * 512 + lane * 8) = o0;
        *(float4*)(orow + ch * 512 + lane * 8 + 4) = o1;
      }
    }
  }
}

#ifndef REP0
#define REP0 1
#endif
#ifndef REP1
#define REP1 1
#endif
#ifndef REP2
#define REP2 1
#endif
#ifndef REP3
#define REP3 1
#endif
#ifndef REP4
#define REP4 1
#endif
__global__ void __launch_bounds__(NTHR, 2) nsa_gmlp_megakernel(Params p) {
  __shared__ __attribute__((aligned(16))) unsigned char smem[SMEM_BYTES];
  cg::grid_group grid = cg::this_grid();
  volatile XB_LAS unsigned* xst = (volatile XB_LAS unsigned*)((XB_LAS unsigned char*)smem + 134144);
  if (threadIdx.x == 0) { xst[0] = 0u; xst[1] = 0u; }
  __syncthreads();
  const XcdBarrier xb = xcd_barrier_post((unsigned*)(p.ws + OFF_XBAR), xst);
  if (p.ws == nullptr) grid.sync();
  const int wid_s = __builtin_amdgcn_readfirstlane((int)(threadIdx.x >> 6));
  for (int rep = 0; rep < REP0; ++rep) phase0(p);
  xcd_barrier(xb);
  unsigned* const barp = (unsigned*)(p.ws + OFF_BAR);
  const unsigned nblk = gridDim.x;
  const bool leader = threadIdx.x == 0;
  for (int rep = 0; rep < REP1; ++rep) {
    pg8::Gemm g;
    g.A = (const bf16_t*)(p.ws + OFF_HN); g.Bt = (const bf16_t*)(p.ws + OFF_WTIN); g.M = NTOK; g.N = NPAD; g.K = 1024;
    pg8::StaticOrder S; S.init(NTOK, NPAD, (int)gridDim.x, (int)blockIdx.x);
    EpiP1 E; E.ws = p.ws;
    pg8::gemm_phase<EpiP1, pg8::StaticOrder, false>((PG8_LAS unsigned char*)smem, g, S, E, nullptr, opaque_tid());
    __syncthreads();
  }
  xcd_barrier(xb);
  for (int rep = 0; rep < REP2; ++rep) {
    const int vb = blockIdx.x * 2 + (threadIdx.x >> 8), nvb = gridDim.x * 2;
    char* sh = (char*)smem + (threadIdx.x >> 8) * 52224;
    for (int it0 = 0; it0 < 512; it0 += nvb) compress_item(p, sh, it0 + vb, it0 + vb < 512);
    for (int it0 = 0; it0 < 4096; it0 += nvb) gmlp_item(p, sh, it0 + vb, it0 + vb < 4096);
  }
  xcd_barrier(xb);
  for (int rep = 0; rep < REP3; ++rep) phase3(p, (char*)smem);
  xcd_barrier(xb);
  if (gridDim.x == 256) {
    phase4_fused(p, smem, wid_s);
  } else {
    for (int rep = 0; rep < REP4; ++rep) phase4(p, smem, wid_s);
    xcd_barrier(xb);
    phase5(p, wid_s);
  }
}

extern "C" void kernel_launch(void* const* d_in, const int* in_sizes, int n_in, void* d_out, int out_size, void* d_ws,
                              size_t ws_size, hipStream_t stream) {
  static int grid_blocks = 0;
  if (!grid_blocks) {
    int dev = 0, cus = 0, per_cu = 0;
    (void)hipGetDevice(&dev);
    (void)hipDeviceGetAttribute(&cus, hipDeviceAttributeMultiprocessorCount, dev);
    (void)hipOccupancyMaxActiveBlocksPerMultiprocessor(&per_cu, nsa_gmlp_megakernel, NTHR, 0);
    if (per_cu < 1) per_cu = 1;
    grid_blocks = cus;
  }
  Params p{};
  p.x = (const float*)d_in[0];
  p.norm_in_g = (const float*)d_in[1];
  p.w_in = (const float*)d_in[2];
  p.w_k1 = (const float*)d_in[3];
  p.w_k2 = (const float*)d_in[4];
  p.pe_k = (const float*)d_in[5];
  p.w_v1 = (const float*)d_in[6];
  p.w_v2 = (const float*)d_in[7];
  p.pe_v = (const float*)d_in[8];
  p.ln_g = (const float*)d_in[9];
  p.ln_b = (const float*)d_in[10];
  p.w_sp = (const float*)d_in[11];
  p.b_sp = (const float*)d_in[12];
  p.w_out = (const float*)d_in[13];
  p.norm_f_g = (const float*)d_in[14];
  p.out = (float*)d_out;
  p.ws = (char*)d_ws;
  void* args[] = {&p};
  (void)hipMemsetAsync((char*)d_ws + OFF_XBAR, 0, 3456 * 4, stream);
  hipError_t e = hipLaunchCooperativeKernel((void*)nsa_gmlp_megakernel, dim3(grid_blocks), dim3(NTHR), args, 0, stream);
  if (e != hipSuccess) fprintf(stderr, "cooperative launch failed: %s (grid %d)\n", hipGetErrorString(e), grid_blocks);
}
```

```cpp
#include <hip/hip_runtime.h>
#include <hip/hip_cooperative_groups.h>
#include <cstdio>
namespace cg = cooperative_groups;

#define DI __device__ __forceinline__
typedef unsigned short bf16_t;
typedef unsigned long long u64;
typedef __attribute__((ext_vector_type(8))) short s16x8;
typedef __attribute__((ext_vector_type(4))) short s16x4;
typedef __attribute__((ext_vector_type(16))) float f32x16;
typedef __attribute__((ext_vector_type(4))) unsigned u32x4;
typedef __attribute__((ext_vector_type(2))) unsigned u32x2;
typedef __bf16 bf2_t __attribute__((ext_vector_type(2)));
typedef float f2_t __attribute__((ext_vector_type(2)));

#define MFMA32(a, b, c) __builtin_amdgcn_mfma_f32_32x32x16_bf16((a), (b), (c), 0, 0, 0)

constexpr int NTOK = 65536;
constexpr int NTHR = 512;
constexpr int NPAD = 3584;
constexpr float L2E = 1.4426950408889634f;

constexpr size_t OFF_HN    = 0;
constexpr size_t OFF_WTIN  = OFF_HN    + (size_t)NTOK * 1024 * 2;
constexpr size_t OFF_WTOUT = OFF_WTIN  + (size_t)NPAD * 1024 * 2;
constexpr size_t OFF_W1TK  = OFF_WTOUT + (size_t)1024 * 1024 * 2;
constexpr size_t OFF_W1TV  = OFF_W1TK  + (size_t)128 * 2048 * 2;
constexpr size_t OFF_BIAS  = OFF_W1TV  + (size_t)128 * 2048 * 2;
constexpr size_t OFF_WSP   = OFF_BIAS  + 1024;
constexpr size_t OFF_Q     = OFF_WSP   + (size_t)8 * 128 * 128 * 2;
constexpr size_t OFF_KC    = OFF_Q     + (size_t)NTOK * 512 * 2;
constexpr size_t OFF_VC    = OFF_KC    + (size_t)NTOK * 128 * 2;
constexpr size_t OFF_KS    = OFF_VC    + (size_t)NTOK * 128 * 2;
constexpr size_t OFF_KW    = OFF_KS    + (size_t)NTOK * 128 * 2;
constexpr size_t OFF_VST   = OFF_KW    + (size_t)NTOK * 128 * 2;
constexpr size_t OFF_VWT   = OFF_VST   + (size_t)NTOK * 128 * 2;
constexpr size_t OFF_ZN    = OFF_VWT   + (size_t)NTOK * 128 * 2;
constexpr size_t OFF_U     = OFF_ZN    + (size_t)NTOK * 512 * 2;
constexpr size_t OFF_V     = OFF_U     + (size_t)NTOK * 512 * 2;
constexpr size_t OFF_ZG    = OFF_V     + (size_t)NTOK * 512 * 2;
constexpr size_t OFF_GATES = OFF_ZG    + (size_t)NTOK * 512 * 2;
constexpr size_t OFF_KCMP  = OFF_GATES + (size_t)NTOK * 24 * 4;
constexpr size_t OFF_VCMPT = OFF_KCMP  + (size_t)32 * 256 * 64 * 2;
constexpr size_t OFF_MIX   = OFF_VCMPT + (size_t)32 * 256 * 64 * 2;
constexpr size_t OFF_SMALL = OFF_MIX   + (size_t)NTOK * 1024 * 2;
constexpr int SM_LNG = 0, SM_LNB = 512, SM_BSP = 1024, SM_W2K = 2048, SM_W2V = 2048 + 8192, SM_NFG = 2048 + 16384, SM_TOTAL = 2048 + 16384 + 1024;
constexpr size_t OFF_ROWSS = OFF_SMALL + (size_t)SM_TOTAL * 4;
constexpr size_t OFF_BAR   = OFF_ROWSS + (size_t)NTOK * 4;
constexpr size_t OFF_XBAR  = OFF_BAR + 256;
constexpr size_t OFF_PCNT  = OFF_XBAR + 3456 * 4;
constexpr size_t OFF_QCTR  = OFF_PCNT + 256 * 4;
constexpr size_t WS_END    = OFF_QCTR + 256;

constexpr int SMEM_BYTES = 135168;

struct Params {
  const float *x, *norm_in_g, *w_in, *w_k1, *w_k2, *pe_k, *w_v1, *w_v2, *pe_v, *ln_g, *ln_b, *w_sp, *b_sp, *w_out, *norm_f_g;
  float* out;
  char* ws;
};

DI unsigned pack2(float a, float b) {
  f2_t v = {a, b};
  bf2_t r = __builtin_convertvector(v, bf2_t);
  return __builtin_bit_cast(unsigned, r);
}
DI bf16_t f2bf(float a) { return (bf16_t)(pack2(a, 0.f) & 0xffffu); }
DI float bflo(unsigned u) { return __uint_as_float(u << 16); }
DI float bfhi(unsigned u) { return __uint_as_float(u & 0xffff0000u); }
DI float shx(float v, int mask, int lane) {
  return __builtin_bit_cast(float, __builtin_amdgcn_ds_bpermute((lane ^ mask) << 2, __builtin_bit_cast(int, v)));
}
DI unsigned shxu(unsigned v, int mask, int lane) {
  return (unsigned)__builtin_amdgcn_ds_bpermute((lane ^ mask) << 2, (int)v);
}
DI float wave_sum(float v, int lane) {
#pragma unroll
  for (int o = 32; o >= 1; o >>= 1) v += shx(v, o, lane);
  return v;
}
DI float gelu_t(float x) {
  const float y2 = x * __builtin_fmaf(0.044715f, x * x, 1.0f) * (-2.0f * 0.7978845608028654f * 1.4426950408889634f);
  return x * __builtin_amdgcn_rcpf(1.0f + __builtin_amdgcn_exp2f(y2));
}
DI float sigmoid_f(float x) { return __builtin_amdgcn_rcpf(1.0f + __builtin_amdgcn_exp2f(-1.4426950408889634f * x)); }
DI float silu_f(float x) { return x * __builtin_amdgcn_rcpf(1.0f + __builtin_amdgcn_exp2f(-1.4426950408889634f * x)); }
typedef float f2a __attribute__((ext_vector_type(2)));
DI f2a gelu2(f2a x) {
  const f2a t = x * x * 0.044715f + 1.0f;
  const f2a y2 = x * t * (-2.0f * 0.7978845608028654f * 1.4426950408889634f);
  f2a e = {__builtin_amdgcn_exp2f(y2.x), __builtin_amdgcn_exp2f(y2.y)};
  e = e + 1.0f;
  const f2a rinv = {__builtin_amdgcn_rcpf(e.x), __builtin_amdgcn_rcpf(e.y)};
  return x * rinv;
}
DI f2a silu2(f2a x) {
  const f2a a = x * (-1.4426950408889634f);
  f2a e = {__builtin_amdgcn_exp2f(a.x), __builtin_amdgcn_exp2f(a.y)};
  e = e + 1.0f;
  const f2a rinv = {__builtin_amdgcn_rcpf(e.x), __builtin_amdgcn_rcpf(e.y)};
  return x * rinv;
}
DI unsigned pack2v(f2a v) { return pack2(v.x, v.y); }
DI float xhalf_max(float v) {
  const auto r_ = __builtin_amdgcn_permlane32_swap(__float_as_uint(v), __float_as_uint(v), false, false);
  return fmaxf(__uint_as_float(r_[0]), __uint_as_float(r_[1]));
}
DI float xhalf_sum(float v) {
  const auto r_ = __builtin_amdgcn_permlane32_swap(__float_as_uint(v), __float_as_uint(v), false, false);
  return __uint_as_float(r_[0]) + __uint_as_float(r_[1]);
}
DI int crow(int i, int h) { return (i & 3) + 8 * (i >> 2) + 4 * h; }
DI int opaque_tid() { int t = threadIdx.x; asm volatile("" : "+v"(t)); return t; }
DI int opaque_tid_w(int wid_s) {
  int t = (wid_s << 6) | (int)__builtin_amdgcn_mbcnt_hi(~0u, __builtin_amdgcn_mbcnt_lo(~0u, 0u));
  asm volatile("" : "+v"(t));
  return t;
}

#define XB_TMO      128
#define XB_XCNT(j)  (256  + 64 * (j))
#define XB_XSUB(j)  (1280 + 64 * (j))
#define XB_XGEN(j)  (2304 + 64 * (j))
#define XB_TOP      3328
#define XB_TOPGEN   3392
#define XCD_BAR_WORDS 3456
#define XB_SPIN_CAP (1u << 18)
#define XB_LAS __attribute__((address_space(3)))

__device__ __forceinline__ unsigned xb_ld(unsigned* p)              { return __hip_atomic_load(p, __ATOMIC_RELAXED, __HIP_MEMORY_SCOPE_AGENT); }
__device__ __forceinline__ unsigned xb_add(unsigned* p, unsigned v) { return __hip_atomic_fetch_add(p, v, __ATOMIC_RELAXED, __HIP_MEMORY_SCOPE_AGENT); }
__device__ __forceinline__ unsigned xb_xcc_id() { return (unsigned)__builtin_amdgcn_s_getreg((3 << 11) | 20) & 0xFu; }
#define XB_SPIN(cond, bar) do { unsigned _sp = 0; while (cond) { __builtin_amdgcn_s_sleep(1); \
    if ((++_sp & 255u) == 0u) { if (xb_ld(&(bar)[XB_TMO])) break; if (_sp > XB_SPIN_CAP) { atomicAdd(&(bar)[XB_TMO], 1u); break; } } } } while (0)

struct XcdBarrier {
    unsigned* bar; unsigned x;
    volatile XB_LAS unsigned* st;
};

__device__ __forceinline__ XcdBarrier xcd_barrier_post(unsigned* bar, volatile XB_LAS unsigned* st) {
    XcdBarrier b; b.bar = bar; b.x = xb_xcc_id(); b.st = st;
    if (threadIdx.x == 0) (void)xb_add(&bar[XB_XCNT(b.x)], 1u);
    return b;
}
__device__ __forceinline__ void xcd_barrier_complete(unsigned* bar, unsigned x, unsigned& nloc, unsigned& nx) {
    const unsigned G = gridDim.x * gridDim.y * gridDim.z;
    unsigned sum, cnt, mine, sp = 0u;
    for (;;) {
        sum = 0u; cnt = 0u; mine = 0u;
#pragma unroll
        for (unsigned j = 0; j < 16; ++j) { const unsigned c = xb_ld(&bar[XB_XCNT(j)]); sum += c; cnt += (c > 0u) ? 1u : 0u; mine = (j == x) ? c : mine; }
        if (sum == G) break;
        __builtin_amdgcn_s_sleep(1);
        if ((++sp & 255u) == 0u) { if (xb_ld(&bar[XB_TMO])) break; if (sp > XB_SPIN_CAP) { atomicAdd(&bar[XB_TMO], 1u); break; } }
    }
    nloc = mine > 0u ? mine : 1u; nx = cnt > 0u ? cnt : 1u;
}

__device__ __forceinline__ void xcd_barrier(const XcdBarrier& b) {
    asm volatile("s_waitcnt vmcnt(0)" ::: "memory");
    __syncthreads();
    if (threadIdx.x == 0) {
        unsigned* bar = b.bar;
        __builtin_amdgcn_s_waitcnt(0);
        unsigned nloc = b.st[0], nx = b.st[1];
        if (nloc == 0u) { xcd_barrier_complete(bar, b.x, nloc, nx); b.st[0] = nloc; b.st[1] = nx; }
        const unsigned old = xb_add(&bar[XB_XSUB(b.x)], 1u);
        const unsigned gen = old / nloc;
        if (old + 1u == (gen + 1u) * nloc) {
            __builtin_amdgcn_fence(__ATOMIC_RELEASE, "agent");
            asm volatile("s_waitcnt vmcnt(0)" ::: "memory");
            const unsigned og = xb_add(&bar[XB_TOP], 1u);
            const unsigned tg = og / nx;
            if (og + 1u == (tg + 1u) * nx) xb_add(&bar[XB_TOPGEN], 1u);
            else XB_SPIN(xb_ld(&bar[XB_TOPGEN]) == tg, bar);
            __builtin_amdgcn_fence(__ATOMIC_ACQUIRE, "agent");
            xb_add(&bar[XB_XGEN(b.x)], 1u);
            asm volatile("s_waitcnt vmcnt(0)" ::: "memory");
        } else {
            XB_SPIN(xb_ld(&bar[XB_XGEN(b.x)]) == gen, bar);
            __builtin_amdgcn_fence(__ATOMIC_ACQUIRE, "agent");
            asm volatile("s_waitcnt vmcnt(0)" ::: "memory");
        }
    }
    __syncthreads();
}

DI void grid_bar(unsigned* ctr, unsigned target, bool leader) {
  asm volatile("s_waitcnt vmcnt(0) lgkmcnt(0)" ::: "memory");
  __syncthreads();
  if (leader) {
    __builtin_amdgcn_fence(__ATOMIC_RELEASE, "agent");
    asm volatile("s_waitcnt vmcnt(0)" ::: "memory");
    __hip_atomic_fetch_add(ctr, 1u, __ATOMIC_RELAXED, __HIP_MEMORY_SCOPE_AGENT);
    while (__hip_atomic_load(ctr, __ATOMIC_RELAXED, __HIP_MEMORY_SCOPE_AGENT) < target) __builtin_amdgcn_s_sleep(2);
    __builtin_amdgcn_fence(__ATOMIC_ACQUIRE, "agent");
    asm volatile("s_waitcnt vmcnt(0)" ::: "memory");
  }
  __syncthreads();
}

DI void transpose_w(const float* __restrict__ src, int src_ld, bf16_t* __restrict__ dst, int Np, int K, int mode,
                    int gtid, int gthreads) {
  const int nchunks = K >> 3;
  const long total = (long)nchunks * Np;
  for (long id = gtid; id < total; id += gthreads) {
    const int n = (int)(id % Np), kc = (int)(id / Np);
    int sn = n;
    if (mode == 1) {
      if (n < 1280) sn = n;
      else if (n < 3328) sn = n + 24;
      else if (n < 3352) sn = n - 3328 + 1280;
      else sn = -1;
    }
    u32x4 o = {0u, 0u, 0u, 0u};
    if (sn >= 0) {
      float f[8];
#pragma unroll
      for (int j = 0; j < 8; ++j) f[j] = src[(size_t)(kc * 8 + j) * src_ld + sn];
      o[0] = pack2(f[0], f[1]); o[1] = pack2(f[2], f[3]); o[2] = pack2(f[4], f[5]); o[3] = pack2(f[6], f[7]);
    }
    *(u32x4*)(dst + (size_t)n * K + kc * 8) = o;
  }
}

DI void phase0(const Params& p) {
  const int tid = opaque_tid(), lane = tid & 63, wave = tid >> 6;
  const int gthreads = gridDim.x * NTHR, gtid = blockIdx.x * NTHR + tid;
  const int gwaves = gridDim.x * 8, gwave = blockIdx.x * 8 + wave;
  bf16_t* HN = (bf16_t*)(p.ws + OFF_HN);
  for (int row = gwave; row < NTOK; row += gwaves) {
    const float4* xr = (const float4*)(p.x + (size_t)row * 1024);
    float4 v[4];
    float ss = 0.f;
#pragma unroll
    for (int i = 0; i < 4; ++i) {
      v[i] = xr[i * 64 + lane];
      ss += v[i].x * v[i].x + v[i].y * v[i].y + v[i].z * v[i].z + v[i].w * v[i].w;
    }
    ss = wave_sum(ss, lane);
    const float rstd = rsqrtf(ss * (1.f / 1024.f) + 1e-6f);
#pragma unroll
    for (int i = 0; i < 4; ++i) {
      const float4 g = ((const float4*)p.norm_in_g)[i * 64 + lane];
      u32x2 o;
      o[0] = pack2(v[i].x * rstd * g.x, v[i].y * rstd * g.y);
      o[1] = pack2(v[i].z * rstd * g.z, v[i].w * rstd * g.w);
      *(u32x2*)(HN + (size_t)row * 1024 + (i * 64 + lane) * 4) = o;
    }
  }
  transpose_w(p.w_in, 3352, (bf16_t*)(p.ws + OFF_WTIN), NPAD, 1024, 1, gtid, gthreads);
  transpose_w(p.w_out, 1024, (bf16_t*)(p.ws + OFF_WTOUT), 1024, 1024, 0, gtid, gthreads);
  transpose_w(p.w_k1, 128, (bf16_t*)(p.ws + OFF_W1TK), 128, 2048, 0, gtid, gthreads);
  transpose_w(p.w_v1, 128, (bf16_t*)(p.ws + OFF_W1TV), 128, 2048, 0, gtid, gthreads);
  float* BIAS = (float*)(p.ws + OFF_BIAS);
  for (int it = gwave; it < 256; it += gwaves) {
    const int kv = it >> 7, e = it & 127;
    const float* w1 = kv ? p.w_v1 : p.w_k1;
    const float* pe = kv ? p.pe_v : p.pe_k;
    float s = 0.f;
    for (int kk = lane; kk < 2048; kk += 64) s += pe[kk] * w1[(size_t)kk * 128 + e];
    s = wave_sum(s, lane);
    if (lane == 0) BIAS[it] = s;
  }
  if (gtid == 0) { *(unsigned*)(p.ws + OFF_BAR) = 0u; *(unsigned*)(p.ws + OFF_QCTR) = 0u; }
  {
    float* RS = (float*)(p.ws + OFF_ROWSS);
    for (int id = gtid; id < NTOK; id += gthreads) RS[id] = 0.f;
    if (gtid < 256) ((unsigned*)(p.ws + OFF_PCNT))[gtid] = 0u;
  }
  {
    float* SMALL = (float*)(p.ws + OFF_SMALL);
    for (int id = gtid; id < SM_TOTAL; id += gthreads) {
      float v;
      if (id < SM_LNB) v = p.ln_g[id - SM_LNG];
      else if (id < SM_BSP) v = p.ln_b[id - SM_LNB];
      else if (id < SM_W2K) v = p.b_sp[id - SM_BSP];
      else if (id < SM_W2V) v = p.w_k2[id - SM_W2K];
      else if (id < SM_NFG) v = p.w_v2[id - SM_W2V];
      else v = p.norm_f_g[id - SM_NFG];
      SMALL[id] = v;
    }
  }
  bf16_t* WSP = (bf16_t*)(p.ws + OFF_WSP);
  for (int id = gtid; id < 8 * 128 * 128; id += gthreads) {
    const int t = (id >> 7) & 127, s = id & 127;
    WSP[id] = (s <= t) ? f2bf(p.w_sp[id]) : (bf16_t)0;
  }
}

namespace pg8 {
#define PG8_LAS __attribute__((address_space(3)))
typedef unsigned short bf16_t;
typedef short bf16x8 __attribute__((ext_vector_type(8)));
typedef float f32x4 __attribute__((ext_vector_type(4)));
typedef unsigned u32x4 __attribute__((ext_vector_type(4)));
constexpr int BM = 256, BK = 64, HALF = 128, HTB = HALF * BK * 2  , STAGE_BYTES = 8 * HTB, NXCD = 8, WGM = 4;

__host__ __device__ __forceinline__ int lds_byte(int r, int c) { const int st = (r >> 4) * 2 + (c >> 5), rr = r & 15, cc = c & 31, ob = rr * 64 + cc * 2; return st * 1024 + (ob ^ (((ob >> 9) & 1) << 5)); }
__host__ __device__ __forceinline__ void stage_rc(int b, int& R, int& C) { const int st = b / 1024, sb = b % 1024, swz = sb ^ (((sb >> 9) & 1) << 5); R = (st >> 1) * 16 + swz / 64; C = (st & 1) * 32 + (swz % 64) / 2; }
__host__ __device__ __forceinline__ int perm32(int rho) { const int n = rho >> 4, i = rho & 15; return 8 * (i >> 2) + 4 * n + (i & 3); }

struct Unit { int pm, pn; };
struct Gemm { const bf16_t* A; const bf16_t* Bt; int M, N, K; };

struct StaticOrder {
    int nM, nN, nwg, G, c;
    __host__ __device__ void init(int M, int N, int G_, int c_) { nM = M / BM; nN = N / BM; nwg = nM * nN; G = G_; c = c_; }
    __host__ __device__ bool next(int i, Unit& u) const {
        const long L = (long)i * G + c; if (L >= nwg) return false;
        int wgid = (int)L; { const int q = nwg / NXCD, r = nwg % NXCD, xcd = wgid % NXCD, off = wgid / NXCD; wgid = (xcd < r ? xcd * (q + 1) : r * (q + 1) + (xcd - r) * q) + off; }
        const int nig = WGM * nN, gid = wgid / nig, fm = gid * WGM, gsz = (nM - fm) < WGM ? (nM - fm) : WGM;
        u.pm = fm + ((wgid % nig) % gsz); u.pn = (wgid % nig) / gsz; return true;
    }
    __device__ __forceinline__ void a_ready(const Unit&) const {}
    __device__ __forceinline__ void done(const Unit&) const {}
};

template <class Epi, class Sched, bool STAMP = false>
__device__ __forceinline__ void gemm_phase(PG8_LAS unsigned char* lds, const Gemm g, const Sched& S, const Epi& E, unsigned long long* stamps, const int tid_in) {
    const int tid = tid_in, wid = __builtin_amdgcn_readfirstlane(tid >> 6), lane = tid & 63, wr = wid >> 2, wc = wid & 3, fr = lane & 15, fq = lane >> 4;
    const int K = g.K, nt = K / BK;
    int ts_lo = 0, ts_hi = 0, nts = 0; const unsigned long long rt_entry = STAMP ? (unsigned long long)wall_clock64() : 0ull;
#define PG8_STAMP() do { if (STAMP && wid == 0 && nts < 64) { const unsigned long long _c = (unsigned long long)clock64(); \
        ts_lo = (lane == nts) ? (int)(unsigned)_c : ts_lo; ts_hi = (lane == nts) ? (int)(unsigned)(_c >> 32) : ts_hi; ++nts; } } while (0)
    PG8_STAMP();
    unsigned voffA[2], voffB[2];
#pragma unroll
    for (int i = 0; i < 2; ++i) { int R, C; stage_rc(tid * 16 + i * 8192, R, C); const int Rb = Epi::PERM ? ((R & ~31) + perm32(R & 31)) : R;
        voffA[i] = (unsigned)(R * K + C) * 2u; voffB[i] = (unsigned)(Rb * K + C) * 2u; }
    const size_t kstep = (size_t)(BK * 2);
    const size_t hstep = (size_t)HALF * K * 2;
    const size_t tstep = 2 * hstep;
    const unsigned ldsw = (unsigned)wid * 1024u;
    const int aoff = lds_byte(wr * 64 + fr, fq * 8), boff = lds_byte(wc * 32 + fr, fq * 8);
#define PG8_SA(b, h) (((b) * 2 + (h)) * HTB)
#define PG8_SB(b, h) ((4 + (b) * 2 + (h)) * HTB)
#define PG8_STAGE(bufoff, gbase, voff) do { _Pragma("unroll") for (int _i = 0; _i < 2; ++_i) \
        __builtin_amdgcn_global_load_lds((const unsigned*)((const char*)(gbase) + (voff)[_i]), (PG8_LAS unsigned*)(lds + (bufoff) + ldsw + _i * 8192), 16, 0, 0); } while (0)
#define PG8_LDA(dst, b, h) do { _Pragma("unroll") for (int m = 0; m < 4; ++m) _Pragma("unroll") for (int k = 0; k < 2; ++k) dst[m][k] = *(const PG8_LAS bf16x8*)(lds + PG8_SA(b, h) + aoff + m * 2048 + k * 1024); } while (0)
#define PG8_LDB(dst, b, h) do { _Pragma("unroll") for (int n = 0; n < 2; ++n) _Pragma("unroll") for (int k = 0; k < 2; ++k) dst[n][k] = *(const PG8_LAS bf16x8*)(lds + PG8_SB(b, h) + boff + n * 2048 + k * 1024); } while (0)
#define PG8_MMA(ai, bj, At, Bt) do { __builtin_amdgcn_s_setprio(1); _Pragma("unroll") for (int m = 0; m < 4; ++m) _Pragma("unroll") for (int n = 0; n < 2; ++n) _Pragma("unroll") for (int k = 0; k < 2; ++k) \
        acc[ai][bj][m][n] = __builtin_amdgcn_mfma_f32_16x16x32_bf16(Bt[n][k], At[m][k], acc[ai][bj][m][n], 0, 0, 0); __builtin_amdgcn_s_setprio(0); } while (0)
#define PG8_WAIT_V(n) asm volatile("s_waitcnt vmcnt(" #n ")" ::: "memory")
#define PG8_WAIT_L(n) asm volatile("s_waitcnt lgkmcnt(" #n ")" ::: "memory")
#define PG8_BAR __builtin_amdgcn_s_barrier()
#define PG8_SCHED __builtin_amdgcn_sched_barrier(0)
    Unit cur, nxt; int ui = 0;
    if (!S.next(0, cur)) return;
    f32x4 acc[2][2][4][2];
#pragma unroll
    for (int a = 0; a < 2; ++a)
#pragma unroll
        for (int b = 0; b < 2; ++b)
#pragma unroll
            for (int m = 0; m < 4; ++m)
#pragma unroll
                for (int n = 0; n < 2; ++n) acc[a][b][m][n] = (f32x4){0.f, 0.f, 0.f, 0.f};
    bf16x8 At[4][2], B0[2][2], B1[2][2];
    const char* cA = (const char*)g.A + (size_t)cur.pm * tstep; const char* cB = (const char*)g.Bt + (size_t)cur.pn * tstep;
    S.a_ready(cur);
    PG8_STAGE(PG8_SB(0, 0), cB, voffB); PG8_STAGE(PG8_SA(0, 0), cA, voffA); PG8_STAGE(PG8_SB(0, 1), cB + hstep, voffB); PG8_STAGE(PG8_SA(0, 1), cA + hstep, voffA);
    if (wr == 1) PG8_BAR;
    PG8_WAIT_V(4); PG8_BAR;
    PG8_STAGE(PG8_SB(1, 0), cB + kstep, voffB); PG8_STAGE(PG8_SA(1, 0), cA + kstep, voffA); PG8_STAGE(PG8_SB(1, 1), cB + hstep + kstep, voffB);
    PG8_WAIT_V(6); PG8_BAR;
    PG8_STAMP();
    for (;;) {
        const bool has_next = S.next(ui + 1, nxt);
        const char* nA = has_next ? (const char*)g.A + (size_t)nxt.pm * tstep : cA; const char* nB = has_next ? (const char*)g.Bt + (size_t)nxt.pn * tstep : cB;
        for (int t = 0; t < nt; t += 2) {
            const bool last = (t == nt - 2);
            const char* a1 = cA + (size_t)(t + 1) * kstep;
            const char* a2 = last ? nA : cA + (size_t)(t + 2) * kstep; const char* b2 = last ? nB : cB + (size_t)(t + 2) * kstep;
            const char* a3 = a2 + kstep; const char* b3 = b2 + kstep;
            if (last && has_next) S.a_ready(nxt);
            PG8_LDB(B0, 0, 0); PG8_SCHED; PG8_LDA(At, 0, 0); PG8_STAGE(PG8_SA(1, 1), a1 + hstep, voffA);
            PG8_WAIT_L(8); PG8_BAR; PG8_WAIT_L(0); PG8_MMA(0, 0, At, B0); PG8_BAR; PG8_SCHED;
            PG8_LDB(B1, 0, 1); PG8_STAGE(PG8_SB(0, 0), b2, voffB);
            PG8_BAR; PG8_WAIT_L(0); PG8_MMA(0, 1, At, B1); PG8_BAR;
            PG8_LDA(At, 0, 1); PG8_STAGE(PG8_SA(0, 0), a2, voffA);
            PG8_BAR; PG8_WAIT_L(0); PG8_MMA(1, 0, At, B0); PG8_BAR; PG8_SCHED;
            PG8_STAGE(PG8_SB(0, 1), b2 + hstep, voffB);
            PG8_WAIT_V(6); PG8_BAR; PG8_MMA(1, 1, At, B1); PG8_BAR;
            PG8_LDB(B0, 1, 0); PG8_SCHED; PG8_LDA(At, 1, 0); PG8_STAGE(PG8_SA(0, 1), a2 + hstep, voffA);
            PG8_WAIT_L(8); PG8_BAR; PG8_WAIT_L(0); PG8_MMA(0, 0, At, B0); PG8_BAR; PG8_SCHED;
            PG8_LDB(B1, 1, 1); PG8_STAGE(PG8_SB(1, 0), b3, voffB);
            PG8_BAR; PG8_WAIT_L(0); PG8_MMA(0, 1, At, B1); PG8_BAR;
            PG8_LDA(At, 1, 1); PG8_STAGE(PG8_SA(1, 0), a3, voffA);
            PG8_BAR; PG8_WAIT_L(0); PG8_MMA(1, 0, At, B0); PG8_BAR; PG8_SCHED;
            PG8_STAGE(PG8_SB(1, 1), b3 + hstep, voffB);
            PG8_WAIT_V(6); PG8_BAR; PG8_MMA(1, 1, At, B1); PG8_BAR;
        }
        PG8_STAMP();
        if constexpr (!Epi::AFTER_DRAIN) { E(acc, cur, wr, wc, fr, fq); S.done(cur); }
        PG8_STAMP();
        if (!has_next) break;
#pragma unroll
        for (int a = 0; a < 2; ++a)
#pragma unroll
            for (int b = 0; b < 2; ++b)
#pragma unroll
                for (int m = 0; m < 4; ++m)
#pragma unroll
                    for (int n = 0; n < 2; ++n) acc[a][b][m][n] = (f32x4){0.f, 0.f, 0.f, 0.f};
        cur = nxt; cA = nA; cB = nB; ++ui;
    }
    PG8_WAIT_V(0);
    if (wr == 0) PG8_BAR;
    PG8_BAR;
    if constexpr (Epi::AFTER_DRAIN) { E.fused(acc, cur, wr, wc, fr, fq, lds, wid, lane); S.done(cur); }
    PG8_STAMP();
    if (STAMP && wid == 0) { stamps[lane] = lane < nts ? (((unsigned long long)(unsigned)ts_hi << 32) | (unsigned)ts_lo) : 0ull;
        if (lane == 62) stamps[62] = rt_entry; if (lane == 63) stamps[63] = (unsigned long long)wall_clock64(); }
#undef PG8_STAMP
#undef PG8_SA
#undef PG8_SB
#undef PG8_STAGE
#undef PG8_LDA
#undef PG8_LDB
#undef PG8_MMA
#undef PG8_WAIT_V
#undef PG8_WAIT_L
#undef PG8_BAR
#undef PG8_SCHED
}
}

struct PanelOrder {
  int c, npn;
  __device__ bool next(int i, pg8::Unit& u) const { if (i >= npn) return false; u.pm = c; u.pn = i; return true; }
  __device__ __forceinline__ void a_ready(const pg8::Unit&) const {}
  __device__ __forceinline__ void done(const pg8::Unit&) const {}
};

struct EpiP1 {
  static constexpr bool PERM = true, AFTER_DRAIN = false;
  char* ws;
  __device__ __forceinline__ void operator()(const pg8::f32x4 (&acc)[2][2][4][2], const pg8::Unit& u, int wr, int wc, int fr, int fq) const {
#pragma unroll
    for (int bj = 0; bj < 2; ++bj) {
      const int nt = u.pn * 2 + bj;
      if (nt >= 27) continue;
      const int cn0 = wc * 32 + fq * 8;
      bf16_t* dst = nullptr;
      int ld = 512, colbase = 0, act = 0;
      bool transposed = false;
      if (nt < 4) { dst = (bf16_t*)(ws + OFF_Q); colbase = nt * 128; act = 1; }
      else if (nt == 4) { dst = (bf16_t*)(ws + OFF_KC); ld = 128; }
      else if (nt == 5) { dst = (bf16_t*)(ws + OFF_VC); ld = 128; }
      else if (nt == 6) { dst = (bf16_t*)(ws + OFF_KS); ld = 128; }
      else if (nt == 7) { dst = (bf16_t*)(ws + OFF_VST); transposed = true; }
      else if (nt == 8) { dst = (bf16_t*)(ws + OFF_KW); ld = 128; }
      else if (nt == 9) { dst = (bf16_t*)(ws + OFF_VWT); transposed = true; }
      else if (nt < 14) { dst = (bf16_t*)(ws + OFF_ZN); colbase = (nt - 10) * 128; }
      else if (nt < 18) { dst = (bf16_t*)(ws + OFF_U); colbase = (nt - 14) * 128; }
      else if (nt < 22) { dst = (bf16_t*)(ws + OFF_V); colbase = (nt - 18) * 128; }
      else if (nt < 26) { dst = (bf16_t*)(ws + OFF_ZG); colbase = (nt - 22) * 128; }
#pragma unroll
      for (int ai = 0; ai < 2; ++ai)
#pragma unroll
        for (int m = 0; m < 4; ++m) {
          const int row = u.pm * 256 + ai * 128 + wr * 64 + m * 16 + fr;
          float v[8];
#pragma unroll
          for (int j = 0; j < 4; ++j) { v[j] = acc[ai][bj][m][0][j]; v[4 + j] = acc[ai][bj][m][1][j]; }
          if (nt == 26) {
            if (cn0 < 24) {
              float* G = (float*)(ws + OFF_GATES) + (size_t)row * 24 + cn0;
              float4 g0, g1;
              g0.x = sigmoid_f(v[0]); g0.y = sigmoid_f(v[1]); g0.z = sigmoid_f(v[2]); g0.w = sigmoid_f(v[3]);
              g1.x = sigmoid_f(v[4]); g1.y = sigmoid_f(v[5]); g1.z = sigmoid_f(v[6]); g1.w = sigmoid_f(v[7]);
              *(float4*)G = g0;
              *(float4*)(G + 4) = g1;
            }
          } else if (transposed) {
            const int b = row >> 12, t = row & 4095;
            bf16_t* dp = dst + ((size_t)((b * 2 + (cn0 >> 6)) * 64 + (cn0 & 63))) * 4096 + t;
#pragma unroll
            for (int j = 0; j < 8; ++j) dp[(size_t)j * 4096] = f2bf(v[j]);
          } else {
            if (act == 1) {
#pragma unroll
              for (int j = 0; j < 8; ++j) v[j] *= 0.125f;
            } else if (act == 2) {
#pragma unroll
              for (int j = 0; j < 8; ++j) v[j] = silu_f(v[j]);
            } else if (act == 3) {
#pragma unroll
              for (int j = 0; j < 8; ++j) v[j] = gelu_t(v[j]);
            }
            u32x4 o;
            o[0] = pack2(v[0], v[1]); o[1] = pack2(v[2], v[3]); o[2] = pack2(v[4], v[5]); o[3] = pack2(v[6], v[7]);
            *(u32x4*)(dst + (size_t)row * ld + colbase + cn0) = o;
          }
          __builtin_amdgcn_sched_barrier(0);
        }
    }
  }
};

struct EpiP4 {
  static constexpr bool PERM = true, AFTER_DRAIN = false;
  const float* x;
  bf16_t* hb;
  float* rowss;
  __device__ __forceinline__ void operator()(const pg8::f32x4 (&acc)[2][2][4][2], const pg8::Unit& u, int wr, int wc, int fr_in, int fq) const {
    int fr = fr_in;
    asm volatile("" : "+v"(fr));
    int pm_ = u.pm;
    asm volatile("" : "+s"(pm_));
#pragma unroll
    for (int ai = 0; ai < 2; ++ai)
#pragma unroll
      for (int m = 0; m < 4; ++m) {
        const int rl = ai * 128 + wr * 64 + m * 16 + fr;
        const size_t rowoff = ((size_t)pm_ * 256 + rl) * 1024;
        float4 xv[2][2];
#pragma unroll
        for (int bj = 0; bj < 2; ++bj) {
          const int col = u.pn * 256 + bj * 128 + wc * 32 + fq * 8;
          xv[bj][0] = *(const float4*)(x + rowoff + col);
          xv[bj][1] = *(const float4*)(x + rowoff + col + 4);
        }
        float ss = 0.f;
#pragma unroll
        for (int bj = 0; bj < 2; ++bj) {
          const int col = u.pn * 256 + bj * 128 + wc * 32 + fq * 8;
          float v[8];
          v[0] = acc[ai][bj][m][0][0] + xv[bj][0].x; v[1] = acc[ai][bj][m][0][1] + xv[bj][0].y;
          v[2] = acc[ai][bj][m][0][2] + xv[bj][0].z; v[3] = acc[ai][bj][m][0][3] + xv[bj][0].w;
          v[4] = acc[ai][bj][m][1][0] + xv[bj][1].x; v[5] = acc[ai][bj][m][1][1] + xv[bj][1].y;
          v[6] = acc[ai][bj][m][1][2] + xv[bj][1].z; v[7] = acc[ai][bj][m][1][3] + xv[bj][1].w;
#pragma unroll
          for (int j = 0; j < 8; ++j) ss += v[j] * v[j];
          u32x4 o;
          o[0] = pack2(v[0], v[1]); o[1] = pack2(v[2], v[3]); o[2] = pack2(v[4], v[5]); o[3] = pack2(v[6], v[7]);
          *(u32x4*)(hb + rowoff + col) = o;
        }
        ss += shx(ss, 16, fq * 16 + fr);
        ss += shx(ss, 32, fq * 16 + fr);
        if (fq == 0) __hip_atomic_fetch_add(rowss + (size_t)pm_ * 256 + rl, ss, __ATOMIC_RELAXED, __HIP_MEMORY_SCOPE_AGENT);
      }
  }
};

DI void compress_item(const Params& p, char* smem, int it, bool active) {
  const int tid = opaque_tid() & 255, lane = tid & 63, wave = tid >> 6;
  const int r = lane & 31, h = lane >> 5;
  const int kv = it >> 8, b = (it >> 4) & 15, g = (it >> 3) & 1, n0 = (it & 7) * 32;
  float* hidL = (float*)smem;
  if (active) {
    const bf16_t* src = (const bf16_t*)(p.ws + (kv ? OFF_VC : OFF_KC));
    const bf16_t* w1t = (const bf16_t*)(p.ws + (kv ? OFF_W1TV : OFF_W1TK));
    const float* bias = (const float*)(p.ws + OFF_BIAS) + kv * 128;
    f32x16 acc;
#pragma unroll
    for (int i = 0; i < 16; ++i) acc[i] = 0.f;
    const int n = n0 + r;
    const bf16_t* brow = w1t + (size_t)(32 * wave + r) * 2048 + h * 8;
#pragma unroll 2
    for (int l = 0; l < 32; ++l) {
      int tok = 16 * n + l;
      tok = tok > 4095 ? 4095 : tok;
      const bf16_t* arow = src + ((size_t)b * 4096 + tok) * 128 + g * 64 + h * 8;
#pragma unroll
      for (int s = 0; s < 4; ++s) {
        const s16x8 af = *(const s16x8*)(arow + s * 16);
        const s16x8 bfr = *(const s16x8*)(brow + l * 64 + s * 16);
        acc = MFMA32(af, bfr, acc);
      }
    }
    const int e = 32 * wave + r;
    const float be = bias[e];
#pragma unroll
    for (int i = 0; i < 16; ++i) hidL[crow(i, h) * 132 + e] = gelu_t(acc[i] + be);
  }
  __syncthreads();
  if (active) {
    const float* w2 = (const float*)(p.ws + OFF_SMALL) + (kv ? SM_W2V : SM_W2K);
    const int f = tid & 63, ng = tid >> 6;
    float o[8];
#pragma unroll
    for (int k = 0; k < 8; ++k) o[k] = 0.f;
    for (int e = 0; e < 128; ++e) {
      const float wv = w2[e * 64 + f];
#pragma unroll
      for (int k = 0; k < 8; ++k) o[k] += hidL[(ng * 8 + k) * 132 + e] * wv;
    }
    const int bg = b * 2 + g;
#pragma unroll
    for (int k = 0; k < 8; ++k) {
      const int nn = n0 + ng * 8 + k;
      const float val = (nn < 255) ? o[k] : 0.f;
      if (kv == 0) ((bf16_t*)(p.ws + OFF_KCMP))[((size_t)bg * 256 + nn) * 64 + f] = f2bf(val);
      else ((bf16_t*)(p.ws + OFF_VCMPT))[((size_t)bg * 64 + f) * 256 + nn] = f2bf(val);
    }
  }
  __syncthreads();
}

DI void gmlp_item(const Params& p, char* smem, int it, bool active) {
  const int tid = opaque_tid() & 255, lane = tid & 63, wave = tid >> 6;
  const int r = lane & 31, h = lane >> 5;
  const int gg = it & 7, ck = (it >> 3) & 31, b = it >> 8;
  const size_t tokbase = (size_t)b * 4096 + ck * 128;
  const bf16_t* V = (const bf16_t*)(p.ws + OFF_V);
  const bf16_t* U = (const bf16_t*)(p.ws + OFF_U);
  const bf16_t* ZG = (const bf16_t*)(p.ws + OFF_ZG);
  const bf16_t* WSP = (const bf16_t*)(p.ws + OFF_WSP);
  bf16_t* MIX = (bf16_t*)(p.ws + OFF_MIX);
  const float* SMALLP = (const float*)(p.ws + OFF_SMALL);
  char* vnT = smem;
  float* mxl = (float*)(smem + 17408);
  const int tl = tid >> 1, half = tid & 1, d0 = half * 32;
  u32x4 uu4[4], zz4[4];
  if (active) {
    const size_t off0 = (tokbase + tl) * 512 + gg * 64 + d0;
#pragma unroll
    for (int q = 0; q < 4; ++q) { uu4[q] = *(const u32x4*)(U + off0 + q * 8); zz4[q] = *(const u32x4*)(ZG + off0 + q * 8); }
  }
  if (active) {
    float v[32];
    const bf16_t* vp = V + (tokbase + tl) * 512 + gg * 64 + d0;
#pragma unroll
    for (int q = 0; q < 4; ++q) {
      const u32x4 w = *(const u32x4*)(vp + q * 8);
#pragma unroll
      for (int k = 0; k < 4; ++k) { const f2a g2 = gelu2((f2a){bflo(w[k]), bfhi(w[k])}); v[q * 8 + 2 * k] = g2.x; v[q * 8 + 2 * k + 1] = g2.y; }
    }
    float s1 = 0.f;
#pragma unroll
    for (int j = 0; j < 32; ++j) s1 += v[j];
    s1 += shx(s1, 1, lane);
    const float mu = s1 * (1.f / 64.f);
    float s2 = 0.f;
#pragma unroll
    for (int j = 0; j < 32; ++j) { const float d = v[j] - mu; s2 += d * d; }
    s2 += shx(s2, 1, lane);
    const float rstd = rsqrtf(s2 * (1.f / 64.f) + 1e-6f);
#pragma unroll
    for (int j = 0; j < 32; ++j) {
      const float vn = (v[j] - mu) * rstd * SMALLP[SM_LNG + gg * 64 + d0 + j] + SMALLP[SM_LNB + gg * 64 + d0 + j];
      *(bf16_t*)(vnT + (d0 + j) * 272 + tl * 2) = f2bf(vn);
    }
  }
  __syncthreads();
  if (active) {
    f32x16 acc[2];
#pragma unroll
    for (int c = 0; c < 2; ++c)
#pragma unroll
      for (int i = 0; i < 16; ++i) acc[c][i] = 0.f;
    const bf16_t* arow = WSP + ((size_t)gg * 128 + 32 * wave + r) * 128 + h * 8;
    const int nks = 2 * (wave + 1);
    for (int ks = 0; ks < nks; ++ks) {
      const s16x8 af = *(const s16x8*)(arow + ks * 16);
#pragma unroll
      for (int c = 0; c < 2; ++c) {
        const s16x8 bfr = *(const s16x8*)(vnT + (c * 32 + r) * 272 + (ks * 16 + h * 8) * 2);
        acc[c] = MFMA32(af, bfr, acc[c]);
      }
    }
#pragma unroll
    for (int i = 0; i < 16; ++i) {
      const int t = 32 * wave + crow(i, h);
      const float bs = SMALLP[SM_BSP + gg * 128 + t];
#pragma unroll
      for (int c = 0; c < 2; ++c) mxl[t * 68 + c * 32 + r] = acc[c][i] + bs;
    }
  }
  __syncthreads();
  if (active) {
    const size_t off = (tokbase + tl) * 512 + gg * 64 + d0;
    bf16_t* op = MIX + (tokbase + tl) * 1024 + 512 + gg * 64 + d0;
#pragma unroll
    for (int q = 0; q < 4; ++q) {
      const u32x4 uu = uu4[q];
      const u32x4 zz = zz4[q];
      const float4 m0 = *(const float4*)(mxl + tl * 68 + d0 + q * 8);
      const float4 m1 = *(const float4*)(mxl + tl * 68 + d0 + q * 8 + 4);
      u32x4 o;
#define GM2_(uw, zw, ma, mb) pack2v(gelu2((f2a){bflo(uw), bfhi(uw)}) * (f2a){(ma), (mb)} * silu2((f2a){bflo(zw), bfhi(zw)}))
      o[0] = GM2_(uu[0], zz[0], m0.x, m0.y);
      o[1] = GM2_(uu[1], zz[1], m0.z, m0.w);
      o[2] = GM2_(uu[2], zz[2], m1.x, m1.y);
      o[3] = GM2_(uu[3], zz[3], m1.z, m1.w);
#undef GM2_
      *(u32x4*)(op + q * 8) = o;
    }
  }
  __syncthreads();
}

DI void qk1(const char* Kl, const s16x8 (&qf)[4], f32x16 (&S)[2], int r, int h) {
#pragma unroll
  for (int a = 0; a < 2; ++a)
#pragma unroll
    for (int i = 0; i < 16; ++i) S[a][i] = 0.f;
#pragma unroll
  for (int kt2 = 0; kt2 < 2; ++kt2)
#pragma unroll
    for (int s = 0; s < 4; ++s) {
      const s16x8 kf = *(const s16x8*)(Kl + (kt2 * 32 + r) * 144 + s * 32 + h * 16);
      S[kt2] = MFMA32(kf, qf[s], S[kt2]);
    }
}
DI void pv1(const char* Vl, const f32x16 (&S)[2], f32x16 (&O)[2], int r, int h) {
#pragma unroll
  for (int kt2 = 0; kt2 < 2; ++kt2)
#pragma unroll
    for (int s2 = 0; s2 < 2; ++s2) {
      u32x4 pk;
      pk[0] = pack2(S[kt2][8 * s2 + 0], S[kt2][8 * s2 + 1]);
      pk[1] = pack2(S[kt2][8 * s2 + 2], S[kt2][8 * s2 + 3]);
      pk[2] = pack2(S[kt2][8 * s2 + 4], S[kt2][8 * s2 + 5]);
      pk[3] = pack2(S[kt2][8 * s2 + 6], S[kt2][8 * s2 + 7]);
      const s16x8 pf = __builtin_bit_cast(s16x8, pk);
#pragma unroll
      for (int dt = 0; dt < 2; ++dt) {
        const char* vp = Vl + (dt * 32 + r) * 144 + (kt2 * 32 + 16 * s2 + 4 * h) * 2;
        const s16x4 lo = *(const s16x4*)(vp);
        const s16x4 hi = *(const s16x4*)(vp + 16);
        const s16x8 vf = __builtin_shufflevector(lo, hi, 0, 1, 2, 3, 4, 5, 6, 7);
        O[dt] = MFMA32(vf, pf, O[dt]);
      }
    }
}
DI float max3f(float a, float b, float c) {
  float d;
  asm("v_max3_f32 %0, %1, %2, %3" : "=v"(d) : "v"(a), "v"(b), "v"(c));
  return d;
}
typedef float f2v __attribute__((ext_vector_type(2)));
DI float max17f(float a, const f32x16& x) {
  float d;
  asm("v_max3_f32 %0, %1, %2, %3\n\t"
      "v_max3_f32 %0, %0, %4, %5\n\t"
      "v_max3_f32 %0, %0, %6, %7\n\t"
      "v_max3_f32 %0, %0, %8, %9\n\t"
      "v_max3_f32 %0, %0, %10, %11\n\t"
      "v_max3_f32 %0, %0, %12, %13\n\t"
      "v_max3_f32 %0, %0, %14, %15\n\t"
      "v_max3_f32 %0, %0, %16, %17"
      : "=&v"(d)
      : "v"(a), "v"(x[0]), "v"(x[1]), "v"(x[2]), "v"(x[3]), "v"(x[4]), "v"(x[5]), "v"(x[6]), "v"(x[7]), "v"(x[8]), "v"(x[9]),
        "v"(x[10]), "v"(x[11]), "v"(x[12]), "v"(x[13]), "v"(x[14]), "v"(x[15]));
  return d;
}

DI void softmax1(f32x16 (&S)[2], int kbase, int lo, int hi, bool fast, bool rowok, float& m, float& l,
                 f32x16 (&O)[2], int h, int lane) {
  float mx = -1e30f;
  const int lo2 = lo - kbase - 4 * h, hi2 = hi - kbase - 4 * h;
  if (fast) {
#pragma unroll
    for (int kt2 = 0; kt2 < 2; ++kt2) mx = max17f(mx, S[kt2]);
    mx = rowok ? mx : -1e30f;
  } else {
#pragma unroll
    for (int kt2 = 0; kt2 < 2; ++kt2)
#pragma unroll
      for (int i = 0; i < 16; ++i) {
        const int ci = kt2 * 32 + (i & 3) + 8 * (i >> 2);
        mx = (ci >= lo2 && ci <= hi2) ? fmaxf(mx, S[kt2][i]) : mx;
      }
  }
  mx = xhalf_max(mx);
  const float mnew = fmaxf(m, mx);
  const float alpha = __builtin_amdgcn_exp2f((m - mnew) * L2E);
  const float mL = mnew * L2E;
  float sum = 0.f;
  if (fast) {
    const float mLe = rowok ? mL : 3.0e38f;
    f2v sumv = {0.f, 0.f};
#pragma unroll
    for (int kt2 = 0; kt2 < 2; ++kt2)
#pragma unroll
      for (int i = 0; i < 16; i += 2) {
        f2v t = {S[kt2][i], S[kt2][i + 1]};
        t = __builtin_elementwise_fma(t, (f2v){L2E, L2E}, (f2v){-mLe, -mLe});
        f2v pv2 = {__builtin_amdgcn_exp2f(t.x), __builtin_amdgcn_exp2f(t.y)};
        S[kt2][i] = pv2.x;
        S[kt2][i + 1] = pv2.y;
        sumv += pv2;
      }
    sum = sumv.x + sumv.y;
  } else {
#pragma unroll
    for (int kt2 = 0; kt2 < 2; ++kt2)
#pragma unroll
      for (int i = 0; i < 16; ++i) {
        const int ci = kt2 * 32 + (i & 3) + 8 * (i >> 2);
        const float pv = (ci >= lo2 && ci <= hi2) ? __builtin_amdgcn_exp2f(__builtin_fmaf(S[kt2][i], L2E, -mL)) : 0.f;
        S[kt2][i] = pv;
        sum += pv;
      }
  }
  l = l * alpha + sum;
  if (__builtin_amdgcn_ballot_w64(mnew > m) != 0ull) {
#pragma unroll
    for (int dt = 0; dt < 2; ++dt)
#pragma unroll
      for (int i = 0; i < 16; ++i) O[dt][i] *= alpha;
  }
  m = mnew;
}

DI void attn_item(const Params& p, char* smem, int c, int b, int g) {
  const int tid = opaque_tid(), lane = tid & 63, wave = tid >> 6;
  const int r = lane & 31, h = lane >> 5;
  const int hl = wave & 3, qt = wave >> 2;
  const int hd = g * 4 + hl, bg = b * 2 + g;
  const int ql = qt * 32 + r;
  const size_t tok = (size_t)b * 4096 + c * 64 + ql;
  const int tq = c * 64 + ql;
  float* imp = (float*)(smem + 36864);
  unsigned char* selm = (unsigned char*)(smem + 53248);
  const bf16_t* KCMP = (const bf16_t*)(p.ws + OFF_KCMP) + (size_t)bg * 256 * 64;
  const bf16_t* VCMPT = (const bf16_t*)(p.ws + OFF_VCMPT) + (size_t)bg * 64 * 256;
  const bf16_t* KS = (const bf16_t*)(p.ws + OFF_KS) + (size_t)b * 4096 * 128 + g * 64;
  const bf16_t* KW = (const bf16_t*)(p.ws + OFF_KW) + (size_t)b * 4096 * 128 + g * 64;
  const bf16_t* VST = (const bf16_t*)(p.ws + OFF_VST) + (size_t)bg * 64 * 4096;
  const bf16_t* VWT = (const bf16_t*)(p.ws + OFF_VWT) + (size_t)bg * 64 * 4096;

  s16x8 qf[4];
  {
    const bf16_t* qp = (const bf16_t*)(p.ws + OFF_Q) + tok * 512 + hd * 64 + h * 8;
#pragma unroll
    for (int s = 0; s < 4; ++s) qf[s] = *(const s16x8*)(qp + s * 16);
  }
  const float* gp = (const float*)(p.ws + OFF_GATES) + tok * 24 + hd * 3;
  const float gate0 = gp[0], gate1 = gp[1], gate2 = gp[2];

  const int nct = ((4 * c + 2) >> 6) + 1, nsel = c + 1, j0 = c >= 8 ? c - 8 : 0, nwin = c - j0 + 1;
  const int total = 2 * nct + nsel + nwin;
  const int srow = tid >> 3, scc = tid & 7;
  u32x4 kreg, vreg;
#define ATT_ISSUE(sidx)                                                                          \
  do {                                                                                           \
    const int s_ = (sidx);                                                                       \
    const bf16_t *kp_, *vp_;                                                                     \
    int kpi_, vpi_;                                                                              \
    if (s_ < 2 * nct) { const int ct_ = s_ < nct ? s_ : s_ - nct; kp_ = KCMP + ct_ * 4096; kpi_ = 64; vp_ = VCMPT + ct_ * 64; vpi_ = 256; } \
    else if (s_ < 2 * nct + nsel) { const int j_ = s_ - 2 * nct; kp_ = KS + (size_t)j_ * 8192; kpi_ = 128; vp_ = VST + j_ * 64; vpi_ = 4096; } \
    else { const int j_ = j0 + s_ - 2 * nct - nsel; kp_ = KW + (size_t)j_ * 8192; kpi_ = 128; vp_ = VWT + j_ * 64; vpi_ = 4096; } \
    kreg = *(const u32x4*)(kp_ + srow * kpi_ + scc * 8);                                         \
    vreg = *(const u32x4*)(vp_ + (size_t)srow * vpi_ + scc * 8);                                 \
  } while (0)
#define ATT_COMMIT(buf)                                                                          \
  do {                                                                                           \
    *(u32x4*)(smem + (buf) * 9216 + srow * 144 + scc * 16) = kreg;                               \
    *(u32x4*)(smem + 18432 + (buf) * 9216 + srow * 144 + scc * 16) = vreg;                       \
  } while (0)
#define ATT_PRE(s)  do { if ((s) + 1 < total) ATT_ISSUE((s) + 1); } while (0)
#define ATT_POST(s) do { if ((s) + 1 < total) ATT_COMMIT(((s) + 1) & 1); __syncthreads(); } while (0)

  ATT_ISSUE(0);
  ATT_COMMIT(0);
  for (int i = tid; i < 4096; i += NTHR) imp[i] = 0.f;
  __syncthreads();

  f32x16 S[2], O[2], Oout[2];
  float m, l;
  int s = 0;
  const int hic = (tq - 31) >> 4;
  m = -1e30f; l = 0.f;
  for (int ct = 0; ct < nct; ++ct, ++s) {
    ATT_PRE(s);
    qk1(smem + (s & 1) * 9216, qf, S, r, h);
    float mx = -1e30f;
    const int hi2 = hic - ct * 64 - 4 * h;
#pragma unroll
    for (int kt2 = 0; kt2 < 2; ++kt2)
#pragma unroll
      for (int i = 0; i < 16; ++i) {
        const int ci = kt2 * 32 + (i & 3) + 8 * (i >> 2);
        mx = (ci <= hi2) ? fmaxf(mx, S[kt2][i]) : mx;
      }
    mx = xhalf_max(mx);
    const float mnew = fmaxf(m, mx);
    const float alpha = __builtin_amdgcn_exp2f((m - mnew) * L2E);
    const float mL = mnew * L2E;
    float sum = 0.f;
#pragma unroll
    for (int kt2 = 0; kt2 < 2; ++kt2)
#pragma unroll
      for (int i = 0; i < 16; ++i) {
        const int ci = kt2 * 32 + (i & 3) + 8 * (i >> 2);
        sum += (ci <= hi2) ? __builtin_amdgcn_exp2f(__builtin_fmaf(S[kt2][i], L2E, -mL)) : 0.f;
      }
    l = l * alpha + sum;
    m = mnew;
    ATT_POST(s);
  }
  {
    const float lt = xhalf_sum(l);
    const float inv = (hic >= 0 && lt > 0.f) ? 1.f / lt : 0.f;
    const float mL = m * L2E;
#pragma unroll
    for (int a = 0; a < 2; ++a)
#pragma unroll
      for (int i = 0; i < 16; ++i) O[a][i] = 0.f;
    for (int ct = 0; ct < nct; ++ct, ++s) {
      ATT_PRE(s);
      qk1(smem + (s & 1) * 9216, qf, S, r, h);
      const int hi2 = hic - ct * 64 - 4 * h;
#pragma unroll
      for (int kt2 = 0; kt2 < 2; ++kt2)
#pragma unroll
        for (int i = 0; i < 16; ++i) {
          const int ci = kt2 * 32 + (i & 3) + 8 * (i >> 2);
          S[kt2][i] = (ci <= hi2) ? __builtin_amdgcn_exp2f(__builtin_fmaf(S[kt2][i], L2E, -mL)) * inv : 0.f;
        }
      if (c >= 16) {
        float* irow = imp + ql * 64;
#pragma unroll
        for (int kt2 = 0; kt2 < 2; ++kt2)
#pragma unroll
          for (int gi = 0; gi < 4; ++gi) {
            const int jb = ct * 16 + kt2 * 8 + 2 * gi + h;
            const float a4 = (S[kt2][4 * gi] + S[kt2][4 * gi + 1]) + (S[kt2][4 * gi + 2] + S[kt2][4 * gi + 3]);
            __hip_atomic_fetch_add(irow + jb, a4, __ATOMIC_RELAXED, __HIP_MEMORY_SCOPE_WORKGROUP);
            if (jb + 1 < 64)
              __hip_atomic_fetch_add(irow + jb + 1, S[kt2][4 * gi + 3], __ATOMIC_RELAXED, __HIP_MEMORY_SCOPE_WORKGROUP);
          }
      }
      pv1(smem + 18432 + (s & 1) * 9216, S, O, r, h);
      ATT_POST(s);
    }
#pragma unroll
    for (int dt = 0; dt < 2; ++dt)
#pragma unroll
      for (int i = 0; i < 16; ++i) Oout[dt][i] = gate0 * O[dt][i];
  }
  {
    const int tr_ = opaque_tid();
    const int q = tr_ >> 3, part = tr_ & 7;
    unsigned bits = 0;
    if (c >= 16) {
      unsigned key[8];
#pragma unroll
      for (int k = 0; k < 8; ++k) {
        const int j = part * 8 + k;
        const unsigned u = __float_as_uint(imp[q * 64 + j]);
        key[k] = (j >= 1 && j <= c - 2) ? ((u & ~63u) | (unsigned)(63 - j)) : 0u;
      }
      for (int rd = 0; rd < 13; ++rd) {
        unsigned lm = key[0];
#pragma unroll
        for (int k = 1; k < 8; ++k) lm = lm > key[k] ? lm : key[k];
#pragma unroll
        for (int o = 1; o <= 4; o <<= 1) {
          const unsigned ot = shxu(lm, o, tr_ & 63);
          lm = lm > ot ? lm : ot;
        }
#pragma unroll
        for (int k = 0; k < 8; ++k) {
          const bool hit = (key[k] == lm) && (lm != 0u);
          bits |= hit ? (1u << k) : 0u;
          key[k] = hit ? 0u : key[k];
        }
      }
#pragma unroll
      for (int k = 0; k < 8; ++k) {
        const int j = part * 8 + k;
        if (j == 0 || j == c || j == c - 1) bits |= (1u << k);
      }
    } else {
#pragma unroll
      for (int k = 0; k < 8; ++k) {
        const int j = part * 8 + k;
        if (j <= c) bits |= (1u << k);
      }
    }
    selm[q * 8 + part] = (unsigned char)bits;
  }
  __syncthreads();
  const u64 sm = *(const u64*)(selm + ql * 8);

  m = -1e30f; l = 0.f;
#pragma unroll
  for (int a = 0; a < 2; ++a)
#pragma unroll
    for (int i = 0; i < 16; ++i) O[a][i] = 0.f;
  for (int j = 0; j <= c; ++j, ++s) {
    {
      const bool more_ = j < c;
      const bf16_t* kp_ = more_ ? KS + (size_t)(j + 1) * 8192 : KW + (size_t)j0 * 8192;
      const bf16_t* vp_ = more_ ? VST + (j + 1) * 64 : VWT + j0 * 64;
      kreg = *(const u32x4*)(kp_ + srow * 128 + scc * 8);
      vreg = *(const u32x4*)(vp_ + (size_t)srow * 4096 + scc * 8);
    }
    qk1(smem + (s & 1) * 9216, qf, S, r, h);
    const bool selq = ((sm >> j) & 1ull) != 0ull;
    softmax1(S, j * 64, 0, selq ? tq : -1, j < c, selq, m, l, O, h, lane);
    pv1(smem + 18432 + (s & 1) * 9216, S, O, r, h);
    ATT_POST(s);
  }
  {
    const float lt = xhalf_sum(l);
    const float sc = gate1 / lt;
#pragma unroll
    for (int dt = 0; dt < 2; ++dt)
#pragma unroll
      for (int i = 0; i < 16; ++i) Oout[dt][i] += sc * O[dt][i];
  }
  m = -1e30f; l = 0.f;
#pragma unroll
  for (int a = 0; a < 2; ++a)
#pragma unroll
    for (int i = 0; i < 16; ++i) O[a][i] = 0.f;
  for (int j = j0; j <= c; ++j, ++s) {
    if (j < c) {
      kreg = *(const u32x4*)(KW + (size_t)(j + 1) * 8192 + srow * 128 + scc * 8);
      vreg = *(const u32x4*)(VWT + (j + 1) * 64 + (size_t)srow * 4096 + scc * 8);
    }
    qk1(smem + (s & 1) * 9216, qf, S, r, h);
    softmax1(S, j * 64, tq - 511, tq, (j >= c - 7) && (j < c), true, m, l, O, h, lane);
    pv1(smem + 18432 + (s & 1) * 9216, S, O, r, h);
    ATT_POST(s);
  }
  {
    const float lt = xhalf_sum(l);
    const float sc = gate2 / lt;
#pragma unroll
    for (int dt = 0; dt < 2; ++dt)
#pragma unroll
      for (int i = 0; i < 16; ++i) Oout[dt][i] += sc * O[dt][i];
  }
  {
    const bf16_t* ZN = (const bf16_t*)(p.ws + OFF_ZN) + tok * 512 + hd * 64;
    bf16_t* MIX = (bf16_t*)(p.ws + OFF_MIX) + tok * 1024 + hd * 64;
#pragma unroll
    for (int dt = 0; dt < 2; ++dt)
#pragma unroll
      for (int gi = 0; gi < 4; ++gi) {
        const int d = dt * 32 + 8 * gi + 4 * h;
        const u32x2 z = *(const u32x2*)(ZN + d);
        u32x2 o;
        o[0] = pack2(Oout[dt][4 * gi + 0] * silu_f(bflo(z[0])), Oout[dt][4 * gi + 1] * silu_f(bfhi(z[0])));
        o[1] = pack2(Oout[dt][4 * gi + 2] * silu_f(bflo(z[1])), Oout[dt][4 * gi + 3] * silu_f(bfhi(z[1])));
        *(u32x2*)(MIX + d) = o;
      }
  }
  __syncthreads();
#undef ATT_ISSUE
#undef ATT_COMMIT
#undef ATT_PRE
#undef ATT_POST
}

DI void phase3(const Params& p, char* smem) {
  unsigned* qctr = (unsigned*)(p.ws + OFF_QCTR);
  volatile int* qw = (volatile int*)(smem + 134160);
  const bool t0 = threadIdx.x == 0;
  int nxt = 0;
  if (t0) nxt = (int)__hip_atomic_fetch_add(qctr, 1u, __ATOMIC_RELAXED, __HIP_MEMORY_SCOPE_AGENT);
  for (;;) {
    if (t0) *qw = nxt;
    __syncthreads();
    const int idx = *qw;
    __syncthreads();
    if (idx >= 4096) break;
    if (t0) nxt = (int)__hip_atomic_fetch_add(qctr, 1u, __ATOMIC_RELAXED, __HIP_MEMORY_SCOPE_AGENT);
    if (idx < 2048) {
      const int c = 63 - (idx >> 5), bgi = idx & 31;
      attn_item(p, smem, c, bgi >> 1, bgi & 1);
    } else {
      const int half = (int)(threadIdx.x >> 8);
      gmlp_item(p, smem + half * 52224, (idx - 2048) * 2 + half, true);
    }
  }
}

struct OneUnit {
  pg8::Unit u0;
  __device__ bool next(int i, pg8::Unit& u) const { if (i != 0) return false; u = u0; return true; }
  __device__ __forceinline__ void a_ready(const pg8::Unit&) const {}
  __device__ __forceinline__ void done(const pg8::Unit&) const {}
};
struct EpiP4F {
  static constexpr bool PERM = true, AFTER_DRAIN = true;
  const float* x;
  float* out;
  float* rowss;
  unsigned* pcnt;
  const float* gvec;
  __device__ __forceinline__ void operator()(const pg8::f32x4 (&)[2][2][4][2], const pg8::Unit&, int, int, int, int) const {}
  __device__ __forceinline__ void fused(const pg8::f32x4 (&acc_c)[2][2][4][2], const pg8::Unit& u, int wr, int wc, int fr, int fq,
                                        PG8_LAS unsigned char* lds, int wid, int lane) const {
    auto& acc = const_cast<pg8::f32x4 (&)[2][2][4][2]>(acc_c);
    PG8_LAS float* rl = (PG8_LAS float*)lds;
    const int tid = wid * 64 + lane;
    if (tid < 256) rl[tid] = 0.f;
    __syncthreads();
#pragma unroll
    for (int ai = 0; ai < 2; ++ai)
#pragma unroll
      for (int m = 0; m < 4; ++m) {
        const int row_l = ai * 128 + wr * 64 + m * 16 + fr;
        const size_t rowoff = ((size_t)u.pm * 256 + row_l) * 1024;
        float ss = 0.f;
#pragma unroll
        for (int bj = 0; bj < 2; ++bj) {
          const int col = u.pn * 256 + bj * 128 + wc * 32 + fq * 8;
          const float4 x0 = *(const float4*)(x + rowoff + col);
          const float4 x1 = *(const float4*)(x + rowoff + col + 4);
          acc[ai][bj][m][0][0] += x0.x; acc[ai][bj][m][0][1] += x0.y; acc[ai][bj][m][0][2] += x0.z; acc[ai][bj][m][0][3] += x0.w;
          acc[ai][bj][m][1][0] += x1.x; acc[ai][bj][m][1][1] += x1.y; acc[ai][bj][m][1][2] += x1.z; acc[ai][bj][m][1][3] += x1.w;
#pragma unroll
          for (int n = 0; n < 2; ++n)
#pragma unroll
            for (int j = 0; j < 4; ++j) ss += acc[ai][bj][m][n][j] * acc[ai][bj][m][n][j];
        }
        ss += shx(ss, 16, lane);
        ss += shx(ss, 32, lane);
        if (fq == 0) __hip_atomic_fetch_add(rl + row_l, ss, __ATOMIC_RELAXED, __HIP_MEMORY_SCOPE_WORKGROUP);
      }
    __syncthreads();
    if (tid < 256) __hip_atomic_fetch_add(rowss + (size_t)u.pm * 256 + tid, rl[tid], __ATOMIC_RELAXED, __HIP_MEMORY_SCOPE_AGENT);
    asm volatile("s_waitcnt vmcnt(0)" ::: "memory");
    __syncthreads();
    if (tid == 0) {
      __builtin_amdgcn_fence(__ATOMIC_RELEASE, "agent");
      asm volatile("s_waitcnt vmcnt(0)" ::: "memory");
      __hip_atomic_fetch_add(pcnt + u.pm, 1u, __ATOMIC_RELAXED, __HIP_MEMORY_SCOPE_AGENT);
      unsigned spins = 0;
      while (__hip_atomic_load(pcnt + u.pm, __ATOMIC_RELAXED, __HIP_MEMORY_SCOPE_AGENT) < 4u && ++spins < (1u << 22)) __builtin_amdgcn_s_sleep(2);
      __builtin_amdgcn_fence(__ATOMIC_ACQUIRE, "agent");
      asm volatile("s_waitcnt vmcnt(0)" ::: "memory");
    }
    __syncthreads();
    if (tid < 256) {
      const float rs = __hip_atomic_load(rowss + (size_t)u.pm * 256 + tid, __ATOMIC_RELAXED, __HIP_MEMORY_SCOPE_AGENT);
      rl[256 + tid] = rsqrtf(rs * (1.f / 1024.f) + 1e-6f);
    }
    __syncthreads();
    float4 g0[2], g1[2];
#pragma unroll
    for (int bj = 0; bj < 2; ++bj) {
      const int col = u.pn * 256 + bj * 128 + wc * 32 + fq * 8;
      g0[bj] = *(const float4*)(gvec + col);
      g1[bj] = *(const float4*)(gvec + col + 4);
    }
#pragma unroll
    for (int ai = 0; ai < 2; ++ai)
#pragma unroll
      for (int m = 0; m < 4; ++m) {
        const int row_l = ai * 128 + wr * 64 + m * 16 + fr;
        const size_t rowoff = ((size_t)u.pm * 256 + row_l) * 1024;
        const float rstd = rl[256 + row_l];
#pragma unroll
        for (int bj = 0; bj < 2; ++bj) {
          const int col = u.pn * 256 + bj * 128 + wc * 32 + fq * 8;
          float4 o0, o1;
          o0.x = acc[ai][bj][m][0][0] * rstd * g0[bj].x; o0.y = acc[ai][bj][m][0][1] * rstd * g0[bj].y;
          o0.z = acc[ai][bj][m][0][2] * rstd * g0[bj].z; o0.w = acc[ai][bj][m][0][3] * rstd * g0[bj].w;
          o1.x = acc[ai][bj][m][1][0] * rstd * g1[bj].x; o1.y = acc[ai][bj][m][1][1] * rstd * g1[bj].y;
          o1.z = acc[ai][bj][m][1][2] * rstd * g1[bj].z; o1.w = acc[ai][bj][m][1][3] * rstd * g1[bj].w;
          *(float4*)(out + rowoff + col) = o0;
          *(float4*)(out + rowoff + col + 4) = o1;
        }
      }
    __syncthreads();
  }
};

DI void phase4_fused(const Params& p, unsigned char* smem, const int wid_s) {
  pg8::Gemm g;
  g.A = (const bf16_t*)(p.ws + OFF_MIX); g.Bt = (const bf16_t*)(p.ws + OFF_WTOUT); g.M = NTOK; g.N = 1024; g.K = 1024;
  pg8::StaticOrder S; S.init(NTOK, 1024, (int)gridDim.x, (int)blockIdx.x);
  EpiP4F E; E.x = p.x; E.out = p.out; E.rowss = (float*)(p.ws + OFF_ROWSS); E.pcnt = (unsigned*)(p.ws + OFF_PCNT);
  E.gvec = (const float*)(p.ws + OFF_SMALL) + SM_NFG;
  for (int i = 0; i < 4; ++i) {
    OneUnit O1;
    if (!S.next(i, O1.u0)) break;
    pg8::gemm_phase<EpiP4F, OneUnit, false>((PG8_LAS unsigned char*)smem, g, O1, E, nullptr, opaque_tid_w(wid_s));
    __syncthreads();
  }
}

DI void phase4(const Params& p, unsigned char* smem, const int wid_s) {
  pg8::Gemm g;
  g.A = (const bf16_t*)(p.ws + OFF_MIX); g.Bt = (const bf16_t*)(p.ws + OFF_WTOUT); g.M = NTOK; g.N = 1024; g.K = 1024;
  pg8::StaticOrder S; S.init(NTOK, 1024, (int)gridDim.x, (int)blockIdx.x);
  EpiP4 E; E.x = p.x; E.hb = (bf16_t*)(p.ws + OFF_HN); E.rowss = (float*)(p.ws + OFF_ROWSS);
  pg8::gemm_phase<EpiP4, pg8::StaticOrder, false>((PG8_LAS unsigned char*)smem, g, S, E, nullptr, opaque_tid_w(wid_s));
  __syncthreads();
}

DI void phase5(const Params& p, const int wid_s) {
  const int t2 = opaque_tid_w(wid_s), lane = t2 & 63, wave = t2 >> 6;
  const bf16_t* HB = (const bf16_t*)(p.ws + OFF_HN);
  const float* RS = (const float*)(p.ws + OFF_ROWSS);
  float4 gf[2][2];
#pragma unroll
  for (int ch = 0; ch < 2; ++ch)
#pragma unroll
    for (int q = 0; q < 2; ++q) gf[ch][q] = *(const float4*)(p.ws + OFF_SMALL + (size_t)(SM_NFG + ch * 512 + lane * 8 + q * 4) * 4);
  const int gw = blockIdx.x * 8 + wave, ngw = gridDim.x * 8;
  for (int r0 = gw * 4; r0 < NTOK; r0 += ngw * 4) {
    u32x4 hv[4][2];
    float rs[4];
#pragma unroll
    for (int k = 0; k < 4; ++k) {
      const bf16_t* hrow = HB + (size_t)(r0 + k) * 1024;
#pragma unroll
      for (int ch = 0; ch < 2; ++ch) hv[k][ch] = *(const u32x4*)(hrow + ch * 512 + lane * 8);
      rs[k] = RS[r0 + k];
    }
#pragma unroll
    for (int k = 0; k < 4; ++k) {
      const float rstd = rsqrtf(rs[k] * (1.f / 1024.f) + 1e-6f);
      float* orow = p.out + (size_t)(r0 + k) * 1024;
#pragma unroll
      for (int ch = 0; ch < 2; ++ch) {
        float4 o0, o1;
        o0.x = bflo(hv[k][ch][0]) * rstd * gf[ch][0].x; o0.y = bfhi(hv[k][ch][0]) * rstd * gf[ch][0].y;
        o0.z = bflo(hv[k][ch][1]) * rstd * gf[ch][0].z; o0.w = bfhi(hv[k][ch][1]) * rstd * gf[ch][0].w;
        o1.x = bflo(hv[k][ch][2]) * rstd * gf[ch][1].x; o1.y = bfhi(hv[k][ch][2]) * rstd * gf[ch][1].y;
        o1.z = bflo(hv[k][ch][3]) * rstd * gf[ch][1].z; o1.w = bfhi(hv[k][ch][3]) * rstd * gf[ch][1].w;
        *(float4*)(orow + ch * 512 + lane * 8) = o0;
        *(float4*)(orow + ch * 512 + lane * 8 + 4) = o1;
      }
    }
  }
}

#ifndef REP0
#define REP0 1
#endif
#ifndef REP1
#define REP1 1
#endif
#ifndef REP2
#define REP2 1
#endif
#ifndef REP3
#define REP3 1
#endif
#ifndef REP4
#define REP4 1
#endif
__global__ void __launch_bounds__(NTHR, 2) nsa_gmlp_megakernel(Params p) {
  __shared__ __attribute__((aligned(16))) unsigned char smem[SMEM_BYTES];
  cg::grid_group grid = cg::this_grid();
  volatile XB_LAS unsigned* xst = (volatile XB_LAS unsigned*)((XB_LAS unsigned char*)smem + 134144);
  if (threadIdx.x == 0) { xst[0] = 0u; xst[1] = 0u; }
  __syncthreads();
  const XcdBarrier xb = xcd_barrier_post((unsigned*)(p.ws + OFF_XBAR), xst);
  if (p.ws == nullptr) grid.sync();
  const int wid_s = __builtin_amdgcn_readfirstlane((int)(threadIdx.x >> 6));
  for (int rep = 0; rep < REP0; ++rep) phase0(p);
  xcd_barrier(xb);
  unsigned* const barp = (unsigned*)(p.ws + OFF_BAR);
  const unsigned nblk = gridDim.x;
  const bool leader = threadIdx.x == 0;
  for (int rep = 0; rep < REP1; ++rep) {
    pg8::Gemm g;
    g.A = (const bf16_t*)(p.ws + OFF_HN); g.Bt = (const bf16_t*)(p.ws + OFF_WTIN); g.M = NTOK; g.N = NPAD; g.K = 1024;
    pg8::StaticOrder S; S.init(NTOK, NPAD, (int)gridDim.x, (int)blockIdx.x);
    EpiP1 E; E.ws = p.ws;
    pg8::gemm_phase<EpiP1, pg8::StaticOrder, false>((PG8_LAS unsigned char*)smem, g, S, E, nullptr, opaque_tid());
    __syncthreads();
  }
  xcd_barrier(xb);
  for (int rep = 0; rep < REP2; ++rep) {
    const int vb = blockIdx.x * 2 + (threadIdx.x >> 8), nvb = gridDim.x * 2;
    char* sh = (char*)smem + (threadIdx.x >> 8) * 52224;
    for (int it0 = 0; it0 < 512; it0 += nvb) compress_item(p, sh, it0 + vb, it0 + vb < 512);
  }
  xcd_barrier(xb);
  for (int rep = 0; rep < REP3; ++rep) phase3(p, (char*)smem);
  xcd_barrier(xb);
  if (gridDim.x == 256) {
    phase4_fused(p, smem, wid_s);
  } else {
    for (int rep = 0; rep < REP4; ++rep) phase4(p, smem, wid_s);
    xcd_barrier(xb);
    phase5(p, wid_s);
  }
}

extern "C" void kernel_launch(void* const* d_in, const int* in_sizes, int n_in, void* d_out, int out_size, void* d_ws,
                              size_t ws_size, hipStream_t stream) {
  static int grid_blocks = 0;
  if (!grid_blocks) {
    int dev = 0, cus = 0, per_cu = 0;
    (void)hipGetDevice(&dev);
    (void)hipDeviceGetAttribute(&cus, hipDeviceAttributeMultiprocessorCount, dev);
    (void)hipOccupancyMaxActiveBlocksPerMultiprocessor(&per_cu, nsa_gmlp_megakernel, NTHR, 0);
    if (per_cu < 1) per_cu = 1;
    grid_blocks = cus;
  }
  Params p{};
  p.x = (const float*)d_in[0];
  p.norm_in_g = (const float*)d_in[1];
  p.w_in = (const float*)d_in[2];
  p.w_k1 = (const float*)d_in[3];
  p.w_k2 = (const float*)d_in[4];
  p.pe_k = (const float*)d_in[5];
  p.w_v1 = (const float*)d_in[6];
  p.w_v2 = (const float*)d_in[7];
  p.pe_v = (const float*)d_in[8];
  p.ln_g = (const float*)d_in[9];
  p.ln_b = (const float*)d_in[10];
  p.w_sp = (const float*)d_in[11];
  p.b_sp = (const float*)d_in[12];
  p.w_out = (const float*)d_in[13];
  p.norm_f_g = (const float*)d_in[14];
  p.out = (float*)d_out;
  p.ws = (char*)d_ws;
  void* args[] = {&p};
  (void)hipMemsetAsync((char*)d_ws + OFF_XBAR, 0, 3456 * 4, stream);
  hipError_t e = hipLaunchCooperativeKernel((void*)nsa_gmlp_megakernel, dim3(grid_blocks), dim3(NTHR), args, 0, stream);
  if (e != hipSuccess) fprintf(stderr, "cooperative launch failed: %s (grid %d)\n", hipGetErrorString(e), grid_blocks);
}
```

```cpp
#include <hip/hip_runtime.h>
#include <hip/hip_cooperative_groups.h>
#include <cstdio>
namespace cg = cooperative_groups;

#define DI __device__ __forceinline__
typedef unsigned short bf16_t;
typedef unsigned long long u64;
typedef __attribute__((ext_vector_type(8))) short s16x8;
typedef __attribute__((ext_vector_type(4))) short s16x4;
typedef __attribute__((ext_vector_type(16))) float f32x16;
typedef __attribute__((ext_vector_type(4))) unsigned u32x4;
typedef __attribute__((ext_vector_type(2))) unsigned u32x2;
typedef __bf16 bf2_t __attribute__((ext_vector_type(2)));
typedef float f2_t __attribute__((ext_vector_type(2)));

#define MFMA32(a, b, c) __builtin_amdgcn_mfma_f32_32x32x16_bf16((a), (b), (c), 0, 0, 0)

constexpr int NTOK = 65536;
constexpr int NTHR = 512;
constexpr int NPAD = 3584;
constexpr float L2E = 1.4426950408889634f;

constexpr size_t OFF_HN    = 0;
constexpr size_t OFF_WTIN  = OFF_HN    + (size_t)NTOK * 1024 * 2;
constexpr size_t OFF_WTOUT = OFF_WTIN  + (size_t)NPAD * 1024 * 2;
constexpr size_t OFF_W1TK  = OFF_WTOUT + (size_t)1024 * 1024 * 2;
constexpr size_t OFF_W1TV  = OFF_W1TK  + (size_t)128 * 2048 * 2;
constexpr size_t OFF_BIAS  = OFF_W1TV  + (size_t)128 * 2048 * 2;
constexpr size_t OFF_WSP   = OFF_BIAS  + 1024;
constexpr size_t OFF_Q     = OFF_WSP   + (size_t)8 * 128 * 128 * 2;
constexpr size_t OFF_KC    = OFF_Q     + (size_t)NTOK * 512 * 2;
constexpr size_t OFF_VC    = OFF_KC    + (size_t)NTOK * 128 * 2;
constexpr size_t OFF_KS    = OFF_VC    + (size_t)NTOK * 128 * 2;
constexpr size_t OFF_KW    = OFF_KS    + (size_t)NTOK * 128 * 2;
constexpr size_t OFF_VST   = OFF_KW    + (size_t)NTOK * 128 * 2;
constexpr size_t OFF_VWT   = OFF_VST   + (size_t)NTOK * 128 * 2;
constexpr size_t OFF_ZN    = OFF_VWT   + (size_t)NTOK * 128 * 2;
constexpr size_t OFF_U     = OFF_ZN    + (size_t)NTOK * 512 * 2;
constexpr size_t OFF_V     = OFF_U     + (size_t)NTOK * 512 * 2;
constexpr size_t OFF_ZG    = OFF_V     + (size_t)NTOK * 512 * 2;
constexpr size_t OFF_GATES = OFF_ZG    + (size_t)NTOK * 512 * 2;
constexpr size_t OFF_KCMP  = OFF_GATES + (size_t)NTOK * 24 * 4;
constexpr size_t OFF_VCMPT = OFF_KCMP  + (size_t)32 * 256 * 64 * 2;
constexpr size_t OFF_MIX   = OFF_VCMPT + (size_t)32 * 256 * 64 * 2;
constexpr size_t OFF_SMALL = OFF_MIX   + (size_t)NTOK * 1024 * 2;
constexpr int SM_LNG = 0, SM_LNB = 512, SM_BSP = 1024, SM_W2K = 2048, SM_W2V = 2048 + 8192, SM_NFG = 2048 + 16384, SM_TOTAL = 2048 + 16384 + 1024;
constexpr size_t OFF_ROWSS = OFF_SMALL + (size_t)SM_TOTAL * 4;
constexpr size_t OFF_BAR   = OFF_ROWSS + (size_t)NTOK * 4;
constexpr size_t OFF_XBAR  = OFF_BAR + 256;
constexpr size_t OFF_PCNT  = OFF_XBAR + 3456 * 4;
constexpr size_t OFF_QCTR  = OFF_PCNT + 256 * 4;
constexpr size_t WS_END    = OFF_QCTR + 256;

constexpr int SMEM_BYTES = 135168;

struct Params {
  const float *x, *norm_in_g, *w_in, *w_k1, *w_k2, *pe_k, *w_v1, *w_v2, *pe_v, *ln_g, *ln_b, *w_sp, *b_sp, *w_out, *norm_f_g;
  float* out;
  char* ws;
};

DI unsigned pack2(float a, float b) {
  f2_t v = {a, b};
  bf2_t r = __builtin_convertvector(v, bf2_t);
  return __builtin_bit_cast(unsigned, r);
}
DI bf16_t f2bf(float a) { return (bf16_t)(pack2(a, 0.f) & 0xffffu); }
DI float bflo(unsigned u) { return __uint_as_float(u << 16); }
DI float bfhi(unsigned u) { return __uint_as_float(u & 0xffff0000u); }
DI float shx(float v, int mask, int lane) {
  return __builtin_bit_cast(float, __builtin_amdgcn_ds_bpermute((lane ^ mask) << 2, __builtin_bit_cast(int, v)));
}
DI unsigned shxu(unsigned v, int mask, int lane) {
  return (unsigned)__builtin_amdgcn_ds_bpermute((lane ^ mask) << 2, (int)v);
}
DI float wave_sum(float v, int lane) {
#pragma unroll
  for (int o = 32; o >= 1; o >>= 1) v += shx(v, o, lane);
  return v;
}
DI float gelu_t(float x) {
  const float y2 = x * __builtin_fmaf(0.044715f, x * x, 1.0f) * (-2.0f * 0.7978845608028654f * 1.4426950408889634f);
  return x * __builtin_amdgcn_rcpf(1.0f + __builtin_amdgcn_exp2f(y2));
}
DI float sigmoid_f(float x) { return __builtin_amdgcn_rcpf(1.0f + __builtin_amdgcn_exp2f(-1.4426950408889634f * x)); }
DI float silu_f(float x) { return x * __builtin_amdgcn_rcpf(1.0f + __builtin_amdgcn_exp2f(-1.4426950408889634f * x)); }
typedef float f2a __attribute__((ext_vector_type(2)));
DI f2a gelu2(f2a x) {
  const f2a t = x * x * 0.044715f + 1.0f;
  const f2a y2 = x * t * (-2.0f * 0.7978845608028654f * 1.4426950408889634f);
  f2a e = {__builtin_amdgcn_exp2f(y2.x), __builtin_amdgcn_exp2f(y2.y)};
  e = e + 1.0f;
  const f2a rinv = {__builtin_amdgcn_rcpf(e.x), __builtin_amdgcn_rcpf(e.y)};
  return x * rinv;
}
DI f2a silu2(f2a x) {
  const f2a a = x * (-1.4426950408889634f);
  f2a e = {__builtin_amdgcn_exp2f(a.x), __builtin_amdgcn_exp2f(a.y)};
  e = e + 1.0f;
  const f2a rinv = {__builtin_amdgcn_rcpf(e.x), __builtin_amdgcn_rcpf(e.y)};
  return x * rinv;
}
DI unsigned pack2v(f2a v) { return pack2(v.x, v.y); }
DI float xhalf_max(float v) {
  const auto r_ = __builtin_amdgcn_permlane32_swap(__float_as_uint(v), __float_as_uint(v), false, false);
  return fmaxf(__uint_as_float(r_[0]), __uint_as_float(r_[1]));
}
DI float xhalf_sum(float v) {
  const auto r_ = __builtin_amdgcn_permlane32_swap(__float_as_uint(v), __float_as_uint(v), false, false);
  return __uint_as_float(r_[0]) + __uint_as_float(r_[1]);
}
DI int crow(int i, int h) { return (i & 3) + 8 * (i >> 2) + 4 * h; }
DI int opaque_tid() { int t = threadIdx.x; asm volatile("" : "+v"(t)); return t; }
DI int opaque_tid_w(int wid_s) {
  int t = (wid_s << 6) | (int)__builtin_amdgcn_mbcnt_hi(~0u, __builtin_amdgcn_mbcnt_lo(~0u, 0u));
  asm volatile("" : "+v"(t));
  return t;
}

#define XB_TMO      128
#define XB_XCNT(j)  (256  + 64 * (j))
#define XB_XSUB(j)  (1280 + 64 * (j))
#define XB_XGEN(j)  (2304 + 64 * (j))
#define XB_TOP      3328
#define XB_TOPGEN   3392
#define XCD_BAR_WORDS 3456
#define XB_SPIN_CAP (1u << 18)
#define XB_LAS __attribute__((address_space(3)))

__device__ __forceinline__ unsigned xb_ld(unsigned* p)              { return __hip_atomic_load(p, __ATOMIC_RELAXED, __HIP_MEMORY_SCOPE_AGENT); }
__device__ __forceinline__ unsigned xb_add(unsigned* p, unsigned v) { return __hip_atomic_fetch_add(p, v, __ATOMIC_RELAXED, __HIP_MEMORY_SCOPE_AGENT); }
__device__ __forceinline__ unsigned xb_xcc_id() { return (unsigned)__builtin_amdgcn_s_getreg((3 << 11) | 20) & 0xFu; }
#define XB_SPIN(cond, bar) do { unsigned _sp = 0; while (cond) { __builtin_amdgcn_s_sleep(1); \
    if ((++_sp & 255u) == 0u) { if (xb_ld(&(bar)[XB_TMO])) break; if (_sp > XB_SPIN_CAP) { atomicAdd(&(bar)[XB_TMO], 1u); break; } } } } while (0)

struct XcdBarrier {
    unsigned* bar; unsigned x;
    volatile XB_LAS unsigned* st;
};

__device__ __forceinline__ XcdBarrier xcd_barrier_post(unsigned* bar, volatile XB_LAS unsigned* st) {
    XcdBarrier b; b.bar = bar; b.x = xb_xcc_id(); b.st = st;
    if (threadIdx.x == 0) (void)xb_add(&bar[XB_XCNT(b.x)], 1u);
    return b;
}
__device__ __forceinline__ void xcd_barrier_complete(unsigned* bar, unsigned x, unsigned& nloc, unsigned& nx) {
    const unsigned G = gridDim.x * gridDim.y * gridDim.z;
    unsigned sum, cnt, mine, sp = 0u;
    for (;;) {
        sum = 0u; cnt = 0u; mine = 0u;
#pragma unroll
        for (unsigned j = 0; j < 16; ++j) { const unsigned c = xb_ld(&bar[XB_XCNT(j)]); sum += c; cnt += (c > 0u) ? 1u : 0u; mine = (j == x) ? c : mine; }
        if (sum == G) break;
        __builtin_amdgcn_s_sleep(1);
        if ((++sp & 255u) == 0u) { if (xb_ld(&bar[XB_TMO])) break; if (sp > XB_SPIN_CAP) { atomicAdd(&bar[XB_TMO], 1u); break; } }
    }
    nloc = mine > 0u ? mine : 1u; nx = cnt > 0u ? cnt : 1u;
}

__device__ __forceinline__ void xcd_barrier(const XcdBarrier& b) {
    asm volatile("s_waitcnt vmcnt(0)" ::: "memory");
    __syncthreads();
    if (threadIdx.x == 0) {
        unsigned* bar = b.bar;
        __builtin_amdgcn_s_waitcnt(0);
        unsigned nloc = b.st[0], nx = b.st[1];
        if (nloc == 0u) { xcd_barrier_complete(bar, b.x, nloc, nx); b.st[0] = nloc; b.st[1] = nx; }
        const unsigned old = xb_add(&bar[XB_XSUB(b.x)], 1u);
        const unsigned gen = old / nloc;
        if (old + 1u == (gen + 1u) * nloc) {
            __builtin_amdgcn_fence(__ATOMIC_RELEASE, "agent");
            asm volatile("s_waitcnt vmcnt(0)" ::: "memory");
            const unsigned og = xb_add(&bar[XB_TOP], 1u);
            const unsigned tg = og / nx;
            if (og + 1u == (tg + 1u) * nx) xb_add(&bar[XB_TOPGEN], 1u);
            else XB_SPIN(xb_ld(&bar[XB_TOPGEN]) == tg, bar);
            __builtin_amdgcn_fence(__ATOMIC_ACQUIRE, "agent");
            xb_add(&bar[XB_XGEN(b.x)], 1u);
            asm volatile("s_waitcnt vmcnt(0)" ::: "memory");
        } else {
            XB_SPIN(xb_ld(&bar[XB_XGEN(b.x)]) == gen, bar);
            __builtin_amdgcn_fence(__ATOMIC_ACQUIRE, "agent");
            asm volatile("s_waitcnt vmcnt(0)" ::: "memory");
        }
    }
    __syncthreads();
}

DI void grid_bar(unsigned* ctr, unsigned target, bool leader) {
  asm volatile("s_waitcnt vmcnt(0) lgkmcnt(0)" ::: "memory");
  __syncthreads();
  if (leader) {
    __builtin_amdgcn_fence(__ATOMIC_RELEASE, "agent");
    asm volatile("s_waitcnt vmcnt(0)" ::: "memory");
    __hip_atomic_fetch_add(ctr, 1u, __ATOMIC_RELAXED, __HIP_MEMORY_SCOPE_AGENT);
    while (__hip_atomic_load(ctr, __ATOMIC_RELAXED, __HIP_MEMORY_SCOPE_AGENT) < target) __builtin_amdgcn_s_sleep(2);
    __builtin_amdgcn_fence(__ATOMIC_ACQUIRE, "agent");
    asm volatile("s_waitcnt vmcnt(0)" ::: "memory");
  }
  __syncthreads();
}

DI void transpose_w(const float* __restrict__ src, int src_ld, bf16_t* __restrict__ dst, int Np, int K, int mode,
                    int gtid, int gthreads) {
  const int nchunks = K >> 3;
  const long total = (long)nchunks * Np;
  for (long id = gtid; id < total; id += gthreads) {
    const int n = (int)(id % Np), kc = (int)(id / Np);
    int sn = n;
    if (mode == 1) {
      if (n < 1280) sn = n;
      else if (n < 3328) sn = n + 24;
      else if (n < 3352) sn = n - 3328 + 1280;
      else sn = -1;
    }
    u32x4 o = {0u, 0u, 0u, 0u};
    if (sn >= 0) {
      float f[8];
#pragma unroll
      for (int j = 0; j < 8; ++j) f[j] = src[(size_t)(kc * 8 + j) * src_ld + sn];
      o[0] = pack2(f[0], f[1]); o[1] = pack2(f[2], f[3]); o[2] = pack2(f[4], f[5]); o[3] = pack2(f[6], f[7]);
    }
    *(u32x4*)(dst + (size_t)n * K + kc * 8) = o;
  }
}

DI void phase0(const Params& p) {
  const int tid = opaque_tid(), lane = tid & 63, wave = tid >> 6;
  const int gthreads = gridDim.x * NTHR, gtid = blockIdx.x * NTHR + tid;
  const int gwaves = gridDim.x * 8, gwave = blockIdx.x * 8 + wave;
  bf16_t* HN = (bf16_t*)(p.ws + OFF_HN);
  for (int row = gwave; row < NTOK; row += gwaves) {
    const float4* xr = (const float4*)(p.x + (size_t)row * 1024);
    float4 v[4];
    float ss = 0.f;
#pragma unroll
    for (int i = 0; i < 4; ++i) {
      v[i] = xr[i * 64 + lane];
      ss += v[i].x * v[i].x + v[i].y * v[i].y + v[i].z * v[i].z + v[i].w * v[i].w;
    }
    ss = wave_sum(ss, lane);
    const float rstd = rsqrtf(ss * (1.f / 1024.f) + 1e-6f);
#pragma unroll
    for (int i = 0; i < 4; ++i) {
      const float4 g = ((const float4*)p.norm_in_g)[i * 64 + lane];
      u32x2 o;
      o[0] = pack2(v[i].x * rstd * g.x, v[i].y * rstd * g.y);
      o[1] = pack2(v[i].z * rstd * g.z, v[i].w * rstd * g.w);
      *(u32x2*)(HN + (size_t)row * 1024 + (i * 64 + lane) * 4) = o;
    }
  }
  transpose_w(p.w_in, 3352, (bf16_t*)(p.ws + OFF_WTIN), NPAD, 1024, 1, gtid, gthreads);
  transpose_w(p.w_out, 1024, (bf16_t*)(p.ws + OFF_WTOUT), 1024, 1024, 0, gtid, gthreads);
  transpose_w(p.w_k1, 128, (bf16_t*)(p.ws + OFF_W1TK), 128, 2048, 0, gtid, gthreads);
  transpose_w(p.w_v1, 128, (bf16_t*)(p.ws + OFF_W1TV), 128, 2048, 0, gtid, gthreads);
  float* BIAS = (float*)(p.ws + OFF_BIAS);
  for (int it = gwave; it < 256; it += gwaves) {
    const int kv = it >> 7, e = it & 127;
    const float* w1 = kv ? p.w_v1 : p.w_k1;
    const float* pe = kv ? p.pe_v : p.pe_k;
    float s = 0.f;
    for (int kk = lane; kk < 2048; kk += 64) s += pe[kk] * w1[(size_t)kk * 128 + e];
    s = wave_sum(s, lane);
    if (lane == 0) BIAS[it] = s;
  }
  if (gtid == 0) { *(unsigned*)(p.ws + OFF_BAR) = 0u; *(unsigned*)(p.ws + OFF_QCTR) = 0u; }
  {
    float* RS = (float*)(p.ws + OFF_ROWSS);
    for (int id = gtid; id < NTOK; id += gthreads) RS[id] = 0.f;
    if (gtid < 256) ((unsigned*)(p.ws + OFF_PCNT))[gtid] = 0u;
  }
  {
    float* SMALL = (float*)(p.ws + OFF_SMALL);
    for (int id = gtid; id < SM_TOTAL; id += gthreads) {
      float v;
      if (id < SM_LNB) v = p.ln_g[id - SM_LNG];
      else if (id < SM_BSP) v = p.ln_b[id - SM_LNB];
      else if (id < SM_W2K) v = p.b_sp[id - SM_BSP];
      else if (id < SM_W2V) v = p.w_k2[id - SM_W2K];
      else if (id < SM_NFG) v = p.w_v2[id - SM_W2V];
      else v = p.norm_f_g[id - SM_NFG];
      SMALL[id] = v;
    }
  }
  bf16_t* WSP = (bf16_t*)(p.ws + OFF_WSP);
  for (int id = gtid; id < 8 * 128 * 128; id += gthreads) {
    const int t = (id >> 7) & 127, s = id & 127;
    WSP[id] = (s <= t) ? f2bf(p.w_sp[id]) : (bf16_t)0;
  }
}

namespace pg8 {
#define PG8_LAS __attribute__((address_space(3)))
typedef unsigned short bf16_t;
typedef short bf16x8 __attribute__((ext_vector_type(8)));
typedef float f32x4 __attribute__((ext_vector_type(4)));
typedef unsigned u32x4 __attribute__((ext_vector_type(4)));
constexpr int BM = 256, BK = 64, HALF = 128, HTB = HALF * BK * 2  , STAGE_BYTES = 8 * HTB, NXCD = 8, WGM = 4;

__host__ __device__ __forceinline__ int lds_byte(int r, int c) { const int st = (r >> 4) * 2 + (c >> 5), rr = r & 15, cc = c & 31, ob = rr * 64 + cc * 2; return st * 1024 + (ob ^ (((ob >> 9) & 1) << 5)); }
__host__ __device__ __forceinline__ void stage_rc(int b, int& R, int& C) { const int st = b / 1024, sb = b % 1024, swz = sb ^ (((sb >> 9) & 1) << 5); R = (st >> 1) * 16 + swz / 64; C = (st & 1) * 32 + (swz % 64) / 2; }
__host__ __device__ __forceinline__ int perm32(int rho) { const int n = rho >> 4, i = rho & 15; return 8 * (i >> 2) + 4 * n + (i & 3); }

struct Unit { int pm, pn; };
struct Gemm { const bf16_t* A; const bf16_t* Bt; int M, N, K; };

struct StaticOrder {
    int nM, nN, nwg, G, c;
    __host__ __device__ void init(int M, int N, int G_, int c_) { nM = M / BM; nN = N / BM; nwg = nM * nN; G = G_; c = c_; }
    __host__ __device__ bool next(int i, Unit& u) const {
        const long L = (long)i * G + c; if (L >= nwg) return false;
        int wgid = (int)L; { const int q = nwg / NXCD, r = nwg % NXCD, xcd = wgid % NXCD, off = wgid / NXCD; wgid = (xcd < r ? xcd * (q + 1) : r * (q + 1) + (xcd - r) * q) + off; }
        const int nig = WGM * nN, gid = wgid / nig, fm = gid * WGM, gsz = (nM - fm) < WGM ? (nM - fm) : WGM;
        u.pm = fm + ((wgid % nig) % gsz); u.pn = (wgid % nig) / gsz; return true;
    }
    __device__ __forceinline__ void a_ready(const Unit&) const {}
    __device__ __forceinline__ void done(const Unit&) const {}
};

template <class Epi, class Sched, bool STAMP = false>
__device__ __forceinline__ void gemm_phase(PG8_LAS unsigned char* lds, const Gemm g, const Sched& S, const Epi& E, unsigned long long* stamps, const int tid_in) {
    const int tid = tid_in, wid = __builtin_amdgcn_readfirstlane(tid >> 6), lane = tid & 63, wr = wid >> 2, wc = wid & 3, fr = lane & 15, fq = lane >> 4;
    const int K = g.K, nt = K / BK;
    int ts_lo = 0, ts_hi = 0, nts = 0; const unsigned long long rt_entry = STAMP ? (unsigned long long)wall_clock64() : 0ull;
#define PG8_STAMP() do { if (STAMP && wid == 0 && nts < 64) { const unsigned long long _c = (unsigned long long)clock64(); \
        ts_lo = (lane == nts) ? (int)(unsigned)_c : ts_lo; ts_hi = (lane == nts) ? (int)(unsigned)(_c >> 32) : ts_hi; ++nts; } } while (0)
    PG8_STAMP();
    unsigned voffA[2], voffB[2];
#pragma unroll
    for (int i = 0; i < 2; ++i) { int R, C; stage_rc(tid * 16 + i * 8192, R, C); const int Rb = Epi::PERM ? ((R & ~31) + perm32(R & 31)) : R;
        voffA[i] = (unsigned)(R * K + C) * 2u; voffB[i] = (unsigned)(Rb * K + C) * 2u; }
    const size_t kstep = (size_t)(BK * 2);
    const size_t hstep = (size_t)HALF * K * 2;
    const size_t tstep = 2 * hstep;
    const unsigned ldsw = (unsigned)wid * 1024u;
    const int aoff = lds_byte(wr * 64 + fr, fq * 8), boff = lds_byte(wc * 32 + fr, fq * 8);
#define PG8_SA(b, h) (((b) * 2 + (h)) * HTB)
#define PG8_SB(b, h) ((4 + (b) * 2 + (h)) * HTB)
#define PG8_STAGE(bufoff, gbase, voff) do { _Pragma("unroll") for (int _i = 0; _i < 2; ++_i) \
        __builtin_amdgcn_global_load_lds((const unsigned*)((const char*)(gbase) + (voff)[_i]), (PG8_LAS unsigned*)(lds + (bufoff) + ldsw + _i * 8192), 16, 0, 0); } while (0)
#define PG8_LDA(dst, b, h) do { _Pragma("unroll") for (int m = 0; m < 4; ++m) _Pragma("unroll") for (int k = 0; k < 2; ++k) dst[m][k] = *(const PG8_LAS bf16x8*)(lds + PG8_SA(b, h) + aoff + m * 2048 + k * 1024); } while (0)
#define PG8_LDB(dst, b, h) do { _Pragma("unroll") for (int n = 0; n < 2; ++n) _Pragma("unroll") for (int k = 0; k < 2; ++k) dst[n][k] = *(const PG8_LAS bf16x8*)(lds + PG8_SB(b, h) + boff + n * 2048 + k * 1024); } while (0)
#define PG8_MMA(ai, bj, At, Bt) do { __builtin_amdgcn_s_setprio(1); _Pragma("unroll") for (int m = 0; m < 4; ++m) _Pragma("unroll") for (int n = 0; n < 2; ++n) _Pragma("unroll") for (int k = 0; k < 2; ++k) \
        acc[ai][bj][m][n] = __builtin_amdgcn_mfma_f32_16x16x32_bf16(Bt[n][k], At[m][k], acc[ai][bj][m][n], 0, 0, 0); __builtin_amdgcn_s_setprio(0); } while (0)
#define PG8_WAIT_V(n) asm volatile("s_waitcnt vmcnt(" #n ")" ::: "memory")
#define PG8_WAIT_L(n) asm volatile("s_waitcnt lgkmcnt(" #n ")" ::: "memory")
#define PG8_BAR __builtin_amdgcn_s_barrier()
#define PG8_SCHED __builtin_amdgcn_sched_barrier(0)
    Unit cur, nxt; int ui = 0;
    if (!S.next(0, cur)) return;
    f32x4 acc[2][2][4][2];
#pragma unroll
    for (int a = 0; a < 2; ++a)
#pragma unroll
        for (int b = 0; b < 2; ++b)
#pragma unroll
            for (int m = 0; m < 4; ++m)
#pragma unroll
                for (int n = 0; n < 2; ++n) acc[a][b][m][n] = (f32x4){0.f, 0.f, 0.f, 0.f};
    bf16x8 At[4][2], B0[2][2], B1[2][2];
    const char* cA = (const char*)g.A + (size_t)cur.pm * tstep; const char* cB = (const char*)g.Bt + (size_t)cur.pn * tstep;
    S.a_ready(cur);
    PG8_STAGE(PG8_SB(0, 0), cB, voffB); PG8_STAGE(PG8_SA(0, 0), cA, voffA); PG8_STAGE(PG8_SB(0, 1), cB + hstep, voffB); PG8_STAGE(PG8_SA(0, 1), cA + hstep, voffA);
    if (wr == 1) PG8_BAR;
    PG8_WAIT_V(4); PG8_BAR;
    PG8_STAGE(PG8_SB(1, 0), cB + kstep, voffB); PG8_STAGE(PG8_SA(1, 0), cA + kstep, voffA); PG8_STAGE(PG8_SB(1, 1), cB + hstep + kstep, voffB);
    PG8_WAIT_V(6); PG8_BAR;
    PG8_STAMP();
    for (;;) {
        const bool has_next = S.next(ui + 1, nxt);
        const char* nA = has_next ? (const char*)g.A + (size_t)nxt.pm * tstep : cA; const char* nB = has_next ? (const char*)g.Bt + (size_t)nxt.pn * tstep : cB;
        for (int t = 0; t < nt; t += 2) {
            const bool last = (t == nt - 2);
            const char* a1 = cA + (size_t)(t + 1) * kstep;
            const char* a2 = last ? nA : cA + (size_t)(t + 2) * kstep; const char* b2 = last ? nB : cB + (size_t)(t + 2) * kstep;
            const char* a3 = a2 + kstep; const char* b3 = b2 + kstep;
            if (last && has_next) S.a_ready(nxt);
            PG8_LDB(B0, 0, 0); PG8_SCHED; PG8_LDA(At, 0, 0); PG8_STAGE(PG8_SA(1, 1), a1 + hstep, voffA);
            PG8_WAIT_L(8); PG8_BAR; PG8_WAIT_L(0); PG8_MMA(0, 0, At, B0); PG8_BAR; PG8_SCHED;
            PG8_LDB(B1, 0, 1); PG8_STAGE(PG8_SB(0, 0), b2, voffB);
            PG8_BAR; PG8_WAIT_L(0); PG8_MMA(0, 1, At, B1); PG8_BAR;
            PG8_LDA(At, 0, 1); PG8_STAGE(PG8_SA(0, 0), a2, voffA);
            PG8_BAR; PG8_WAIT_L(0); PG8_MMA(1, 0, At, B0); PG8_BAR; PG8_SCHED;
            PG8_STAGE(PG8_SB(0, 1), b2 + hstep, voffB);
            PG8_WAIT_V(6); PG8_BAR; PG8_MMA(1, 1, At, B1); PG8_BAR;
            PG8_LDB(B0, 1, 0); PG8_SCHED; PG8_LDA(At, 1, 0); PG8_STAGE(PG8_SA(0, 1), a2 + hstep, voffA);
            PG8_WAIT_L(8); PG8_BAR; PG8_WAIT_L(0); PG8_MMA(0, 0, At, B0); PG8_BAR; PG8_SCHED;
            PG8_LDB(B1, 1, 1); PG8_STAGE(PG8_SB(1, 0), b3, voffB);
            PG8_BAR; PG8_WAIT_L(0); PG8_MMA(0, 1, At, B1); PG8_BAR;
            PG8_LDA(At, 1, 1); PG8_STAGE(PG8_SA(1, 0), a3, voffA);
            PG8_BAR; PG8_WAIT_L(0); PG8_MMA(1, 0, At, B0); PG8_BAR; PG8_SCHED;
            PG8_STAGE(PG8_SB(1, 1), b3 + hstep, voffB);
            PG8_WAIT_V(6); PG8_BAR; PG8_MMA(1, 1, At, B1); PG8_BAR;
        }
        PG8_STAMP();
        if constexpr (!Epi::AFTER_DRAIN) { E(acc, cur, wr, wc, fr, fq); S.done(cur); }
        PG8_STAMP();
        if (!has_next) break;
#pragma unroll
        for (int a = 0; a < 2; ++a)
#pragma unroll
            for (int b = 0; b < 2; ++b)
#pragma unroll
                for (int m = 0; m < 4; ++m)
#pragma unroll
                    for (int n = 0; n < 2; ++n) acc[a][b][m][n] = (f32x4){0.f, 0.f, 0.f, 0.f};
        cur = nxt; cA = nA; cB = nB; ++ui;
    }
    PG8_WAIT_V(0);
    if (wr == 0) PG8_BAR;
    PG8_BAR;
    if constexpr (Epi::AFTER_DRAIN) { E.fused(acc, cur, wr, wc, fr, fq, lds, wid, lane); S.done(cur); }
    PG8_STAMP();
    if (STAMP && wid == 0) { stamps[lane] = lane < nts ? (((unsigned long long)(unsigned)ts_hi << 32) | (unsigned)ts_lo) : 0ull;
        if (lane == 62) stamps[62] = rt_entry; if (lane == 63) stamps[63] = (unsigned long long)wall_clock64(); }
#undef PG8_STAMP
#undef PG8_SA
#undef PG8_SB
#undef PG8_STAGE
#undef PG8_LDA
#undef PG8_LDB
#undef PG8_MMA
#undef PG8_WAIT_V
#undef PG8_WAIT_L
#undef PG8_BAR
#undef PG8_SCHED
}
}

struct PanelOrder {
  int c, npn;
  __device__ bool next(int i, pg8::Unit& u) const { if (i >= npn) return false; u.pm = c; u.pn = i; return true; }
  __device__ __forceinline__ void a_ready(const pg8::Unit&) const {}
  __device__ __forceinline__ void done(const pg8::Unit&) const {}
};

struct EpiP1 {
  static constexpr bool PERM = true, AFTER_DRAIN = false;
  char* ws;
  __device__ __forceinline__ void operator()(const pg8::f32x4 (&acc)[2][2][4][2], const pg8::Unit& u, int wr, int wc, int fr, int fq) const {
#pragma unroll
    for (int bj = 0; bj < 2; ++bj) {
      const int nt = u.pn * 2 + bj;
      if (nt >= 27) continue;
      const int cn0 = wc * 32 + fq * 8;
      bf16_t* dst = nullptr;
      int ld = 512, colbase = 0, act = 0;
      bool transposed = false;
      if (nt < 4) { dst = (bf16_t*)(ws + OFF_Q); colbase = nt * 128; act = 1; }
      else if (nt == 4) { dst = (bf16_t*)(ws + OFF_KC); ld = 128; }
      else if (nt == 5) { dst = (bf16_t*)(ws + OFF_VC); ld = 128; }
      else if (nt == 6) { dst = (bf16_t*)(ws + OFF_KS); ld = 128; }
      else if (nt == 7) { dst = (bf16_t*)(ws + OFF_VST); transposed = true; }
      else if (nt == 8) { dst = (bf16_t*)(ws + OFF_KW); ld = 128; }
      else if (nt == 9) { dst = (bf16_t*)(ws + OFF_VWT); transposed = true; }
      else if (nt < 14) { dst = (bf16_t*)(ws + OFF_ZN); colbase = (nt - 10) * 128; }
      else if (nt < 18) { dst = (bf16_t*)(ws + OFF_U); colbase = (nt - 14) * 128; }
      else if (nt < 22) { dst = (bf16_t*)(ws + OFF_V); colbase = (nt - 18) * 128; }
      else if (nt < 26) { dst = (bf16_t*)(ws + OFF_ZG); colbase = (nt - 22) * 128; }
#pragma unroll
      for (int ai = 0; ai < 2; ++ai)
#pragma unroll
        for (int m = 0; m < 4; ++m) {
          const int row = u.pm * 256 + ai * 128 + wr * 64 + m * 16 + fr;
          float v[8];
#pragma unroll
          for (int j = 0; j < 4; ++j) { v[j] = acc[ai][bj][m][0][j]; v[4 + j] = acc[ai][bj][m][1][j]; }
          if (nt == 26) {
            if (cn0 < 24) {
              float* G = (float*)(ws + OFF_GATES) + (size_t)row * 24 + cn0;
              float4 g0, g1;
              g0.x = sigmoid_f(v[0]); g0.y = sigmoid_f(v[1]); g0.z = sigmoid_f(v[2]); g0.w = sigmoid_f(v[3]);
              g1.x = sigmoid_f(v[4]); g1.y = sigmoid_f(v[5]); g1.z = sigmoid_f(v[6]); g1.w = sigmoid_f(v[7]);
              *(float4*)G = g0;
              *(float4*)(G + 4) = g1;
            }
          } else if (transposed) {
            const int b = row >> 12, t = row & 4095;
            bf16_t* dp = dst + ((size_t)((b * 2 + (cn0 >> 6)) * 64 + (cn0 & 63))) * 4096 + t;
#pragma unroll
            for (int j = 0; j < 8; ++j) dp[(size_t)j * 4096] = f2bf(v[j]);
          } else {
            if (act == 1) {
#pragma unroll
              for (int j = 0; j < 8; ++j) v[j] *= 0.125f;
            } else if (act == 2) {
#pragma unroll
              for (int j = 0; j < 8; ++j) v[j] = silu_f(v[j]);
            } else if (act == 3) {
#pragma unroll
              for (int j = 0; j < 8; ++j) v[j] = gelu_t(v[j]);
            }
            u32x4 o;
            o[0] = pack2(v[0], v[1]); o[1] = pack2(v[2], v[3]); o[2] = pack2(v[4], v[5]); o[3] = pack2(v[6], v[7]);
            *(u32x4*)(dst + (size_t)row * ld + colbase + cn0) = o;
          }
          __builtin_amdgcn_sched_barrier(0);
        }
    }
  }
};

struct EpiP4 {
  static constexpr bool PERM = true, AFTER_DRAIN = false;
  const float* x;
  bf16_t* hb;
  float* rowss;
  __device__ __forceinline__ void operator()(const pg8::f32x4 (&acc)[2][2][4][2], const pg8::Unit& u, int wr, int wc, int fr_in, int fq) const {
    int fr = fr_in;
    asm volatile("" : "+v"(fr));
    int pm_ = u.pm;
    asm volatile("" : "+s"(pm_));
#pragma unroll
    for (int ai = 0; ai < 2; ++ai)
#pragma unroll
      for (int m = 0; m < 4; ++m) {
        const int rl = ai * 128 + wr * 64 + m * 16 + fr;
        const size_t rowoff = ((size_t)pm_ * 256 + rl) * 1024;
        float4 xv[2][2];
#pragma unroll
        for (int bj = 0; bj < 2; ++bj) {
          const int col = u.pn * 256 + bj * 128 + wc * 32 + fq * 8;
          xv[bj][0] = *(const float4*)(x + rowoff + col);
          xv[bj][1] = *(const float4*)(x + rowoff + col + 4);
        }
        float ss = 0.f;
#pragma unroll
        for (int bj = 0; bj < 2; ++bj) {
          const int col = u.pn * 256 + bj * 128 + wc * 32 + fq * 8;
          float v[8];
          v[0] = acc[ai][bj][m][0][0] + xv[bj][0].x; v[1] = acc[ai][bj][m][0][1] + xv[bj][0].y;
          v[2] = acc[ai][bj][m][0][2] + xv[bj][0].z; v[3] = acc[ai][bj][m][0][3] + xv[bj][0].w;
          v[4] = acc[ai][bj][m][1][0] + xv[bj][1].x; v[5] = acc[ai][bj][m][1][1] + xv[bj][1].y;
          v[6] = acc[ai][bj][m][1][2] + xv[bj][1].z; v[7] = acc[ai][bj][m][1][3] + xv[bj][1].w;
#pragma unroll
          for (int j = 0; j < 8; ++j) ss += v[j] * v[j];
          u32x4 o;
          o[0] = pack2(v[0], v[1]); o[1] = pack2(v[2], v[3]); o[2] = pack2(v[4], v[5]); o[3] = pack2(v[6], v[7]);
          *(u32x4*)(hb + rowoff + col) = o;
        }
        ss += shx(ss, 16, fq * 16 + fr);
        ss += shx(ss, 32, fq * 16 + fr);
        if (fq == 0) __hip_atomic_fetch_add(rowss + (size_t)pm_ * 256 + rl, ss, __ATOMIC_RELAXED, __HIP_MEMORY_SCOPE_AGENT);
      }
  }
};

DI void compress_item(const Params& p, char* smem, int it, bool active) {
  const int tid = opaque_tid() & 255, lane = tid & 63, wave = tid >> 6;
  const int r = lane & 31, h = lane >> 5;
  const int kv = it >> 8, b = (it >> 4) & 15, g = (it >> 3) & 1, n0 = (it & 7) * 32;
  float* hidL = (float*)smem;
  if (active) {
    const bf16_t* src = (const bf16_t*)(p.ws + (kv ? OFF_VC : OFF_KC));
    const bf16_t* w1t = (const bf16_t*)(p.ws + (kv ? OFF_W1TV : OFF_W1TK));
    const float* bias = (const float*)(p.ws + OFF_BIAS) + kv * 128;
    f32x16 acc;
#pragma unroll
    for (int i = 0; i < 16; ++i) acc[i] = 0.f;
    const int n = n0 + r;
    const bf16_t* brow = w1t + (size_t)(32 * wave + r) * 2048 + h * 8;
#pragma unroll 8
    for (int l = 0; l < 32; ++l) {
      int tok = 16 * n + l;
      tok = tok > 4095 ? 4095 : tok;
      const bf16_t* arow = src + ((size_t)b * 4096 + tok) * 128 + g * 64 + h * 8;
#pragma unroll
      for (int s = 0; s < 4; ++s) {
        const s16x8 af = *(const s16x8*)(arow + s * 16);
        const s16x8 bfr = *(const s16x8*)(brow + l * 64 + s * 16);
        acc = MFMA32(af, bfr, acc);
      }
    }
    const int e = 32 * wave + r;
    const float be = bias[e];
#pragma unroll
    for (int i = 0; i < 16; ++i) hidL[crow(i, h) * 132 + e] = gelu_t(acc[i] + be);
  }
  __syncthreads();
  if (active) {
    const float* w2 = (const float*)(p.ws + OFF_SMALL) + (kv ? SM_W2V : SM_W2K);
    const int f = tid & 63, ng = tid >> 6;
    float o[8];
#pragma unroll
    for (int k = 0; k < 8; ++k) o[k] = 0.f;
    for (int e0 = 0; e0 < 128; e0 += 16) {
      float wv[16];
#pragma unroll
      for (int j = 0; j < 16; ++j) wv[j] = w2[(e0 + j) * 64 + f];
#pragma unroll
      for (int j = 0; j < 16; ++j)
#pragma unroll
        for (int k = 0; k < 8; ++k) o[k] += hidL[(ng * 8 + k) * 132 + e0 + j] * wv[j];
    }
    const int bg = b * 2 + g;
#pragma unroll
    for (int k = 0; k < 8; ++k) {
      const int nn = n0 + ng * 8 + k;
      const float val = (nn < 255) ? o[k] : 0.f;
      if (kv == 0) ((bf16_t*)(p.ws + OFF_KCMP))[((size_t)bg * 256 + nn) * 64 + f] = f2bf(val);
      else ((bf16_t*)(p.ws + OFF_VCMPT))[((size_t)bg * 64 + f) * 256 + nn] = f2bf(val);
    }
  }
  __syncthreads();
}

DI void gmlp_item(const Params& p, char* smem, int it, bool active) {
  const int tid = opaque_tid() & 255, lane = tid & 63, wave = tid >> 6;
  const int r = lane & 31, h = lane >> 5;
  const int gg = it & 7, ck = (it >> 3) & 31, b = it >> 8;
  const size_t tokbase = (size_t)b * 4096 + ck * 128;
  const bf16_t* V = (const bf16_t*)(p.ws + OFF_V);
  const bf16_t* U = (const bf16_t*)(p.ws + OFF_U);
  const bf16_t* ZG = (const bf16_t*)(p.ws + OFF_ZG);
  const bf16_t* WSP = (const bf16_t*)(p.ws + OFF_WSP);
  bf16_t* MIX = (bf16_t*)(p.ws + OFF_MIX);
  const float* SMALLP = (const float*)(p.ws + OFF_SMALL);
  char* vnT = smem;
  float* mxl = (float*)(smem + 17408);
  const int tl = tid >> 1, half = tid & 1, d0 = half * 32;
  u32x4 uu4[4], zz4[4];
  if (active) {
    const size_t off0 = (tokbase + tl) * 512 + gg * 64 + d0;
#pragma unroll
    for (int q = 0; q < 4; ++q) { uu4[q] = *(const u32x4*)(U + off0 + q * 8); zz4[q] = *(const u32x4*)(ZG + off0 + q * 8); }
  }
  if (active) {
    float v[32];
    const bf16_t* vp = V + (tokbase + tl) * 512 + gg * 64 + d0;
#pragma unroll
    for (int q = 0; q < 4; ++q) {
      const u32x4 w = *(const u32x4*)(vp + q * 8);
#pragma unroll
      for (int k = 0; k < 4; ++k) { const f2a g2 = gelu2((f2a){bflo(w[k]), bfhi(w[k])}); v[q * 8 + 2 * k] = g2.x; v[q * 8 + 2 * k + 1] = g2.y; }
    }
    float s1 = 0.f;
#pragma unroll
    for (int j = 0; j < 32; ++j) s1 += v[j];
    s1 += shx(s1, 1, lane);
    const float mu = s1 * (1.f / 64.f);
    float s2 = 0.f;
#pragma unroll
    for (int j = 0; j < 32; ++j) { const float d = v[j] - mu; s2 += d * d; }
    s2 += shx(s2, 1, lane);
    const float rstd = rsqrtf(s2 * (1.f / 64.f) + 1e-6f);
#pragma unroll
    for (int j = 0; j < 32; ++j) {
      const float vn = (v[j] - mu) * rstd * SMALLP[SM_LNG + gg * 64 + d0 + j] + SMALLP[SM_LNB + gg * 64 + d0 + j];
      *(bf16_t*)(vnT + (d0 + j) * 272 + tl * 2) = f2bf(vn);
    }
  }
  __syncthreads();
  if (active) {
    f32x16 acc[2];
#pragma unroll
    for (int c = 0; c < 2; ++c)
#pragma unroll
      for (int i = 0; i < 16; ++i) acc[c][i] = 0.f;
    const bf16_t* arow = WSP + ((size_t)gg * 128 + 32 * wave + r) * 128 + h * 8;
    const int nks = 2 * (wave + 1);
    for (int ks = 0; ks < nks; ++ks) {
      const s16x8 af = *(const s16x8*)(arow + ks * 16);
#pragma unroll
      for (int c = 0; c < 2; ++c) {
        const s16x8 bfr = *(const s16x8*)(vnT + (c * 32 + r) * 272 + (ks * 16 + h * 8) * 2);
        acc[c] = MFMA32(af, bfr, acc[c]);
      }
    }
#pragma unroll
    for (int i = 0; i < 16; ++i) {
      const int t = 32 * wave + crow(i, h);
      const float bs = SMALLP[SM_BSP + gg * 128 + t];
#pragma unroll
      for (int c = 0; c < 2; ++c) mxl[t * 68 + c * 32 + r] = acc[c][i] + bs;
    }
  }
  __syncthreads();
  if (active) {
    const size_t off = (tokbase + tl) * 512 + gg * 64 + d0;
    bf16_t* op = MIX + (tokbase + tl) * 1024 + 512 + gg * 64 + d0;
#pragma unroll
    for (int q = 0; q < 4; ++q) {
      const u32x4 uu = uu4[q];
      const u32x4 zz = zz4[q];
      const float4 m0 = *(const float4*)(mxl + tl * 68 + d0 + q * 8);
      const float4 m1 = *(const float4*)(mxl + tl * 68 + d0 + q * 8 + 4);
      u32x4 o;
#define GM2_(uw, zw, ma, mb) pack2v(gelu2((f2a){bflo(uw), bfhi(uw)}) * (f2a){(ma), (mb)} * silu2((f2a){bflo(zw), bfhi(zw)}))
      o[0] = GM2_(uu[0], zz[0], m0.x, m0.y);
      o[1] = GM2_(uu[1], zz[1], m0.z, m0.w);
      o[2] = GM2_(uu[2], zz[2], m1.x, m1.y);
      o[3] = GM2_(uu[3], zz[3], m1.z, m1.w);
#undef GM2_
      *(u32x4*)(op + q * 8) = o;
    }
  }
  __syncthreads();
}

DI void qk1(const char* Kl, const s16x8 (&qf)[4], f32x16 (&S)[2], int r, int h) {
#pragma unroll
  for (int a = 0; a < 2; ++a)
#pragma unroll
    for (int i = 0; i < 16; ++i) S[a][i] = 0.f;
#pragma unroll
  for (int kt2 = 0; kt2 < 2; ++kt2)
#pragma unroll
    for (int s = 0; s < 4; ++s) {
      const s16x8 kf = *(const s16x8*)(Kl + (kt2 * 32 + r) * 144 + s * 32 + h * 16);
      S[kt2] = MFMA32(kf, qf[s], S[kt2]);
    }
}
DI void pv1(const char* Vl, const f32x16 (&S)[2], f32x16 (&O)[2], int r, int h) {
#pragma unroll
  for (int kt2 = 0; kt2 < 2; ++kt2)
#pragma unroll
    for (int s2 = 0; s2 < 2; ++s2) {
      u32x4 pk;
      pk[0] = pack2(S[kt2][8 * s2 + 0], S[kt2][8 * s2 + 1]);
      pk[1] = pack2(S[kt2][8 * s2 + 2], S[kt2][8 * s2 + 3]);
      pk[2] = pack2(S[kt2][8 * s2 + 4], S[kt2][8 * s2 + 5]);
      pk[3] = pack2(S[kt2][8 * s2 + 6], S[kt2][8 * s2 + 7]);
      const s16x8 pf = __builtin_bit_cast(s16x8, pk);
#pragma unroll
      for (int dt = 0; dt < 2; ++dt) {
        const char* vp = Vl + (dt * 32 + r) * 144 + (kt2 * 32 + 16 * s2 + 4 * h) * 2;
        const s16x4 lo = *(const s16x4*)(vp);
        const s16x4 hi = *(const s16x4*)(vp + 16);
        const s16x8 vf = __builtin_shufflevector(lo, hi, 0, 1, 2, 3, 4, 5, 6, 7);
        O[dt] = MFMA32(vf, pf, O[dt]);
      }
    }
}
DI float max3f(float a, float b, float c) {
  float d;
  asm("v_max3_f32 %0, %1, %2, %3" : "=v"(d) : "v"(a), "v"(b), "v"(c));
  return d;
}
typedef float f2v __attribute__((ext_vector_type(2)));
DI float max17f(float a, const f32x16& x) {
  float d;
  asm("v_max3_f32 %0, %1, %2, %3\n\t"
      "v_max3_f32 %0, %0, %4, %5\n\t"
      "v_max3_f32 %0, %0, %6, %7\n\t"
      "v_max3_f32 %0, %0, %8, %9\n\t"
      "v_max3_f32 %0, %0, %10, %11\n\t"
      "v_max3_f32 %0, %0, %12, %13\n\t"
      "v_max3_f32 %0, %0, %14, %15\n\t"
      "v_max3_f32 %0, %0, %16, %17"
      : "=&v"(d)
      : "v"(a), "v"(x[0]), "v"(x[1]), "v"(x[2]), "v"(x[3]), "v"(x[4]), "v"(x[5]), "v"(x[6]), "v"(x[7]), "v"(x[8]), "v"(x[9]),
        "v"(x[10]), "v"(x[11]), "v"(x[12]), "v"(x[13]), "v"(x[14]), "v"(x[15]));
  return d;
}

DI void softmax1(f32x16 (&S)[2], int kbase, int lo, int hi, bool fast, bool rowok, float& m, float& l,
                 f32x16 (&O)[2], int h, int lane) {
  float mx = -1e30f;
  const int lo2 = lo - kbase - 4 * h, hi2 = hi - kbase - 4 * h;
  if (fast) {
#pragma unroll
    for (int kt2 = 0; kt2 < 2; ++kt2) mx = max17f(mx, S[kt2]);
    mx = rowok ? mx : -1e30f;
  } else {
#pragma unroll
    for (int kt2 = 0; kt2 < 2; ++kt2)
#pragma unroll
      for (int i = 0; i < 16; ++i) {
        const int ci = kt2 * 32 + (i & 3) + 8 * (i >> 2);
        mx = (ci >= lo2 && ci <= hi2) ? fmaxf(mx, S[kt2][i]) : mx;
      }
  }
  mx = xhalf_max(mx);
  const float mnew = fmaxf(m, mx);
  const float alpha = __builtin_amdgcn_exp2f((m - mnew) * L2E);
  const float mL = mnew * L2E;
  float sum = 0.f;
  if (fast) {
    const float mLe = rowok ? mL : 3.0e38f;
    f2v sumv = {0.f, 0.f};
#pragma unroll
    for (int kt2 = 0; kt2 < 2; ++kt2)
#pragma unroll
      for (int i = 0; i < 16; i += 2) {
        f2v t = {S[kt2][i], S[kt2][i + 1]};
        t = __builtin_elementwise_fma(t, (f2v){L2E, L2E}, (f2v){-mLe, -mLe});
        f2v pv2 = {__builtin_amdgcn_exp2f(t.x), __builtin_amdgcn_exp2f(t.y)};
        S[kt2][i] = pv2.x;
        S[kt2][i + 1] = pv2.y;
        sumv += pv2;
      }
    sum = sumv.x + sumv.y;
  } else {
#pragma unroll
    for (int kt2 = 0; kt2 < 2; ++kt2)
#pragma unroll
      for (int i = 0; i < 16; ++i) {
        const int ci = kt2 * 32 + (i & 3) + 8 * (i >> 2);
        const float pv = (ci >= lo2 && ci <= hi2) ? __builtin_amdgcn_exp2f(__builtin_fmaf(S[kt2][i], L2E, -mL)) : 0.f;
        S[kt2][i] = pv;
        sum += pv;
      }
  }
  l = l * alpha + sum;
  if (__builtin_amdgcn_ballot_w64(mnew > m) != 0ull) {
#pragma unroll
    for (int dt = 0; dt < 2; ++dt)
#pragma unroll
      for (int i = 0; i < 16; ++i) O[dt][i] *= alpha;
  }
  m = mnew;
}

DI void attn_item(const Params& p, char* smem, int c, int b, int g) {
  const int tid = opaque_tid(), lane = tid & 63, wave = tid >> 6;
  const int r = lane & 31, h = lane >> 5;
  const int hl = wave & 3, qt = wave >> 2;
  const int hd = g * 4 + hl, bg = b * 2 + g;
  const int ql = qt * 32 + r;
  const size_t tok = (size_t)b * 4096 + c * 64 + ql;
  const int tq = c * 64 + ql;
  float* imp = (float*)(smem + 36864);
  unsigned char* selm = (unsigned char*)(smem + 53248);
  const bf16_t* KCMP = (const bf16_t*)(p.ws + OFF_KCMP) + (size_t)bg * 256 * 64;
  const bf16_t* VCMPT = (const bf16_t*)(p.ws + OFF_VCMPT) + (size_t)bg * 64 * 256;
  const bf16_t* KS = (const bf16_t*)(p.ws + OFF_KS) + (size_t)b * 4096 * 128 + g * 64;
  const bf16_t* KW = (const bf16_t*)(p.ws + OFF_KW) + (size_t)b * 4096 * 128 + g * 64;
  const bf16_t* VST = (const bf16_t*)(p.ws + OFF_VST) + (size_t)bg * 64 * 4096;
  const bf16_t* VWT = (const bf16_t*)(p.ws + OFF_VWT) + (size_t)bg * 64 * 4096;

  s16x8 qf[4];
  {
    const bf16_t* qp = (const bf16_t*)(p.ws + OFF_Q) + tok * 512 + hd * 64 + h * 8;
#pragma unroll
    for (int s = 0; s < 4; ++s) qf[s] = *(const s16x8*)(qp + s * 16);
  }
  const float* gp = (const float*)(p.ws + OFF_GATES) + tok * 24 + hd * 3;
  const float gate0 = gp[0], gate1 = gp[1], gate2 = gp[2];

  const int nct = ((4 * c + 2) >> 6) + 1, nsel = c + 1, j0 = c >= 8 ? c - 8 : 0, nwin = c - j0 + 1;
  const int total = 2 * nct + nsel + nwin;
  const int srow = tid >> 3, scc = tid & 7;
  u32x4 kreg, vreg;
#define ATT_ISSUE(sidx)                                                                          \
  do {                                                                                           \
    const int s_ = (sidx);                                                                       \
    const bf16_t *kp_, *vp_;                                                                     \
    int kpi_, vpi_;                                                                              \
    if (s_ < 2 * nct) { const int ct_ = s_ < nct ? s_ : s_ - nct; kp_ = KCMP + ct_ * 4096; kpi_ = 64; vp_ = VCMPT + ct_ * 64; vpi_ = 256; } \
    else if (s_ < 2 * nct + nsel) { const int j_ = s_ - 2 * nct; kp_ = KS + (size_t)j_ * 8192; kpi_ = 128; vp_ = VST + j_ * 64; vpi_ = 4096; } \
    else { const int j_ = j0 + s_ - 2 * nct - nsel; kp_ = KW + (size_t)j_ * 8192; kpi_ = 128; vp_ = VWT + j_ * 64; vpi_ = 4096; } \
    kreg = *(const u32x4*)(kp_ + srow * kpi_ + scc * 8);                                         \
    vreg = *(const u32x4*)(vp_ + (size_t)srow * vpi_ + scc * 8);                                 \
  } while (0)
#define ATT_COMMIT(buf)                                                                          \
  do {                                                                                           \
    *(u32x4*)(smem + (buf) * 9216 + srow * 144 + scc * 16) = kreg;                               \
    *(u32x4*)(smem + 18432 + (buf) * 9216 + srow * 144 + scc * 16) = vreg;                       \
  } while (0)
#define ATT_PRE(s)  do { if ((s) + 1 < total) ATT_ISSUE((s) + 1); } while (0)
#define ATT_POST(s) do { if ((s) + 1 < total) ATT_COMMIT(((s) + 1) & 1); __syncthreads(); } while (0)

  ATT_ISSUE(0);
  ATT_COMMIT(0);
  for (int i = tid; i < 4096; i += NTHR) imp[i] = 0.f;
  __syncthreads();

  f32x16 S[2], O[2], Oout[2];
  float m, l;
  int s = 0;
  const int hic = (tq - 31) >> 4;
  m = -1e30f; l = 0.f;
  for (int ct = 0; ct < nct; ++ct, ++s) {
    ATT_PRE(s);
    qk1(smem + (s & 1) * 9216, qf, S, r, h);
    float mx = -1e30f;
    const int hi2 = hic - ct * 64 - 4 * h;
#pragma unroll
    for (int kt2 = 0; kt2 < 2; ++kt2)
#pragma unroll
      for (int i = 0; i < 16; ++i) {
        const int ci = kt2 * 32 + (i & 3) + 8 * (i >> 2);
        mx = (ci <= hi2) ? fmaxf(mx, S[kt2][i]) : mx;
      }
    mx = xhalf_max(mx);
    const float mnew = fmaxf(m, mx);
    const float alpha = __builtin_amdgcn_exp2f((m - mnew) * L2E);
    const float mL = mnew * L2E;
    float sum = 0.f;
#pragma unroll
    for (int kt2 = 0; kt2 < 2; ++kt2)
#pragma unroll
      for (int i = 0; i < 16; ++i) {
        const int ci = kt2 * 32 + (i & 3) + 8 * (i >> 2);
        sum += (ci <= hi2) ? __builtin_amdgcn_exp2f(__builtin_fmaf(S[kt2][i], L2E, -mL)) : 0.f;
      }
    l = l * alpha + sum;
    m = mnew;
    ATT_POST(s);
  }
  {
    const float lt = xhalf_sum(l);
    const float inv = (hic >= 0 && lt > 0.f) ? 1.f / lt : 0.f;
    const float mL = m * L2E;
#pragma unroll
    for (int a = 0; a < 2; ++a)
#pragma unroll
      for (int i = 0; i < 16; ++i) O[a][i] = 0.f;
    for (int ct = 0; ct < nct; ++ct, ++s) {
      ATT_PRE(s);
      qk1(smem + (s & 1) * 9216, qf, S, r, h);
      const int hi2 = hic - ct * 64 - 4 * h;
#pragma unroll
      for (int kt2 = 0; kt2 < 2; ++kt2)
#pragma unroll
        for (int i = 0; i < 16; ++i) {
          const int ci = kt2 * 32 + (i & 3) + 8 * (i >> 2);
          S[kt2][i] = (ci <= hi2) ? __builtin_amdgcn_exp2f(__builtin_fmaf(S[kt2][i], L2E, -mL)) * inv : 0.f;
        }
      if (c >= 16) {
        float* irow = imp + ql * 64;
#pragma unroll
        for (int kt2 = 0; kt2 < 2; ++kt2)
#pragma unroll
          for (int gi = 0; gi < 4; ++gi) {
            const int jb = ct * 16 + kt2 * 8 + 2 * gi + h;
            const float a4 = (S[kt2][4 * gi] + S[kt2][4 * gi + 1]) + (S[kt2][4 * gi + 2] + S[kt2][4 * gi + 3]);
            __hip_atomic_fetch_add(irow + jb, a4, __ATOMIC_RELAXED, __HIP_MEMORY_SCOPE_WORKGROUP);
            if (jb + 1 < 64)
              __hip_atomic_fetch_add(irow + jb + 1, S[kt2][4 * gi + 3], __ATOMIC_RELAXED, __HIP_MEMORY_SCOPE_WORKGROUP);
          }
      }
      pv1(smem + 18432 + (s & 1) * 9216, S, O, r, h);
      ATT_POST(s);
    }
#pragma unroll
    for (int dt = 0; dt < 2; ++dt)
#pragma unroll
      for (int i = 0; i < 16; ++i) Oout[dt][i] = gate0 * O[dt][i];
  }
  {
    const int tr_ = opaque_tid();
    const int q = tr_ >> 3, part = tr_ & 7;
    unsigned bits = 0;
    if (c >= 16) {
      unsigned key[8];
#pragma unroll
      for (int k = 0; k < 8; ++k) {
        const int j = part * 8 + k;
        const unsigned u = __float_as_uint(imp[q * 64 + j]);
        key[k] = (j >= 1 && j <= c - 2) ? ((u & ~63u) | (unsigned)(63 - j)) : 0u;
      }
      for (int rd = 0; rd < 13; ++rd) {
        unsigned lm = key[0];
#pragma unroll
        for (int k = 1; k < 8; ++k) lm = lm > key[k] ? lm : key[k];
#pragma unroll
        for (int o = 1; o <= 4; o <<= 1) {
          const unsigned ot = shxu(lm, o, tr_ & 63);
          lm = lm > ot ? lm : ot;
        }
#pragma unroll
        for (int k = 0; k < 8; ++k) {
          const bool hit = (key[k] == lm) && (lm != 0u);
          bits |= hit ? (1u << k) : 0u;
          key[k] = hit ? 0u : key[k];
        }
      }
#pragma unroll
      for (int k = 0; k < 8; ++k) {
        const int j = part * 8 + k;
        if (j == 0 || j == c || j == c - 1) bits |= (1u << k);
      }
    } else {
#pragma unroll
      for (int k = 0; k < 8; ++k) {
        const int j = part * 8 + k;
        if (j <= c) bits |= (1u << k);
      }
    }
    selm[q * 8 + part] = (unsigned char)bits;
  }
  __syncthreads();
  const u64 sm = *(const u64*)(selm + ql * 8);

  m = -1e30f; l = 0.f;
#pragma unroll
  for (int a = 0; a < 2; ++a)
#pragma unroll
    for (int i = 0; i < 16; ++i) O[a][i] = 0.f;
  for (int j = 0; j <= c; ++j, ++s) {
    {
      const bool more_ = j < c;
      const bf16_t* kp_ = more_ ? KS + (size_t)(j + 1) * 8192 : KW + (size_t)j0 * 8192;
      const bf16_t* vp_ = more_ ? VST + (j + 1) * 64 : VWT + j0 * 64;
      kreg = *(const u32x4*)(kp_ + srow * 128 + scc * 8);
      vreg = *(const u32x4*)(vp_ + (size_t)srow * 4096 + scc * 8);
    }
    qk1(smem + (s & 1) * 9216, qf, S, r, h);
    const bool selq = ((sm >> j) & 1ull) != 0ull;
    softmax1(S, j * 64, 0, selq ? tq : -1, j < c, selq, m, l, O, h, lane);
    pv1(smem + 18432 + (s & 1) * 9216, S, O, r, h);
    ATT_POST(s);
  }
  {
    const float lt = xhalf_sum(l);
    const float sc = gate1 / lt;
#pragma unroll
    for (int dt = 0; dt < 2; ++dt)
#pragma unroll
      for (int i = 0; i < 16; ++i) Oout[dt][i] += sc * O[dt][i];
  }
  m = -1e30f; l = 0.f;
#pragma unroll
  for (int a = 0; a < 2; ++a)
#pragma unroll
    for (int i = 0; i < 16; ++i) O[a][i] = 0.f;
  for (int j = j0; j <= c; ++j, ++s) {
    if (j < c) {
      kreg = *(const u32x4*)(KW + (size_t)(j + 1) * 8192 + srow * 128 + scc * 8);
      vreg = *(const u32x4*)(VWT + (j + 1) * 64 + (size_t)srow * 4096 + scc * 8);
    }
    qk1(smem + (s & 1) * 9216, qf, S, r, h);
    softmax1(S, j * 64, tq - 511, tq, (j >= c - 7) && (j < c), true, m, l, O, h, lane);
    pv1(smem + 18432 + (s & 1) * 9216, S, O, r, h);
    ATT_POST(s);
  }
  {
    const float lt = xhalf_sum(l);
    const float sc = gate2 / lt;
#pragma unroll
    for (int dt = 0; dt < 2; ++dt)
#pragma unroll
      for (int i = 0; i < 16; ++i) Oout[dt][i] += sc * O[dt][i];
  }
  {
    const bf16_t* ZN = (const bf16_t*)(p.ws + OFF_ZN) + tok * 512 + hd * 64;
    bf16_t* MIX = (bf16_t*)(p.ws + OFF_MIX) + tok * 1024 + hd * 64;
#pragma unroll
    for (int dt = 0; dt < 2; ++dt)
#pragma unroll
      for (int gi = 0; gi < 4; ++gi) {
        const int d = dt * 32 + 8 * gi + 4 * h;
        const u32x2 z = *(const u32x2*)(ZN + d);
        u32x2 o;
        o[0] = pack2(Oout[dt][4 * gi + 0] * silu_f(bflo(z[0])), Oout[dt][4 * gi + 1] * silu_f(bfhi(z[0])));
        o[1] = pack2(Oout[dt][4 * gi + 2] * silu_f(bflo(z[1])), Oout[dt][4 * gi + 3] * silu_f(bfhi(z[1])));
        *(u32x2*)(MIX + d) = o;
      }
  }
  __syncthreads();
#undef ATT_ISSUE
#undef ATT_COMMIT
#undef ATT_PRE
#undef ATT_POST
}

DI void phase3(const Params& p, char* smem) {
  unsigned* qctr = (unsigned*)(p.ws + OFF_QCTR);
  volatile int* qw = (volatile int*)(smem + 134160);
  const bool t0 = threadIdx.x == 0;
  int nxt = 0;
  if (t0) nxt = (int)__hip_atomic_fetch_add(qctr, 1u, __ATOMIC_RELAXED, __HIP_MEMORY_SCOPE_AGENT);
  for (;;) {
    if (t0) *qw = nxt;
    __syncthreads();
    const int idx = *qw;
    __syncthreads();
    if (idx >= 4096) break;
    if (t0) nxt = (int)__hip_atomic_fetch_add(qctr, 1u, __ATOMIC_RELAXED, __HIP_MEMORY_SCOPE_AGENT);
    if (idx < 2048) {
      const int c = 63 - (idx >> 5), bgi = idx & 31;
      attn_item(p, smem, c, bgi >> 1, bgi & 1);
    } else {
      const int half = (int)(threadIdx.x >> 8);
      gmlp_item(p, smem + half * 52224, (idx - 2048) * 2 + half, true);
    }
  }
}

struct OneUnit {
  pg8::Unit u0;
  __device__ bool next(int i, pg8::Unit& u) const { if (i != 0) return false; u = u0; return true; }
  __device__ __forceinline__ void a_ready(const pg8::Unit&) const {}
  __device__ __forceinline__ void done(const pg8::Unit&) const {}
};
struct EpiP4F {
  static constexpr bool PERM = true, AFTER_DRAIN = true;
  const float* x;
  float* out;
  float* rowss;
  unsigned* pcnt;
  const float* gvec;
  __device__ __forceinline__ void operator()(const pg8::f32x4 (&)[2][2][4][2], const pg8::Unit&, int, int, int, int) const {}
  __device__ __forceinline__ void fused(const pg8::f32x4 (&acc_c)[2][2][4][2], const pg8::Unit& u, int wr, int wc, int fr, int fq,
                                        PG8_LAS unsigned char* lds, int wid, int lane) const {
    auto& acc = const_cast<pg8::f32x4 (&)[2][2][4][2]>(acc_c);
    PG8_LAS float* rl = (PG8_LAS float*)lds;
    const int tid = wid * 64 + lane;
    if (tid < 256) rl[tid] = 0.f;
    __syncthreads();
#pragma unroll
    for (int ai = 0; ai < 2; ++ai)
#pragma unroll
      for (int m = 0; m < 4; ++m) {
        const int row_l = ai * 128 + wr * 64 + m * 16 + fr;
        const size_t rowoff = ((size_t)u.pm * 256 + row_l) * 1024;
        float ss = 0.f;
#pragma unroll
        for (int bj = 0; bj < 2; ++bj) {
          const int col = u.pn * 256 + bj * 128 + wc * 32 + fq * 8;
          const float4 x0 = *(const float4*)(x + rowoff + col);
          const float4 x1 = *(const float4*)(x + rowoff + col + 4);
          acc[ai][bj][m][0][0] += x0.x; acc[ai][bj][m][0][1] += x0.y; acc[ai][bj][m][0][2] += x0.z; acc[ai][bj][m][0][3] += x0.w;
          acc[ai][bj][m][1][0] += x1.x; acc[ai][bj][m][1][1] += x1.y; acc[ai][bj][m][1][2] += x1.z; acc[ai][bj][m][1][3] += x1.w;
#pragma unroll
          for (int n = 0; n < 2; ++n)
#pragma unroll
            for (int j = 0; j < 4; ++j) ss += acc[ai][bj][m][n][j] * acc[ai][bj][m][n][j];
        }
        ss += shx(ss, 16, lane);
        ss += shx(ss, 32, lane);
        if (fq == 0) __hip_atomic_fetch_add(rl + row_l, ss, __ATOMIC_RELAXED, __HIP_MEMORY_SCOPE_WORKGROUP);
      }
    __syncthreads();
    if (tid < 256) __hip_atomic_fetch_add(rowss + (size_t)u.pm * 256 + tid, rl[tid], __ATOMIC_RELAXED, __HIP_MEMORY_SCOPE_AGENT);
    asm volatile("s_waitcnt vmcnt(0)" ::: "memory");
    __syncthreads();
    if (tid == 0) {
      __builtin_amdgcn_fence(__ATOMIC_RELEASE, "agent");
      asm volatile("s_waitcnt vmcnt(0)" ::: "memory");
      __hip_atomic_fetch_add(pcnt + u.pm, 1u, __ATOMIC_RELAXED, __HIP_MEMORY_SCOPE_AGENT);
      unsigned spins = 0;
      while (__hip_atomic_load(pcnt + u.pm, __ATOMIC_RELAXED, __HIP_MEMORY_SCOPE_AGENT) < 4u && ++spins < (1u << 22)) __builtin_amdgcn_s_sleep(2);
      __builtin_amdgcn_fence(__ATOMIC_ACQUIRE, "agent");
      asm volatile("s_waitcnt vmcnt(0)" ::: "memory");
    }
    __syncthreads();
    if (tid < 256) {
      const float rs = __hip_atomic_load(rowss + (size_t)u.pm * 256 + tid, __ATOMIC_RELAXED, __HIP_MEMORY_SCOPE_AGENT);
      rl[256 + tid] = rsqrtf(rs * (1.f / 1024.f) + 1e-6f);
    }
    __syncthreads();
    float4 g0[2], g1[2];
#pragma unroll
    for (int bj = 0; bj < 2; ++bj) {
      const int col = u.pn * 256 + bj * 128 + wc * 32 + fq * 8;
      g0[bj] = *(const float4*)(gvec + col);
      g1[bj] = *(const float4*)(gvec + col + 4);
    }
#pragma unroll
    for (int ai = 0; ai < 2; ++ai)
#pragma unroll
      for (int m = 0; m < 4; ++m) {
        const int row_l = ai * 128 + wr * 64 + m * 16 + fr;
        const size_t rowoff = ((size_t)u.pm * 256 + row_l) * 1024;
        const float rstd = rl[256 + row_l];
#pragma unroll
        for (int bj = 0; bj < 2; ++bj) {
          const int col = u.pn * 256 + bj * 128 + wc * 32 + fq * 8;
          float4 o0, o1;
          o0.x = acc[ai][bj][m][0][0] * rstd * g0[bj].x; o0.y = acc[ai][bj][m][0][1] * rstd * g0[bj].y;
          o0.z = acc[ai][bj][m][0][2] * rstd * g0[bj].z; o0.w = acc[ai][bj][m][0][3] * rstd * g0[bj].w;
          o1.x = acc[ai][bj][m][1][0] * rstd * g1[bj].x; o1.y = acc[ai][bj][m][1][1] * rstd * g1[bj].y;
          o1.z = acc[ai][bj][m][1][2] * rstd * g1[bj].z; o1.w = acc[ai][bj][m][1][3] * rstd * g1[bj].w;
          *(float4*)(out + rowoff + col) = o0;
          *(float4*)(out + rowoff + col + 4) = o1;
        }
      }
    __syncthreads();
  }
};

DI void phase4_fused(const Params& p, unsigned char* smem, const int wid_s) {
  pg8::Gemm g;
  g.A = (const bf16_t*)(p.ws + OFF_MIX); g.Bt = (const bf16_t*)(p.ws + OFF_WTOUT); g.M = NTOK; g.N = 1024; g.K = 1024;
  pg8::StaticOrder S; S.init(NTOK, 1024, (int)gridDim.x, (int)blockIdx.x);
  EpiP4F E; E.x = p.x; E.out = p.out; E.rowss = (float*)(p.ws + OFF_ROWSS); E.pcnt = (unsigned*)(p.ws + OFF_PCNT);
  E.gvec = (const float*)(p.ws + OFF_SMALL) + SM_NFG;
  for (int i = 0; i < 4; ++i) {
    OneUnit O1;
    if (!S.next(i, O1.u0)) break;
    pg8::gemm_phase<EpiP4F, OneUnit, false>((PG8_LAS unsigned char*)smem, g, O1, E, nullptr, opaque_tid_w(wid_s));
    __syncthreads();
  }
}

DI void phase4(const Params& p, unsigned char* smem, const int wid_s) {
  pg8::Gemm g;
  g.A = (const bf16_t*)(p.ws + OFF_MIX); g.Bt = (const bf16_t*)(p.ws + OFF_WTOUT); g.M = NTOK; g.N = 1024; g.K = 1024;
  pg8::StaticOrder S; S.init(NTOK, 1024, (int)gridDim.x, (int)blockIdx.x);
  EpiP4 E; E.x = p.x; E.hb = (bf16_t*)(p.ws + OFF_HN); E.rowss = (float*)(p.ws + OFF_ROWSS);
  pg8::gemm_phase<EpiP4, pg8::StaticOrder, false>((PG8_LAS unsigned char*)smem, g, S, E, nullptr, opaque_tid_w(wid_s));
  __syncthreads();
}

DI void phase5(const Params& p, const int wid_s) {
  const int t2 = opaque_tid_w(wid_s), lane = t2 & 63, wave = t2 >> 6;
  const bf16_t* HB = (const bf16_t*)(p.ws + OFF_HN);
  const float* RS = (const float*)(p.ws + OFF_ROWSS);
  float4 gf[2][2];
#pragma unroll
  for (int ch = 0; ch < 2; ++ch)
#pragma unroll
    for (int q = 0; q < 2; ++q) gf[ch][q] = *(const float4*)(p.ws + OFF_SMALL + (size_t)(SM_NFG + ch * 512 + lane * 8 + q * 4) * 4);
  const int gw = blockIdx.x * 8 + wave, ngw = gridDim.x * 8;
  for (int r0 = gw * 4; r0 < NTOK; r0 += ngw * 4) {
    u32x4 hv[4][2];
    float rs[4];
#pragma unroll
    for (int k = 0; k < 4; ++k) {
      const bf16_t* hrow = HB + (size_t)(r0 + k) * 1024;
#pragma unroll
      for (int ch = 0; ch < 2; ++ch) hv[k][ch] = *(const u32x4*)(hrow + ch * 512 + lane * 8);
      rs[k] = RS[r0 + k];
    }
#pragma unroll
    for (int k = 0; k < 4; ++k) {
      const float rstd = rsqrtf(rs[k] * (1.f / 1024.f) + 1e-6f);
      float* orow = p.out + (size_t)(r0 + k) * 1024;
#pragma unroll
      for (int ch = 0; ch < 2; ++ch) {
        float4 o0, o1;
        o0.x = bflo(hv[k][ch][0]) * rstd * gf[ch][0].x; o0.y = bfhi(hv[k][ch][0]) * rstd * gf[ch][0].y;
        o0.z = bflo(hv[k][ch][1]) * rstd * gf[ch][0].z; o0.w = bfhi(hv[k][ch][1]) * rstd * gf[ch][0].w;
        o1.x = bflo(hv[k][ch][2]) * rstd * gf[ch][1].x; o1.y = bfhi(hv[k][ch][2]) * rstd * gf[ch][1].y;
        o1.z = bflo(hv[k][ch][3]) * rstd * gf[ch][1].z; o1.w = bfhi(hv[k][ch][3]) * rstd * gf[ch][1].w;
        *(float4*)(orow + ch * 512 + lane * 8) = o0;
        *(float4*)(orow + ch * 512 + lane * 8 + 4) = o1;
      }
    }
  }
}

#ifndef REP0
#define REP0 1
#endif
#ifndef REP1
#define REP1 1
#endif
#ifndef REP2
#define REP2 1
#endif
#ifndef REP3
#define REP3 1
#endif
#ifndef REP4
#define REP4 1
#endif
__global__ void __launch_bounds__(NTHR, 2) nsa_gmlp_megakernel(Params p) {
  __shared__ __attribute__((aligned(16))) unsigned char smem[SMEM_BYTES];
  cg::grid_group grid = cg::this_grid();
  volatile XB_LAS unsigned* xst = (volatile XB_LAS unsigned*)((XB_LAS unsigned char*)smem + 134144);
  if (threadIdx.x == 0) { xst[0] = 0u; xst[1] = 0u; }
  __syncthreads();
  const XcdBarrier xb = xcd_barrier_post((unsigned*)(p.ws + OFF_XBAR), xst);
  if (p.ws == nullptr) grid.sync();
  const int wid_s = __builtin_amdgcn_readfirstlane((int)(threadIdx.x >> 6));
  for (int rep = 0; rep < REP0; ++rep) phase0(p);
  xcd_barrier(xb);
  unsigned* const barp = (unsigned*)(p.ws + OFF_BAR);
  const unsigned nblk = gridDim.x;
  const bool leader = threadIdx.x == 0;
  for (int rep = 0; rep < REP1; ++rep) {
    pg8::Gemm g;
    g.A = (const bf16_t*)(p.ws + OFF_HN); g.Bt = (const bf16_t*)(p.ws + OFF_WTIN); g.M = NTOK; g.N = NPAD; g.K = 1024;
    pg8::StaticOrder S; S.init(NTOK, NPAD, (int)gridDim.x, (int)blockIdx.x);
    EpiP1 E; E.ws = p.ws;
    pg8::gemm_phase<EpiP1, pg8::StaticOrder, false>((PG8_LAS unsigned char*)smem, g, S, E, nullptr, opaque_tid());
    __syncthreads();
  }
  xcd_barrier(xb);
  for (int rep = 0; rep < REP2; ++rep) {
    const int vb = blockIdx.x * 2 + (threadIdx.x >> 8), nvb = gridDim.x * 2;
    char* sh = (char*)smem + (threadIdx.x >> 8) * 52224;
    for (int it0 = 0; it0 < 512; it0 += nvb) compress_item(p, sh, it0 + vb, it0 + vb < 512);
  }
  xcd_barrier(xb);
  for (int rep = 0; rep < REP3; ++rep) phase3(p, (char*)smem);
  xcd_barrier(xb);
  if (gridDim.x == 256) {
    phase4_fused(p, smem, wid_s);
  } else {
    for (int rep = 0; rep < REP4; ++rep) phase4(p, smem, wid_s);
    xcd_barrier(xb);
    phase5(p, wid_s);
  }
}

extern "C" void kernel_launch(void* const* d_in, const int* in_sizes, int n_in, void* d_out, int out_size, void* d_ws,
                              size_t ws_size, hipStream_t stream) {
  static int grid_blocks = 0;
  if (!grid_blocks) {
    int dev = 0, cus = 0, per_cu = 0;
    (void)hipGetDevice(&dev);
    (void)hipDeviceGetAttribute(&cus, hipDeviceAttributeMultiprocessorCount, dev);
    (void)hipOccupancyMaxActiveBlocksPerMultiprocessor(&per_cu, nsa_gmlp_megakernel, NTHR, 0);
    if (per_cu < 1) per_cu = 1;
    grid_blocks = cus;
  }
  Params p{};
  p.x = (const float*)d_in[0];
  p.norm_in_g = (const float*)d_in[1];
  p.w_in = (const float*)d_in[2];
  p.w_k1 = (const float*)d_in[3];
  p.w_k2 = (const float*)d_in[4];
  p.pe_k = (const float*)d_in[5];
  p.w_v1 = (const float*)d_in[6];
  p.w_v2 = (const float*)d_in[7];
  p.pe_v = (const float*)d_in[8];
  p.ln_g = (const float*)d_in[9];
  p.ln_b = (const float*)d_in[10];
  p.w_sp = (const float*)d_in[11];
  p.b_sp = (const float*)d_in[12];
  p.w_out = (const float*)d_in[13];
  p.norm_f_g = (const float*)d_in[14];
  p.out = (float*)d_out;
  p.ws = (char*)d_ws;
  void* args[] = {&p};
  (void)hipMemsetAsync((char*)d_ws + OFF_XBAR, 0, 3456 * 4, stream);
  hipError_t e = hipLaunchCooperativeKernel((void*)nsa_gmlp_megakernel, dim3(grid_blocks), dim3(NTHR), args, 0, stream);
  if (e != hipSuccess) fprintf(stderr, "cooperative launch failed: %s (grid %d)\n", hipGetErrorString(e), grid_blocks);
}
```

```cpp
#include <hip/hip_runtime.h>
#include <hip/hip_cooperative_groups.h>
#include <cstdio>
namespace cg = cooperative_groups;

#define DI __device__ __forceinline__
typedef unsigned short bf16_t;
typedef unsigned long long u64;
typedef __attribute__((ext_vector_type(8))) short s16x8;
typedef __attribute__((ext_vector_type(4))) short s16x4;
typedef __attribute__((ext_vector_type(16))) float f32x16;
typedef __attribute__((ext_vector_type(4))) unsigned u32x4;
typedef __attribute__((ext_vector_type(2))) unsigned u32x2;
typedef __bf16 bf2_t __attribute__((ext_vector_type(2)));
typedef float f2_t __attribute__((ext_vector_type(2)));

#define MFMA32(a, b, c) __builtin_amdgcn_mfma_f32_32x32x16_bf16((a), (b), (c), 0, 0, 0)

constexpr int NTOK = 65536;
constexpr int NTHR = 512;
constexpr int NPAD = 3584;
constexpr float L2E = 1.4426950408889634f;

constexpr size_t OFF_HN    = 0;
constexpr size_t OFF_WTIN  = OFF_HN    + (size_t)NTOK * 1024 * 2;
constexpr size_t OFF_WTOUT = OFF_WTIN  + (size_t)NPAD * 1024 * 2;
constexpr size_t OFF_W1TK  = OFF_WTOUT + (size_t)1024 * 1024 * 2;
constexpr size_t OFF_W1TV  = OFF_W1TK  + (size_t)128 * 2048 * 2;
constexpr size_t OFF_BIAS  = OFF_W1TV  + (size_t)128 * 2048 * 2;
constexpr size_t OFF_WSP   = OFF_BIAS  + 1024;
constexpr size_t OFF_Q     = OFF_WSP   + (size_t)8 * 128 * 128 * 2;
constexpr size_t OFF_KC    = OFF_Q     + (size_t)NTOK * 512 * 2;
constexpr size_t OFF_VC    = OFF_KC    + (size_t)NTOK * 128 * 2;
constexpr size_t OFF_KS    = OFF_VC    + (size_t)NTOK * 128 * 2;
constexpr size_t OFF_KW    = OFF_KS    + (size_t)NTOK * 128 * 2;
constexpr size_t OFF_VST   = OFF_KW    + (size_t)NTOK * 128 * 2;
constexpr size_t OFF_VWT   = OFF_VST   + (size_t)NTOK * 128 * 2;
constexpr size_t OFF_ZN    = OFF_VWT   + (size_t)NTOK * 128 * 2;
constexpr size_t OFF_U     = OFF_ZN    + (size_t)NTOK * 512 * 2;
constexpr size_t OFF_V     = OFF_U     + (size_t)NTOK * 512 * 2;
constexpr size_t OFF_ZG    = OFF_V     + (size_t)NTOK * 512 * 2;
constexpr size_t OFF_GATES = OFF_ZG    + (size_t)NTOK * 512 * 2;
constexpr size_t OFF_KCMP  = OFF_GATES + (size_t)NTOK * 24 * 4;
constexpr size_t OFF_VCMPT = OFF_KCMP  + (size_t)32 * 256 * 64 * 2;
constexpr size_t OFF_MIX   = OFF_VCMPT + (size_t)32 * 256 * 64 * 2;
constexpr size_t OFF_SMALL = OFF_MIX   + (size_t)NTOK * 1024 * 2;
constexpr int SM_LNG = 0, SM_LNB = 512, SM_BSP = 1024, SM_W2K = 2048, SM_W2V = 2048 + 8192, SM_NFG = 2048 + 16384, SM_TOTAL = 2048 + 16384 + 1024;
constexpr size_t OFF_ROWSS = OFF_SMALL + (size_t)SM_TOTAL * 4;
constexpr size_t OFF_BAR   = OFF_ROWSS + (size_t)NTOK * 4;
constexpr size_t OFF_XBAR  = OFF_BAR + 256;
constexpr size_t OFF_PCNT  = OFF_XBAR + 3456 * 4;
constexpr size_t OFF_QCTR  = OFF_PCNT + 256 * 4;
constexpr size_t WS_END    = OFF_QCTR + 256;

constexpr int SMEM_BYTES = 135168;

struct Params {
  const float *x, *norm_in_g, *w_in, *w_k1, *w_k2, *pe_k, *w_v1, *w_v2, *pe_v, *ln_g, *ln_b, *w_sp, *b_sp, *w_out, *norm_f_g;
  float* out;
  char* ws;
};

DI unsigned pack2(float a, float b) {
  f2_t v = {a, b};
  bf2_t r = __builtin_convertvector(v, bf2_t);
  return __builtin_bit_cast(unsigned, r);
}
DI bf16_t f2bf(float a) { return (bf16_t)(pack2(a, 0.f) & 0xffffu); }
DI float bflo(unsigned u) { return __uint_as_float(u << 16); }
DI float bfhi(unsigned u) { return __uint_as_float(u & 0xffff0000u); }
DI float shx(float v, int mask, int lane) {
  return __builtin_bit_cast(float, __builtin_amdgcn_ds_bpermute((lane ^ mask) << 2, __builtin_bit_cast(int, v)));
}
DI unsigned shxu(unsigned v, int mask, int lane) {
  return (unsigned)__builtin_amdgcn_ds_bpermute((lane ^ mask) << 2, (int)v);
}
DI float wave_sum(float v, int lane) {
#pragma unroll
  for (int o = 32; o >= 1; o >>= 1) v += shx(v, o, lane);
  return v;
}
DI float gelu_t(float x) {
  const float y2 = x * __builtin_fmaf(0.044715f, x * x, 1.0f) * (-2.0f * 0.7978845608028654f * 1.4426950408889634f);
  return x * __builtin_amdgcn_rcpf(1.0f + __builtin_amdgcn_exp2f(y2));
}
DI float sigmoid_f(float x) { return __builtin_amdgcn_rcpf(1.0f + __builtin_amdgcn_exp2f(-1.4426950408889634f * x)); }
DI float silu_f(float x) { return x * __builtin_amdgcn_rcpf(1.0f + __builtin_amdgcn_exp2f(-1.4426950408889634f * x)); }
typedef float f2a __attribute__((ext_vector_type(2)));
DI f2a gelu2(f2a x) {
  const f2a t = x * x * 0.044715f + 1.0f;
  const f2a y2 = x * t * (-2.0f * 0.7978845608028654f * 1.4426950408889634f);
  f2a e = {__builtin_amdgcn_exp2f(y2.x), __builtin_amdgcn_exp2f(y2.y)};
  e = e + 1.0f;
  const f2a rinv = {__builtin_amdgcn_rcpf(e.x), __builtin_amdgcn_rcpf(e.y)};
  return x * rinv;
}
DI f2a silu2(f2a x) {
  const f2a a = x * (-1.4426950408889634f);
  f2a e = {__builtin_amdgcn_exp2f(a.x), __builtin_amdgcn_exp2f(a.y)};
  e = e + 1.0f;
  const f2a rinv = {__builtin_amdgcn_rcpf(e.x), __builtin_amdgcn_rcpf(e.y)};
  return x * rinv;
}
DI unsigned pack2v(f2a v) { return pack2(v.x, v.y); }
DI float xhalf_max(float v) {
  const auto r_ = __builtin_amdgcn_permlane32_swap(__float_as_uint(v), __float_as_uint(v), false, false);
  return fmaxf(__uint_as_float(r_[0]), __uint_as_float(r_[1]));
}
DI float xhalf_sum(float v) {
  const auto r_ = __builtin_amdgcn_permlane32_swap(__float_as_uint(v), __float_as_uint(v), false, false);
  return __uint_as_float(r_[0]) + __uint_as_float(r_[1]);
}
DI int crow(int i, int h) { return (i & 3) + 8 * (i >> 2) + 4 * h; }
DI int opaque_tid() { int t = threadIdx.x; asm volatile("" : "+v"(t)); return t; }
DI int opaque_tid_w(int wid_s) {
  int t = (wid_s << 6) | (int)__builtin_amdgcn_mbcnt_hi(~0u, __builtin_amdgcn_mbcnt_lo(~0u, 0u));
  asm volatile("" : "+v"(t));
  return t;
}

#define XB_TMO      128
#define XB_XCNT(j)  (256  + 64 * (j))
#define XB_XSUB(j)  (1280 + 64 * (j))
#define XB_XGEN(j)  (2304 + 64 * (j))
#define XB_TOP      3328
#define XB_TOPGEN   3392
#define XCD_BAR_WORDS 3456
#define XB_SPIN_CAP (1u << 18)
#define XB_LAS __attribute__((address_space(3)))

__device__ __forceinline__ unsigned xb_ld(unsigned* p)              { return __hip_atomic_load(p, __ATOMIC_RELAXED, __HIP_MEMORY_SCOPE_AGENT); }
__device__ __forceinline__ unsigned xb_add(unsigned* p, unsigned v) { return __hip_atomic_fetch_add(p, v, __ATOMIC_RELAXED, __HIP_MEMORY_SCOPE_AGENT); }
__device__ __forceinline__ unsigned xb_xcc_id() { return (unsigned)__builtin_amdgcn_s_getreg((3 << 11) | 20) & 0xFu; }
#define XB_SPIN(cond, bar) do { unsigned _sp = 0; while (cond) { __builtin_amdgcn_s_sleep(1); \
    if ((++_sp & 255u) == 0u) { if (xb_ld(&(bar)[XB_TMO])) break; if (_sp > XB_SPIN_CAP) { atomicAdd(&(bar)[XB_TMO], 1u); break; } } } } while (0)

struct XcdBarrier {
    unsigned* bar; unsigned x;
    volatile XB_LAS unsigned* st;
};

__device__ __forceinline__ XcdBarrier xcd_barrier_post(unsigned* bar, volatile XB_LAS unsigned* st) {
    XcdBarrier b; b.bar = bar; b.x = xb_xcc_id(); b.st = st;
    if (threadIdx.x == 0) (void)xb_add(&bar[XB_XCNT(b.x)], 1u);
    return b;
}
__device__ __forceinline__ void xcd_barrier_complete(unsigned* bar, unsigned x, unsigned& nloc, unsigned& nx) {
    const unsigned G = gridDim.x * gridDim.y * gridDim.z;
    unsigned sum, cnt, mine, sp = 0u;
    for (;;) {
        sum = 0u; cnt = 0u; mine = 0u;
#pragma unroll
        for (unsigned j = 0; j < 16; ++j) { const unsigned c = xb_ld(&bar[XB_XCNT(j)]); sum += c; cnt += (c > 0u) ? 1u : 0u; mine = (j == x) ? c : mine; }
        if (sum == G) break;
        __builtin_amdgcn_s_sleep(1);
        if ((++sp & 255u) == 0u) { if (xb_ld(&bar[XB_TMO])) break; if (sp > XB_SPIN_CAP) { atomicAdd(&bar[XB_TMO], 1u); break; } }
    }
    nloc = mine > 0u ? mine : 1u; nx = cnt > 0u ? cnt : 1u;
}

__device__ __forceinline__ void xcd_barrier(const XcdBarrier& b) {
    asm volatile("s_waitcnt vmcnt(0)" ::: "memory");
    __syncthreads();
    if (threadIdx.x == 0) {
        unsigned* bar = b.bar;
        __builtin_amdgcn_s_waitcnt(0);
        unsigned nloc = b.st[0], nx = b.st[1];
        if (nloc == 0u) { xcd_barrier_complete(bar, b.x, nloc, nx); b.st[0] = nloc; b.st[1] = nx; }
        const unsigned old = xb_add(&bar[XB_XSUB(b.x)], 1u);
        const unsigned gen = old / nloc;
        if (old + 1u == (gen + 1u) * nloc) {
            __builtin_amdgcn_fence(__ATOMIC_RELEASE, "agent");
            asm volatile("s_waitcnt vmcnt(0)" ::: "memory");
            const unsigned og = xb_add(&bar[XB_TOP], 1u);
            const unsigned tg = og / nx;
            if (og + 1u == (tg + 1u) * nx) xb_add(&bar[XB_TOPGEN], 1u);
            else XB_SPIN(xb_ld(&bar[XB_TOPGEN]) == tg, bar);
            __builtin_amdgcn_fence(__ATOMIC_ACQUIRE, "agent");
            xb_add(&bar[XB_XGEN(b.x)], 1u);
            asm volatile("s_waitcnt vmcnt(0)" ::: "memory");
        } else {
            XB_SPIN(xb_ld(&bar[XB_XGEN(b.x)]) == gen, bar);
            __builtin_amdgcn_fence(__ATOMIC_ACQUIRE, "agent");
            asm volatile("s_waitcnt vmcnt(0)" ::: "memory");
        }
    }
    __syncthreads();
}

DI void grid_bar(unsigned* ctr, unsigned target, bool leader) {
  asm volatile("s_waitcnt vmcnt(0) lgkmcnt(0)" ::: "memory");
  __syncthreads();
  if (leader) {
    __builtin_amdgcn_fence(__ATOMIC_RELEASE, "agent");
    asm volatile("s_waitcnt vmcnt(0)" ::: "memory");
    __hip_atomic_fetch_add(ctr, 1u, __ATOMIC_RELAXED, __HIP_MEMORY_SCOPE_AGENT);
    while (__hip_atomic_load(ctr, __ATOMIC_RELAXED, __HIP_MEMORY_SCOPE_AGENT) < target) __builtin_amdgcn_s_sleep(2);
    __builtin_amdgcn_fence(__ATOMIC_ACQUIRE, "agent");
    asm volatile("s_waitcnt vmcnt(0)" ::: "memory");
  }
  __syncthreads();
}

DI void transpose_w(const float* __restrict__ src, int src_ld, bf16_t* __restrict__ dst, int Np, int K, int mode,
                    int gtid, int gthreads) {
  const int nchunks = K >> 3;
  const long total = (long)nchunks * Np;
  for (long id = gtid; id < total; id += gthreads) {
    const int n = (int)(id % Np), kc = (int)(id / Np);
    int sn = n;
    if (mode == 1) {
      if (n < 1280) sn = n;
      else if (n < 3328) sn = n + 24;
      else if (n < 3352) sn = n - 3328 + 1280;
      else sn = -1;
    }
    u32x4 o = {0u, 0u, 0u, 0u};
    if (sn >= 0) {
      float f[8];
#pragma unroll
      for (int j = 0; j < 8; ++j) f[j] = src[(size_t)(kc * 8 + j) * src_ld + sn];
      o[0] = pack2(f[0], f[1]); o[1] = pack2(f[2], f[3]); o[2] = pack2(f[4], f[5]); o[3] = pack2(f[6], f[7]);
    }
    *(u32x4*)(dst + (size_t)n * K + kc * 8) = o;
  }
}

DI void transpose_tiles(const float* __restrict__ src, int src_ld, bf16_t* __restrict__ dst, int Np, int K, int mode,
                        char* smem, int tid) {
  float* tile = (float*)smem;
  const int tn = Np >> 6, tk = K >> 6;
  for (int t = blockIdx.x; t < tn * tk; t += gridDim.x) {
    const int n0 = (t % tn) * 64, k0 = (t / tn) * 64;
    const int nl = tid & 63, n = n0 + nl;
    int sn = n;
    if (mode == 1) {
      if (n < 1280) sn = n;
      else if (n < 3328) sn = n + 24;
      else if (n < 3352) sn = n - 3328 + 1280;
      else sn = -1;
    }
#pragma unroll
    for (int q = 0; q < 8; ++q) {
      const int kr = (tid >> 6) + 8 * q;
      tile[kr * 65 + nl] = sn >= 0 ? src[(size_t)(k0 + kr) * src_ld + sn] : 0.f;
    }
    __syncthreads();
    {
      const int nn = tid >> 3, kc = (tid & 7) * 8;
      float f[8];
#pragma unroll
      for (int j = 0; j < 8; ++j) f[j] = tile[(kc + j) * 65 + nn];
      u32x4 o;
      o[0] = pack2(f[0], f[1]); o[1] = pack2(f[2], f[3]); o[2] = pack2(f[4], f[5]); o[3] = pack2(f[6], f[7]);
      *(u32x4*)(dst + (size_t)(n0 + nn) * K + k0 + kc) = o;
    }
    __syncthreads();
  }
}

DI void phase0(const Params& p, char* smem) {
  const int tid = opaque_tid(), lane = tid & 63, wave = tid >> 6;
  const int gthreads = gridDim.x * NTHR, gtid = blockIdx.x * NTHR + tid;
  const int gwaves = gridDim.x * 8, gwave = blockIdx.x * 8 + wave;
  bf16_t* HN = (bf16_t*)(p.ws + OFF_HN);
  for (int row = gwave; row < NTOK; row += gwaves) {
    const float4* xr = (const float4*)(p.x + (size_t)row * 1024);
    float4 v[4];
    float ss = 0.f;
#pragma unroll
    for (int i = 0; i < 4; ++i) {
      v[i] = xr[i * 64 + lane];
      ss += v[i].x * v[i].x + v[i].y * v[i].y + v[i].z * v[i].z + v[i].w * v[i].w;
    }
    ss = wave_sum(ss, lane);
    const float rstd = rsqrtf(ss * (1.f / 1024.f) + 1e-6f);
#pragma unroll
    for (int i = 0; i < 4; ++i) {
      const float4 g = ((const float4*)p.norm_in_g)[i * 64 + lane];
      u32x2 o;
      o[0] = pack2(v[i].x * rstd * g.x, v[i].y * rstd * g.y);
      o[1] = pack2(v[i].z * rstd * g.z, v[i].w * rstd * g.w);
      *(u32x2*)(HN + (size_t)row * 1024 + (i * 64 + lane) * 4) = o;
    }
  }
  transpose_tiles(p.w_in, 3352, (bf16_t*)(p.ws + OFF_WTIN), NPAD, 1024, 1, smem, tid);
  transpose_tiles(p.w_out, 1024, (bf16_t*)(p.ws + OFF_WTOUT), 1024, 1024, 0, smem, tid);
  transpose_tiles(p.w_k1, 128, (bf16_t*)(p.ws + OFF_W1TK), 128, 2048, 0, smem, tid);
  transpose_tiles(p.w_v1, 128, (bf16_t*)(p.ws + OFF_W1TV), 128, 2048, 0, smem, tid);
  float* BIAS = (float*)(p.ws + OFF_BIAS);
  for (int it = gwave; it < 256; it += gwaves) {
    const int kv = it >> 7, e = it & 127;
    const float* w1 = kv ? p.w_v1 : p.w_k1;
    const float* pe = kv ? p.pe_v : p.pe_k;
    float s = 0.f;
    for (int kk = lane; kk < 2048; kk += 64) s += pe[kk] * w1[(size_t)kk * 128 + e];
    s = wave_sum(s, lane);
    if (lane == 0) BIAS[it] = s;
  }
  if (gtid == 0) { *(unsigned*)(p.ws + OFF_BAR) = 0u; *(unsigned*)(p.ws + OFF_QCTR) = 0u; }
  {
    float* RS = (float*)(p.ws + OFF_ROWSS);
    for (int id = gtid; id < NTOK; id += gthreads) RS[id] = 0.f;
    if (gtid < 256) ((unsigned*)(p.ws + OFF_PCNT))[gtid] = 0u;
  }
  {
    float* SMALL = (float*)(p.ws + OFF_SMALL);
    for (int id = gtid; id < SM_TOTAL; id += gthreads) {
      float v;
      if (id < SM_LNB) v = p.ln_g[id - SM_LNG];
      else if (id < SM_BSP) v = p.ln_b[id - SM_LNB];
      else if (id < SM_W2K) v = p.b_sp[id - SM_BSP];
      else if (id < SM_W2V) v = p.w_k2[id - SM_W2K];
      else if (id < SM_NFG) v = p.w_v2[id - SM_W2V];
      else v = p.norm_f_g[id - SM_NFG];
      SMALL[id] = v;
    }
  }
  bf16_t* WSP = (bf16_t*)(p.ws + OFF_WSP);
  for (int id = gtid; id < 8 * 128 * 128; id += gthreads) {
    const int t = (id >> 7) & 127, s = id & 127;
    WSP[id] = (s <= t) ? f2bf(p.w_sp[id]) : (bf16_t)0;
  }
}

namespace pg8 {
#define PG8_LAS __attribute__((address_space(3)))
typedef unsigned short bf16_t;
typedef short bf16x8 __attribute__((ext_vector_type(8)));
typedef float f32x4 __attribute__((ext_vector_type(4)));
typedef unsigned u32x4 __attribute__((ext_vector_type(4)));
constexpr int BM = 256, BK = 64, HALF = 128, HTB = HALF * BK * 2  , STAGE_BYTES = 8 * HTB, NXCD = 8, WGM = 4;

__host__ __device__ __forceinline__ int lds_byte(int r, int c) { const int st = (r >> 4) * 2 + (c >> 5), rr = r & 15, cc = c & 31, ob = rr * 64 + cc * 2; return st * 1024 + (ob ^ (((ob >> 9) & 1) << 5)); }
__host__ __device__ __forceinline__ void stage_rc(int b, int& R, int& C) { const int st = b / 1024, sb = b % 1024, swz = sb ^ (((sb >> 9) & 1) << 5); R = (st >> 1) * 16 + swz / 64; C = (st & 1) * 32 + (swz % 64) / 2; }
__host__ __device__ __forceinline__ int perm32(int rho) { const int n = rho >> 4, i = rho & 15; return 8 * (i >> 2) + 4 * n + (i & 3); }

struct Unit { int pm, pn; };
struct Gemm { const bf16_t* A; const bf16_t* Bt; int M, N, K; };

struct StaticOrder {
    int nM, nN, nwg, G, c;
    __host__ __device__ void init(int M, int N, int G_, int c_) { nM = M / BM; nN = N / BM; nwg = nM * nN; G = G_; c = c_; }
    __host__ __device__ bool next(int i, Unit& u) const {
        const long L = (long)i * G + c; if (L >= nwg) return false;
        int wgid = (int)L; { const int q = nwg / NXCD, r = nwg % NXCD, xcd = wgid % NXCD, off = wgid / NXCD; wgid = (xcd < r ? xcd * (q + 1) : r * (q + 1) + (xcd - r) * q) + off; }
        const int nig = WGM * nN, gid = wgid / nig, fm = gid * WGM, gsz = (nM - fm) < WGM ? (nM - fm) : WGM;
        u.pm = fm + ((wgid % nig) % gsz); u.pn = (wgid % nig) / gsz; return true;
    }
    __device__ __forceinline__ void a_ready(const Unit&) const {}
    __device__ __forceinline__ void done(const Unit&) const {}
};

template <class Epi, class Sched, bool STAMP = false>
__device__ __forceinline__ void gemm_phase(PG8_LAS unsigned char* lds, const Gemm g, const Sched& S, const Epi& E, unsigned long long* stamps, const int tid_in) {
    const int tid = tid_in, wid = __builtin_amdgcn_readfirstlane(tid >> 6), lane = tid & 63, wr = wid >> 2, wc = wid & 3, fr = lane & 15, fq = lane >> 4;
    const int K = g.K, nt = K / BK;
    int ts_lo = 0, ts_hi = 0, nts = 0; const unsigned long long rt_entry = STAMP ? (unsigned long long)wall_clock64() : 0ull;
#define PG8_STAMP() do { if (STAMP && wid == 0 && nts < 64) { const unsigned long long _c = (unsigned long long)clock64(); \
        ts_lo = (lane == nts) ? (int)(unsigned)_c : ts_lo; ts_hi = (lane == nts) ? (int)(unsigned)(_c >> 32) : ts_hi; ++nts; } } while (0)
    PG8_STAMP();
    unsigned voffA[2], voffB[2];
#pragma unroll
    for (int i = 0; i < 2; ++i) { int R, C; stage_rc(tid * 16 + i * 8192, R, C); const int Rb = Epi::PERM ? ((R & ~31) + perm32(R & 31)) : R;
        voffA[i] = (unsigned)(R * K + C) * 2u; voffB[i] = (unsigned)(Rb * K + C) * 2u; }
    const size_t kstep = (size_t)(BK * 2);
    const size_t hstep = (size_t)HALF * K * 2;
    const size_t tstep = 2 * hstep;
    const unsigned ldsw = (unsigned)wid * 1024u;
    const int aoff = lds_byte(wr * 64 + fr, fq * 8), boff = lds_byte(wc * 32 + fr, fq * 8);
#define PG8_SA(b, h) (((b) * 2 + (h)) * HTB)
#define PG8_SB(b, h) ((4 + (b) * 2 + (h)) * HTB)
#define PG8_STAGE(bufoff, gbase, voff) do { _Pragma("unroll") for (int _i = 0; _i < 2; ++_i) \
        __builtin_amdgcn_global_load_lds((const unsigned*)((const char*)(gbase) + (voff)[_i]), (PG8_LAS unsigned*)(lds + (bufoff) + ldsw + _i * 8192), 16, 0, 0); } while (0)
#define PG8_LDA(dst, b, h) do { _Pragma("unroll") for (int m = 0; m < 4; ++m) _Pragma("unroll") for (int k = 0; k < 2; ++k) dst[m][k] = *(const PG8_LAS bf16x8*)(lds + PG8_SA(b, h) + aoff + m * 2048 + k * 1024); } while (0)
#define PG8_LDB(dst, b, h) do { _Pragma("unroll") for (int n = 0; n < 2; ++n) _Pragma("unroll") for (int k = 0; k < 2; ++k) dst[n][k] = *(const PG8_LAS bf16x8*)(lds + PG8_SB(b, h) + boff + n * 2048 + k * 1024); } while (0)
#define PG8_MMA(ai, bj, At, Bt) do { __builtin_amdgcn_s_setprio(1); _Pragma("unroll") for (int m = 0; m < 4; ++m) _Pragma("unroll") for (int n = 0; n < 2; ++n) _Pragma("unroll") for (int k = 0; k < 2; ++k) \
        acc[ai][bj][m][n] = __builtin_amdgcn_mfma_f32_16x16x32_bf16(Bt[n][k], At[m][k], acc[ai][bj][m][n], 0, 0, 0); __builtin_amdgcn_s_setprio(0); } while (0)
#define PG8_WAIT_V(n) asm volatile("s_waitcnt vmcnt(" #n ")" ::: "memory")
#define PG8_WAIT_L(n) asm volatile("s_waitcnt lgkmcnt(" #n ")" ::: "memory")
#define PG8_BAR __builtin_amdgcn_s_barrier()
#define PG8_SCHED __builtin_amdgcn_sched_barrier(0)
    Unit cur, nxt; int ui = 0;
    if (!S.next(0, cur)) return;
    f32x4 acc[2][2][4][2];
#pragma unroll
    for (int a = 0; a < 2; ++a)
#pragma unroll
        for (int b = 0; b < 2; ++b)
#pragma unroll
            for (int m = 0; m < 4; ++m)
#pragma unroll
                for (int n = 0; n < 2; ++n) acc[a][b][m][n] = (f32x4){0.f, 0.f, 0.f, 0.f};
    bf16x8 At[4][2], B0[2][2], B1[2][2];
    const char* cA = (const char*)g.A + (size_t)cur.pm * tstep; const char* cB = (const char*)g.Bt + (size_t)cur.pn * tstep;
    S.a_ready(cur);
    PG8_STAGE(PG8_SB(0, 0), cB, voffB); PG8_STAGE(PG8_SA(0, 0), cA, voffA); PG8_STAGE(PG8_SB(0, 1), cB + hstep, voffB); PG8_STAGE(PG8_SA(0, 1), cA + hstep, voffA);
    if (wr == 1) PG8_BAR;
    PG8_WAIT_V(4); PG8_BAR;
    PG8_STAGE(PG8_SB(1, 0), cB + kstep, voffB); PG8_STAGE(PG8_SA(1, 0), cA + kstep, voffA); PG8_STAGE(PG8_SB(1, 1), cB + hstep + kstep, voffB);
    PG8_WAIT_V(6); PG8_BAR;
    PG8_STAMP();
    for (;;) {
        const bool has_next = S.next(ui + 1, nxt);
        const char* nA = has_next ? (const char*)g.A + (size_t)nxt.pm * tstep : cA; const char* nB = has_next ? (const char*)g.Bt + (size_t)nxt.pn * tstep : cB;
        for (int t = 0; t < nt; t += 2) {
            const bool last = (t == nt - 2);
            const char* a1 = cA + (size_t)(t + 1) * kstep;
            const char* a2 = last ? nA : cA + (size_t)(t + 2) * kstep; const char* b2 = last ? nB : cB + (size_t)(t + 2) * kstep;
            const char* a3 = a2 + kstep; const char* b3 = b2 + kstep;
            if (last && has_next) S.a_ready(nxt);
            PG8_LDB(B0, 0, 0); PG8_SCHED; PG8_LDA(At, 0, 0); PG8_STAGE(PG8_SA(1, 1), a1 + hstep, voffA);
            PG8_WAIT_L(8); PG8_BAR; PG8_WAIT_L(0); PG8_MMA(0, 0, At, B0); PG8_BAR; PG8_SCHED;
            PG8_LDB(B1, 0, 1); PG8_STAGE(PG8_SB(0, 0), b2, voffB);
            PG8_BAR; PG8_WAIT_L(0); PG8_MMA(0, 1, At, B1); PG8_BAR;
            PG8_LDA(At, 0, 1); PG8_STAGE(PG8_SA(0, 0), a2, voffA);
            PG8_BAR; PG8_WAIT_L(0); PG8_MMA(1, 0, At, B0); PG8_BAR; PG8_SCHED;
            PG8_STAGE(PG8_SB(0, 1), b2 + hstep, voffB);
            PG8_WAIT_V(6); PG8_BAR; PG8_MMA(1, 1, At, B1); PG8_BAR;
            PG8_LDB(B0, 1, 0); PG8_SCHED; PG8_LDA(At, 1, 0); PG8_STAGE(PG8_SA(0, 1), a2 + hstep, voffA);
            PG8_WAIT_L(8); PG8_BAR; PG8_WAIT_L(0); PG8_MMA(0, 0, At, B0); PG8_BAR; PG8_SCHED;
            PG8_LDB(B1, 1, 1); PG8_STAGE(PG8_SB(1, 0), b3, voffB);
            PG8_BAR; PG8_WAIT_L(0); PG8_MMA(0, 1, At, B1); PG8_BAR;
            PG8_LDA(At, 1, 1); PG8_STAGE(PG8_SA(1, 0), a3, voffA);
            PG8_BAR; PG8_WAIT_L(0); PG8_MMA(1, 0, At, B0); PG8_BAR; PG8_SCHED;
            PG8_STAGE(PG8_SB(1, 1), b3 + hstep, voffB);
            PG8_WAIT_V(6); PG8_BAR; PG8_MMA(1, 1, At, B1); PG8_BAR;
        }
        PG8_STAMP();
        if constexpr (!Epi::AFTER_DRAIN) { E(acc, cur, wr, wc, fr, fq); S.done(cur); }
        PG8_STAMP();
        if (!has_next) break;
#pragma unroll
        for (int a = 0; a < 2; ++a)
#pragma unroll
            for (int b = 0; b < 2; ++b)
#pragma unroll
                for (int m = 0; m < 4; ++m)
#pragma unroll
                    for (int n = 0; n < 2; ++n) acc[a][b][m][n] = (f32x4){0.f, 0.f, 0.f, 0.f};
        cur = nxt; cA = nA; cB = nB; ++ui;
    }
    PG8_WAIT_V(0);
    if (wr == 0) PG8_BAR;
    PG8_BAR;
    if constexpr (Epi::AFTER_DRAIN) { E.fused(acc, cur, wr, wc, fr, fq, lds, wid, lane); S.done(cur); }
    PG8_STAMP();
    if (STAMP && wid == 0) { stamps[lane] = lane < nts ? (((unsigned long long)(unsigned)ts_hi << 32) | (unsigned)ts_lo) : 0ull;
        if (lane == 62) stamps[62] = rt_entry; if (lane == 63) stamps[63] = (unsigned long long)wall_clock64(); }
#undef PG8_STAMP
#undef PG8_SA
#undef PG8_SB
#undef PG8_STAGE
#undef PG8_LDA
#undef PG8_LDB
#undef PG8_MMA
#undef PG8_WAIT_V
#undef PG8_WAIT_L
#undef PG8_BAR
#undef PG8_SCHED
}
}

struct PanelOrder {
  int c, npn;
  __device__ bool next(int i, pg8::Unit& u) const { if (i >= npn) return false; u.pm = c; u.pn = i; return true; }
  __device__ __forceinline__ void a_ready(const pg8::Unit&) const {}
  __device__ __forceinline__ void done(const pg8::Unit&) const {}
};

struct EpiP1 {
  static constexpr bool PERM = true, AFTER_DRAIN = false;
  char* ws;
  __device__ __forceinline__ void operator()(const pg8::f32x4 (&acc)[2][2][4][2], const pg8::Unit& u, int wr, int wc, int fr, int fq) const {
#pragma unroll
    for (int bj = 0; bj < 2; ++bj) {
      const int nt = u.pn * 2 + bj;
      if (nt >= 27) continue;
      const int cn0 = wc * 32 + fq * 8;
      bf16_t* dst = nullptr;
      int ld = 512, colbase = 0, act = 0;
      bool transposed = false;
      if (nt < 4) { dst = (bf16_t*)(ws + OFF_Q); colbase = nt * 128; act = 1; }
      else if (nt == 4) { dst = (bf16_t*)(ws + OFF_KC); ld = 128; }
      else if (nt == 5) { dst = (bf16_t*)(ws + OFF_VC); ld = 128; }
      else if (nt == 6) { dst = (bf16_t*)(ws + OFF_KS); ld = 128; }
      else if (nt == 7) { dst = (bf16_t*)(ws + OFF_VST); transposed = true; }
      else if (nt == 8) { dst = (bf16_t*)(ws + OFF_KW); ld = 128; }
      else if (nt == 9) { dst = (bf16_t*)(ws + OFF_VWT); transposed = true; }
      else if (nt < 14) { dst = (bf16_t*)(ws + OFF_ZN); colbase = (nt - 10) * 128; }
      else if (nt < 18) { dst = (bf16_t*)(ws + OFF_U); colbase = (nt - 14) * 128; }
      else if (nt < 22) { dst = (bf16_t*)(ws + OFF_V); colbase = (nt - 18) * 128; }
      else if (nt < 26) { dst = (bf16_t*)(ws + OFF_ZG); colbase = (nt - 22) * 128; }
#pragma unroll
      for (int ai = 0; ai < 2; ++ai)
#pragma unroll
        for (int m = 0; m < 4; ++m) {
          const int row = u.pm * 256 + ai * 128 + wr * 64 + m * 16 + fr;
          float v[8];
#pragma unroll
          for (int j = 0; j < 4; ++j) { v[j] = acc[ai][bj][m][0][j]; v[4 + j] = acc[ai][bj][m][1][j]; }
          if (nt == 26) {
            if (cn0 < 24) {
              float* G = (float*)(ws + OFF_GATES) + (size_t)row * 24 + cn0;
              float4 g0, g1;
              g0.x = sigmoid_f(v[0]); g0.y = sigmoid_f(v[1]); g0.z = sigmoid_f(v[2]); g0.w = sigmoid_f(v[3]);
              g1.x = sigmoid_f(v[4]); g1.y = sigmoid_f(v[5]); g1.z = sigmoid_f(v[6]); g1.w = sigmoid_f(v[7]);
              *(float4*)G = g0;
              *(float4*)(G + 4) = g1;
            }
          } else if (transposed) {
            const int b = row >> 12, t = row & 4095;
            bf16_t* dp = dst + ((size_t)((b * 2 + (cn0 >> 6)) * 64 + (cn0 & 63))) * 4096 + t;
#pragma unroll
            for (int j = 0; j < 8; ++j) dp[(size_t)j * 4096] = f2bf(v[j]);
          } else {
            if (act == 1) {
#pragma unroll
              for (int j = 0; j < 8; ++j) v[j] *= 0.125f;
            } else if (act == 2) {
#pragma unroll
              for (int j = 0; j < 8; ++j) v[j] = silu_f(v[j]);
            } else if (act == 3) {
#pragma unroll
              for (int j = 0; j < 8; ++j) v[j] = gelu_t(v[j]);
            }
            u32x4 o;
            o[0] = pack2(v[0], v[1]); o[1] = pack2(v[2], v[3]); o[2] = pack2(v[4], v[5]); o[3] = pack2(v[6], v[7]);
            *(u32x4*)(dst + (size_t)row * ld + colbase + cn0) = o;
          }
          __builtin_amdgcn_sched_barrier(0);
        }
    }
  }
};

struct EpiP4 {
  static constexpr bool PERM = true, AFTER_DRAIN = false;
  const float* x;
  bf16_t* hb;
  float* rowss;
  __device__ __forceinline__ void operator()(const pg8::f32x4 (&acc)[2][2][4][2], const pg8::Unit& u, int wr, int wc, int fr_in, int fq) const {
    int fr = fr_in;
    asm volatile("" : "+v"(fr));
    int pm_ = u.pm;
    asm volatile("" : "+s"(pm_));
#pragma unroll
    for (int ai = 0; ai < 2; ++ai)
#pragma unroll
      for (int m = 0; m < 4; ++m) {
        const int rl = ai * 128 + wr * 64 + m * 16 + fr;
        const size_t rowoff = ((size_t)pm_ * 256 + rl) * 1024;
        float4 xv[2][2];
#pragma unroll
        for (int bj = 0; bj < 2; ++bj) {
          const int col = u.pn * 256 + bj * 128 + wc * 32 + fq * 8;
          xv[bj][0] = *(const float4*)(x + rowoff + col);
          xv[bj][1] = *(const float4*)(x + rowoff + col + 4);
        }
        float ss = 0.f;
#pragma unroll
        for (int bj = 0; bj < 2; ++bj) {
          const int col = u.pn * 256 + bj * 128 + wc * 32 + fq * 8;
          float v[8];
          v[0] = acc[ai][bj][m][0][0] + xv[bj][0].x; v[1] = acc[ai][bj][m][0][1] + xv[bj][0].y;
          v[2] = acc[ai][bj][m][0][2] + xv[bj][0].z; v[3] = acc[ai][bj][m][0][3] + xv[bj][0].w;
          v[4] = acc[ai][bj][m][1][0] + xv[bj][1].x; v[5] = acc[ai][bj][m][1][1] + xv[bj][1].y;
          v[6] = acc[ai][bj][m][1][2] + xv[bj][1].z; v[7] = acc[ai][bj][m][1][3] + xv[bj][1].w;
#pragma unroll
          for (int j = 0; j < 8; ++j) ss += v[j] * v[j];
          u32x4 o;
          o[0] = pack2(v[0], v[1]); o[1] = pack2(v[2], v[3]); o[2] = pack2(v[4], v[5]); o[3] = pack2(v[6], v[7]);
          *(u32x4*)(hb + rowoff + col) = o;
        }
        ss += shx(ss, 16, fq * 16 + fr);
        ss += shx(ss, 32, fq * 16 + fr);
        if (fq == 0) __hip_atomic_fetch_add(rowss + (size_t)pm_ * 256 + rl, ss, __ATOMIC_RELAXED, __HIP_MEMORY_SCOPE_AGENT);
      }
  }
};

DI void compress_item(const Params& p, char* smem, int it, bool active) {
  const int tid = opaque_tid() & 255, lane = tid & 63, wave = tid >> 6;
  const int r = lane & 31, h = lane >> 5;
  const int kv = it >> 8, b = (it >> 4) & 15, g = (it >> 3) & 1, n0 = (it & 7) * 32;
  float* hidL = (float*)smem;
  if (active) {
    const bf16_t* src = (const bf16_t*)(p.ws + (kv ? OFF_VC : OFF_KC));
    const bf16_t* w1t = (const bf16_t*)(p.ws + (kv ? OFF_W1TV : OFF_W1TK));
    const float* bias = (const float*)(p.ws + OFF_BIAS) + kv * 128;
    f32x16 acc;
#pragma unroll
    for (int i = 0; i < 16; ++i) acc[i] = 0.f;
    const int n = n0 + r;
    const bf16_t* brow = w1t + (size_t)(32 * wave + r) * 2048 + h * 8;
#pragma unroll 8
    for (int l = 0; l < 32; ++l) {
      int tok = 16 * n + l;
      tok = tok > 4095 ? 4095 : tok;
      const bf16_t* arow = src + ((size_t)b * 4096 + tok) * 128 + g * 64 + h * 8;
#pragma unroll
      for (int s = 0; s < 4; ++s) {
        const s16x8 af = *(const s16x8*)(arow + s * 16);
        const s16x8 bfr = *(const s16x8*)(brow + l * 64 + s * 16);
        acc = MFMA32(af, bfr, acc);
      }
    }
    const int e = 32 * wave + r;
    const float be = bias[e];
#pragma unroll
    for (int i = 0; i < 16; ++i) hidL[crow(i, h) * 132 + e] = gelu_t(acc[i] + be);
  }
  __syncthreads();
  if (active) {
    const float* w2 = (const float*)(p.ws + OFF_SMALL) + (kv ? SM_W2V : SM_W2K);
    const int f = tid & 63, ng = tid >> 6;
    float o[8];
#pragma unroll
    for (int k = 0; k < 8; ++k) o[k] = 0.f;
    for (int e0 = 0; e0 < 128; e0 += 16) {
      float wv[16];
#pragma unroll
      for (int j = 0; j < 16; ++j) wv[j] = w2[(e0 + j) * 64 + f];
#pragma unroll
      for (int j = 0; j < 16; ++j)
#pragma unroll
        for (int k = 0; k < 8; ++k) o[k] += hidL[(ng * 8 + k) * 132 + e0 + j] * wv[j];
    }
    const int bg = b * 2 + g;
#pragma unroll
    for (int k = 0; k < 8; ++k) {
      const int nn = n0 + ng * 8 + k;
      const float val = (nn < 255) ? o[k] : 0.f;
      if (kv == 0) ((bf16_t*)(p.ws + OFF_KCMP))[((size_t)bg * 256 + nn) * 64 + f] = f2bf(val);
      else ((bf16_t*)(p.ws + OFF_VCMPT))[((size_t)bg * 64 + f) * 256 + nn] = f2bf(val);
    }
  }
  __syncthreads();
}

DI void gmlp_item(const Params& p, char* smem, int it, bool active) {
  const int tid = opaque_tid() & 255, lane = tid & 63, wave = tid >> 6;
  const int r = lane & 31, h = lane >> 5;
  const int gg = it & 7, ck = (it >> 3) & 31, b = it >> 8;
  const size_t tokbase = (size_t)b * 4096 + ck * 128;
  const bf16_t* V = (const bf16_t*)(p.ws + OFF_V);
  const bf16_t* U = (const bf16_t*)(p.ws + OFF_U);
  const bf16_t* ZG = (const bf16_t*)(p.ws + OFF_ZG);
  const bf16_t* WSP = (const bf16_t*)(p.ws + OFF_WSP);
  bf16_t* MIX = (bf16_t*)(p.ws + OFF_MIX);
  const float* SMALLP = (const float*)(p.ws + OFF_SMALL);
  char* vnT = smem;
  float* mxl = (float*)(smem + 17408);
  const int tl = tid >> 1, half = tid & 1, d0 = half * 32;
  u32x4 uu4[4], zz4[4];
  if (active) {
    const size_t off0 = (tokbase + tl) * 512 + gg * 64 + d0;
#pragma unroll
    for (int q = 0; q < 4; ++q) { uu4[q] = *(const u32x4*)(U + off0 + q * 8); zz4[q] = *(const u32x4*)(ZG + off0 + q * 8); }
  }
  if (active) {
    float v[32];
    const bf16_t* vp = V + (tokbase + tl) * 512 + gg * 64 + d0;
#pragma unroll
    for (int q = 0; q < 4; ++q) {
      const u32x4 w = *(const u32x4*)(vp + q * 8);
#pragma unroll
      for (int k = 0; k < 4; ++k) { const f2a g2 = gelu2((f2a){bflo(w[k]), bfhi(w[k])}); v[q * 8 + 2 * k] = g2.x; v[q * 8 + 2 * k + 1] = g2.y; }
    }
    float s1 = 0.f;
#pragma unroll
    for (int j = 0; j < 32; ++j) s1 += v[j];
    s1 += shx(s1, 1, lane);
    const float mu = s1 * (1.f / 64.f);
    float s2 = 0.f;
#pragma unroll
    for (int j = 0; j < 32; ++j) { const float d = v[j] - mu; s2 += d * d; }
    s2 += shx(s2, 1, lane);
    const float rstd = rsqrtf(s2 * (1.f / 64.f) + 1e-6f);
#pragma unroll
    for (int j = 0; j < 32; ++j) {
      const float vn = (v[j] - mu) * rstd * SMALLP[SM_LNG + gg * 64 + d0 + j] + SMALLP[SM_LNB + gg * 64 + d0 + j];
      *(bf16_t*)(vnT + (d0 + j) * 272 + tl * 2) = f2bf(vn);
    }
  }
  __syncthreads();
  if (active) {
    f32x16 acc[2];
#pragma unroll
    for (int c = 0; c < 2; ++c)
#pragma unroll
      for (int i = 0; i < 16; ++i) acc[c][i] = 0.f;
    const bf16_t* arow = WSP + ((size_t)gg * 128 + 32 * wave + r) * 128 + h * 8;
    const int nks = 2 * (wave + 1);
    for (int ks = 0; ks < nks; ++ks) {
      const s16x8 af = *(const s16x8*)(arow + ks * 16);
#pragma unroll
      for (int c = 0; c < 2; ++c) {
        const s16x8 bfr = *(const s16x8*)(vnT + (c * 32 + r) * 272 + (ks * 16 + h * 8) * 2);
        acc[c] = MFMA32(af, bfr, acc[c]);
      }
    }
#pragma unroll
    for (int i = 0; i < 16; ++i) {
      const int t = 32 * wave + crow(i, h);
      const float bs = SMALLP[SM_BSP + gg * 128 + t];
#pragma unroll
      for (int c = 0; c < 2; ++c) mxl[t * 68 + c * 32 + r] = acc[c][i] + bs;
    }
  }
  __syncthreads();
  if (active) {
    const size_t off = (tokbase + tl) * 512 + gg * 64 + d0;
    bf16_t* op = MIX + (tokbase + tl) * 1024 + 512 + gg * 64 + d0;
#pragma unroll
    for (int q = 0; q < 4; ++q) {
      const u32x4 uu = uu4[q];
      const u32x4 zz = zz4[q];
      const float4 m0 = *(const float4*)(mxl + tl * 68 + d0 + q * 8);
      const float4 m1 = *(const float4*)(mxl + tl * 68 + d0 + q * 8 + 4);
      u32x4 o;
#define GM2_(uw, zw, ma, mb) pack2v(gelu2((f2a){bflo(uw), bfhi(uw)}) * (f2a){(ma), (mb)} * silu2((f2a){bflo(zw), bfhi(zw)}))
      o[0] = GM2_(uu[0], zz[0], m0.x, m0.y);
      o[1] = GM2_(uu[1], zz[1], m0.z, m0.w);
      o[2] = GM2_(uu[2], zz[2], m1.x, m1.y);
      o[3] = GM2_(uu[3], zz[3], m1.z, m1.w);
#undef GM2_
      *(u32x4*)(op + q * 8) = o;
    }
  }
  __syncthreads();
}

DI void qk1(const char* Kl, const s16x8 (&qf)[4], f32x16 (&S)[2], int r, int h) {
#pragma unroll
  for (int a = 0; a < 2; ++a)
#pragma unroll
    for (int i = 0; i < 16; ++i) S[a][i] = 0.f;
#pragma unroll
  for (int kt2 = 0; kt2 < 2; ++kt2)
#pragma unroll
    for (int s = 0; s < 4; ++s) {
      const s16x8 kf = *(const s16x8*)(Kl + (kt2 * 32 + r) * 144 + s * 32 + h * 16);
      S[kt2] = MFMA32(kf, qf[s], S[kt2]);
    }
}
DI void pv1(const char* Vl, const f32x16 (&S)[2], f32x16 (&O)[2], int r, int h) {
#pragma unroll
  for (int kt2 = 0; kt2 < 2; ++kt2)
#pragma unroll
    for (int s2 = 0; s2 < 2; ++s2) {
      u32x4 pk;
      pk[0] = pack2(S[kt2][8 * s2 + 0], S[kt2][8 * s2 + 1]);
      pk[1] = pack2(S[kt2][8 * s2 + 2], S[kt2][8 * s2 + 3]);
      pk[2] = pack2(S[kt2][8 * s2 + 4], S[kt2][8 * s2 + 5]);
      pk[3] = pack2(S[kt2][8 * s2 + 6], S[kt2][8 * s2 + 7]);
      const s16x8 pf = __builtin_bit_cast(s16x8, pk);
#pragma unroll
      for (int dt = 0; dt < 2; ++dt) {
        const char* vp = Vl + (dt * 32 + r) * 144 + (kt2 * 32 + 16 * s2 + 4 * h) * 2;
        const s16x4 lo = *(const s16x4*)(vp);
        const s16x4 hi = *(const s16x4*)(vp + 16);
        const s16x8 vf = __builtin_shufflevector(lo, hi, 0, 1, 2, 3, 4, 5, 6, 7);
        O[dt] = MFMA32(vf, pf, O[dt]);
      }
    }
}
DI float max3f(float a, float b, float c) {
  float d;
  asm("v_max3_f32 %0, %1, %2, %3" : "=v"(d) : "v"(a), "v"(b), "v"(c));
  return d;
}
typedef float f2v __attribute__((ext_vector_type(2)));
DI float max17f(float a, const f32x16& x) {
  float d;
  asm("v_max3_f32 %0, %1, %2, %3\n\t"
      "v_max3_f32 %0, %0, %4, %5\n\t"
      "v_max3_f32 %0, %0, %6, %7\n\t"
      "v_max3_f32 %0, %0, %8, %9\n\t"
      "v_max3_f32 %0, %0, %10, %11\n\t"
      "v_max3_f32 %0, %0, %12, %13\n\t"
      "v_max3_f32 %0, %0, %14, %15\n\t"
      "v_max3_f32 %0, %0, %16, %17"
      : "=&v"(d)
      : "v"(a), "v"(x[0]), "v"(x[1]), "v"(x[2]), "v"(x[3]), "v"(x[4]), "v"(x[5]), "v"(x[6]), "v"(x[7]), "v"(x[8]), "v"(x[9]),
        "v"(x[10]), "v"(x[11]), "v"(x[12]), "v"(x[13]), "v"(x[14]), "v"(x[15]));
  return d;
}

DI void softmax1(f32x16 (&S)[2], int kbase, int lo, int hi, bool fast, bool rowok, float& m, float& l,
                 f32x16 (&O)[2], int h, int lane) {
  float mx = -1e30f;
  const int lo2 = lo - kbase - 4 * h, hi2 = hi - kbase - 4 * h;
  if (fast) {
#pragma unroll
    for (int kt2 = 0; kt2 < 2; ++kt2) mx = max17f(mx, S[kt2]);
    mx = rowok ? mx : -1e30f;
  } else {
#pragma unroll
    for (int kt2 = 0; kt2 < 2; ++kt2)
#pragma unroll
      for (int i = 0; i < 16; ++i) {
        const int ci = kt2 * 32 + (i & 3) + 8 * (i >> 2);
        mx = (ci >= lo2 && ci <= hi2) ? fmaxf(mx, S[kt2][i]) : mx;
      }
  }
  mx = xhalf_max(mx);
  const float mnew = fmaxf(m, mx);
  const float alpha = __builtin_amdgcn_exp2f((m - mnew) * L2E);
  const float mL = mnew * L2E;
  float sum = 0.f;
  if (fast) {
    const float mLe = rowok ? mL : 3.0e38f;
    f2v sumv = {0.f, 0.f};
#pragma unroll
    for (int kt2 = 0; kt2 < 2; ++kt2)
#pragma unroll
      for (int i = 0; i < 16; i += 2) {
        f2v t = {S[kt2][i], S[kt2][i + 1]};
        t = __builtin_elementwise_fma(t, (f2v){L2E, L2E}, (f2v){-mLe, -mLe});
        f2v pv2 = {__builtin_amdgcn_exp2f(t.x), __builtin_amdgcn_exp2f(t.y)};
        S[kt2][i] = pv2.x;
        S[kt2][i + 1] = pv2.y;
        sumv += pv2;
      }
    sum = sumv.x + sumv.y;
  } else {
#pragma unroll
    for (int kt2 = 0; kt2 < 2; ++kt2)
#pragma unroll
      for (int i = 0; i < 16; ++i) {
        const int ci = kt2 * 32 + (i & 3) + 8 * (i >> 2);
        const float pv = (ci >= lo2 && ci <= hi2) ? __builtin_amdgcn_exp2f(__builtin_fmaf(S[kt2][i], L2E, -mL)) : 0.f;
        S[kt2][i] = pv;
        sum += pv;
      }
  }
  l = l * alpha + sum;
  if (__builtin_amdgcn_ballot_w64(mnew > m) != 0ull) {
#pragma unroll
    for (int dt = 0; dt < 2; ++dt)
#pragma unroll
      for (int i = 0; i < 16; ++i) O[dt][i] *= alpha;
  }
  m = mnew;
}

DI void attn_item(const Params& p, char* smem, int c, int b, int g) {
  const int tid = opaque_tid(), lane = tid & 63, wave = tid >> 6;
  const int r = lane & 31, h = lane >> 5;
  const int hl = wave & 3, qt = wave >> 2;
  const int hd = g * 4 + hl, bg = b * 2 + g;
  const int ql = qt * 32 + r;
  const size_t tok = (size_t)b * 4096 + c * 64 + ql;
  const int tq = c * 64 + ql;
  float* imp = (float*)(smem + 36864);
  unsigned char* selm = (unsigned char*)(smem + 53248);
  const bf16_t* KCMP = (const bf16_t*)(p.ws + OFF_KCMP) + (size_t)bg * 256 * 64;
  const bf16_t* VCMPT = (const bf16_t*)(p.ws + OFF_VCMPT) + (size_t)bg * 64 * 256;
  const bf16_t* KS = (const bf16_t*)(p.ws + OFF_KS) + (size_t)b * 4096 * 128 + g * 64;
  const bf16_t* KW = (const bf16_t*)(p.ws + OFF_KW) + (size_t)b * 4096 * 128 + g * 64;
  const bf16_t* VST = (const bf16_t*)(p.ws + OFF_VST) + (size_t)bg * 64 * 4096;
  const bf16_t* VWT = (const bf16_t*)(p.ws + OFF_VWT) + (size_t)bg * 64 * 4096;

  s16x8 qf[4];
  {
    const bf16_t* qp = (const bf16_t*)(p.ws + OFF_Q) + tok * 512 + hd * 64 + h * 8;
#pragma unroll
    for (int s = 0; s < 4; ++s) qf[s] = *(const s16x8*)(qp + s * 16);
  }
  const float* gp = (const float*)(p.ws + OFF_GATES) + tok * 24 + hd * 3;
  const float gate0 = gp[0], gate1 = gp[1], gate2 = gp[2];

  const int nct = ((4 * c + 2) >> 6) + 1, nsel = c + 1, j0 = c >= 8 ? c - 8 : 0, nwin = c - j0 + 1;
  const int total = 2 * nct + nsel + nwin;
  const int srow = tid >> 3, scc = tid & 7;
  u32x4 kreg, vreg;
#define ATT_ISSUE(sidx)                                                                          \
  do {                                                                                           \
    const int s_ = (sidx);                                                                       \
    const bf16_t *kp_, *vp_;                                                                     \
    int kpi_, vpi_;                                                                              \
    if (s_ < 2 * nct) { const int ct_ = s_ < nct ? s_ : s_ - nct; kp_ = KCMP + ct_ * 4096; kpi_ = 64; vp_ = VCMPT + ct_ * 64; vpi_ = 256; } \
    else if (s_ < 2 * nct + nsel) { const int j_ = s_ - 2 * nct; kp_ = KS + (size_t)j_ * 8192; kpi_ = 128; vp_ = VST + j_ * 64; vpi_ = 4096; } \
    else { const int j_ = j0 + s_ - 2 * nct - nsel; kp_ = KW + (size_t)j_ * 8192; kpi_ = 128; vp_ = VWT + j_ * 64; vpi_ = 4096; } \
    kreg = *(const u32x4*)(kp_ + srow * kpi_ + scc * 8);                                         \
    vreg = *(const u32x4*)(vp_ + (size_t)srow * vpi_ + scc * 8);                                 \
  } while (0)
#define ATT_COMMIT(buf)                                                                          \
  do {                                                                                           \
    *(u32x4*)(smem + (buf) * 9216 + srow * 144 + scc * 16) = kreg;                               \
    *(u32x4*)(smem + 18432 + (buf) * 9216 + srow * 144 + scc * 16) = vreg;                       \
  } while (0)
#define ATT_PRE(s)  do { if ((s) + 1 < total) ATT_ISSUE((s) + 1); } while (0)
#define ATT_POST(s) do { if ((s) + 1 < total) ATT_COMMIT(((s) + 1) & 1); __syncthreads(); } while (0)

  ATT_ISSUE(0);
  ATT_COMMIT(0);
  for (int i = tid; i < 4096; i += NTHR) imp[i] = 0.f;
  __syncthreads();

  f32x16 S[2], O[2], Oout[2];
  float m, l;
  int s = 0;
  const int hic = (tq - 31) >> 4;
  m = -1e30f; l = 0.f;
  for (int ct = 0; ct < nct; ++ct, ++s) {
    ATT_PRE(s);
    qk1(smem + (s & 1) * 9216, qf, S, r, h);
    float mx = -1e30f;
    const int hi2 = hic - ct * 64 - 4 * h;
#pragma unroll
    for (int kt2 = 0; kt2 < 2; ++kt2)
#pragma unroll
      for (int i = 0; i < 16; ++i) {
        const int ci = kt2 * 32 + (i & 3) + 8 * (i >> 2);
        mx = (ci <= hi2) ? fmaxf(mx, S[kt2][i]) : mx;
      }
    mx = xhalf_max(mx);
    const float mnew = fmaxf(m, mx);
    const float alpha = __builtin_amdgcn_exp2f((m - mnew) * L2E);
    const float mL = mnew * L2E;
    float sum = 0.f;
#pragma unroll
    for (int kt2 = 0; kt2 < 2; ++kt2)
#pragma unroll
      for (int i = 0; i < 16; ++i) {
        const int ci = kt2 * 32 + (i & 3) + 8 * (i >> 2);
        sum += (ci <= hi2) ? __builtin_amdgcn_exp2f(__builtin_fmaf(S[kt2][i], L2E, -mL)) : 0.f;
      }
    l = l * alpha + sum;
    m = mnew;
    ATT_POST(s);
  }
  {
    const float lt = xhalf_sum(l);
    const float inv = (hic >= 0 && lt > 0.f) ? 1.f / lt : 0.f;
    const float mL = m * L2E;
#pragma unroll
    for (int a = 0; a < 2; ++a)
#pragma unroll
      for (int i = 0; i < 16; ++i) O[a][i] = 0.f;
    for (int ct = 0; ct < nct; ++ct, ++s) {
      ATT_PRE(s);
      qk1(smem + (s & 1) * 9216, qf, S, r, h);
      const int hi2 = hic - ct * 64 - 4 * h;
#pragma unroll
      for (int kt2 = 0; kt2 < 2; ++kt2)
#pragma unroll
        for (int i = 0; i < 16; ++i) {
          const int ci = kt2 * 32 + (i & 3) + 8 * (i >> 2);
          S[kt2][i] = (ci <= hi2) ? __builtin_amdgcn_exp2f(__builtin_fmaf(S[kt2][i], L2E, -mL)) * inv : 0.f;
        }
      if (c >= 16) {
        float* irow = imp + ql * 64;
#pragma unroll
        for (int kt2 = 0; kt2 < 2; ++kt2)
#pragma unroll
          for (int gi = 0; gi < 4; ++gi) {
            const int jb = ct * 16 + kt2 * 8 + 2 * gi + h;
            const float a4 = (S[kt2][4 * gi] + S[kt2][4 * gi + 1]) + (S[kt2][4 * gi + 2] + S[kt2][4 * gi + 3]);
            __hip_atomic_fetch_add(irow + jb, a4, __ATOMIC_RELAXED, __HIP_MEMORY_SCOPE_WORKGROUP);
            if (jb + 1 < 64)
              __hip_atomic_fetch_add(irow + jb + 1, S[kt2][4 * gi + 3], __ATOMIC_RELAXED, __HIP_MEMORY_SCOPE_WORKGROUP);
          }
      }
      pv1(smem + 18432 + (s & 1) * 9216, S, O, r, h);
      ATT_POST(s);
    }
#pragma unroll
    for (int dt = 0; dt < 2; ++dt)
#pragma unroll
      for (int i = 0; i < 16; ++i) Oout[dt][i] = gate0 * O[dt][i];
  }
  {
    const int tr_ = opaque_tid();
    const int q = tr_ >> 3, part = tr_ & 7;
    unsigned bits = 0;
    if (c >= 16) {
      unsigned key[8];
#pragma unroll
      for (int k = 0; k < 8; ++k) {
        const int j = part * 8 + k;
        const unsigned u = __float_as_uint(imp[q * 64 + j]);
        key[k] = (j >= 1 && j <= c - 2) ? ((u & ~63u) | (unsigned)(63 - j)) : 0u;
      }
      for (int rd = 0; rd < 13; ++rd) {
        unsigned lm = key[0];
#pragma unroll
        for (int k = 1; k < 8; ++k) lm = lm > key[k] ? lm : key[k];
#pragma unroll
        for (int o = 1; o <= 4; o <<= 1) {
          const unsigned ot = shxu(lm, o, tr_ & 63);
          lm = lm > ot ? lm : ot;
        }
#pragma unroll
        for (int k = 0; k < 8; ++k) {
          const bool hit = (key[k] == lm) && (lm != 0u);
          bits |= hit ? (1u << k) : 0u;
          key[k] = hit ? 0u : key[k];
        }
      }
#pragma unroll
      for (int k = 0; k < 8; ++k) {
        const int j = part * 8 + k;
        if (j == 0 || j == c || j == c - 1) bits |= (1u << k);
      }
    } else {
#pragma unroll
      for (int k = 0; k < 8; ++k) {
        const int j = part * 8 + k;
        if (j <= c) bits |= (1u << k);
      }
    }
    selm[q * 8 + part] = (unsigned char)bits;
  }
  __syncthreads();
  const u64 sm = *(const u64*)(selm + ql * 8);

  m = -1e30f; l = 0.f;
#pragma unroll
  for (int a = 0; a < 2; ++a)
#pragma unroll
    for (int i = 0; i < 16; ++i) O[a][i] = 0.f;
  for (int j = 0; j <= c; ++j, ++s) {
    {
      const bool more_ = j < c;
      const bf16_t* kp_ = more_ ? KS + (size_t)(j + 1) * 8192 : KW + (size_t)j0 * 8192;
      const bf16_t* vp_ = more_ ? VST + (j + 1) * 64 : VWT + j0 * 64;
      kreg = *(const u32x4*)(kp_ + srow * 128 + scc * 8);
      vreg = *(const u32x4*)(vp_ + (size_t)srow * 4096 + scc * 8);
    }
    qk1(smem + (s & 1) * 9216, qf, S, r, h);
    const bool selq = ((sm >> j) & 1ull) != 0ull;
    softmax1(S, j * 64, 0, selq ? tq : -1, j < c, selq, m, l, O, h, lane);
    pv1(smem + 18432 + (s & 1) * 9216, S, O, r, h);
    ATT_POST(s);
  }
  {
    const float lt = xhalf_sum(l);
    const float sc = gate1 / lt;
#pragma unroll
    for (int dt = 0; dt < 2; ++dt)
#pragma unroll
      for (int i = 0; i < 16; ++i) Oout[dt][i] += sc * O[dt][i];
  }
  m = -1e30f; l = 0.f;
#pragma unroll
  for (int a = 0; a < 2; ++a)
#pragma unroll
    for (int i = 0; i < 16; ++i) O[a][i] = 0.f;
  for (int j = j0; j <= c; ++j, ++s) {
    if (j < c) {
      kreg = *(const u32x4*)(KW + (size_t)(j + 1) * 8192 + srow * 128 + scc * 8);
      vreg = *(const u32x4*)(VWT + (j + 1) * 64 + (size_t)srow * 4096 + scc * 8);
    }
    qk1(smem + (s & 1) * 9216, qf, S, r, h);
    softmax1(S, j * 64, tq - 511, tq, (j >= c - 7) && (j < c), true, m, l, O, h, lane);
    pv1(smem + 18432 + (s & 1) * 9216, S, O, r, h);
    ATT_POST(s);
  }
  {
    const float lt = xhalf_sum(l);
    const float sc = gate2 / lt;
#pragma unroll
    for (int dt = 0; dt < 2; ++dt)
#pragma unroll
      for (int i = 0; i < 16; ++i) Oout[dt][i] += sc * O[dt][i];
  }
  {
    const bf16_t* ZN = (const bf16_t*)(p.ws + OFF_ZN) + tok * 512 + hd * 64;
    bf16_t* MIX = (bf16_t*)(p.ws + OFF_MIX) + tok * 1024 + hd * 64;
#pragma unroll
    for (int dt = 0; dt < 2; ++dt)
#pragma unroll
      for (int gi = 0; gi < 4; ++gi) {
        const int d = dt * 32 + 8 * gi + 4 * h;
        const u32x2 z = *(const u32x2*)(ZN + d);
        u32x2 o;
        o[0] = pack2(Oout[dt][4 * gi + 0] * silu_f(bflo(z[0])), Oout[dt][4 * gi + 1] * silu_f(bfhi(z[0])));
        o[1] = pack2(Oout[dt][4 * gi + 2] * silu_f(bflo(z[1])), Oout[dt][4 * gi + 3] * silu_f(bfhi(z[1])));
        *(u32x2*)(MIX + d) = o;
      }
  }
  __syncthreads();
#undef ATT_ISSUE
#undef ATT_COMMIT
#undef ATT_PRE
#undef ATT_POST
}

DI void phase3(const Params& p, char* smem) {
  unsigned* qctr = (unsigned*)(p.ws + OFF_QCTR);
  volatile int* qw = (volatile int*)(smem + 134160);
  const bool t0 = threadIdx.x == 0;
  int nxt = 0;
  if (t0) nxt = (int)__hip_atomic_fetch_add(qctr, 1u, __ATOMIC_RELAXED, __HIP_MEMORY_SCOPE_AGENT);
  for (;;) {
    if (t0) *qw = nxt;
    __syncthreads();
    const int idx = *qw;
    __syncthreads();
    if (idx >= 4096) break;
    if (t0) nxt = (int)__hip_atomic_fetch_add(qctr, 1u, __ATOMIC_RELAXED, __HIP_MEMORY_SCOPE_AGENT);
    if (idx < 2048) {
      const int c = 63 - (idx >> 5), bgi = idx & 31;
      attn_item(p, smem, c, bgi >> 1, bgi & 1);
    } else {
      const int half = (int)(threadIdx.x >> 8);
      gmlp_item(p, smem + half * 52224, (idx - 2048) * 2 + half, true);
    }
  }
}

struct OneUnit {
  pg8::Unit u0;
  __device__ bool next(int i, pg8::Unit& u) const { if (i != 0) return false; u = u0; return true; }
  __device__ __forceinline__ void a_ready(const pg8::Unit&) const {}
  __device__ __forceinline__ void done(const pg8::Unit&) const {}
};
struct EpiP4F {
  static constexpr bool PERM = true, AFTER_DRAIN = true;
  const float* x;
  float* out;
  float* rowss;
  unsigned* pcnt;
  const float* gvec;
  __device__ __forceinline__ void operator()(const pg8::f32x4 (&)[2][2][4][2], const pg8::Unit&, int, int, int, int) const {}
  __device__ __forceinline__ void fused(const pg8::f32x4 (&acc_c)[2][2][4][2], const pg8::Unit& u, int wr, int wc, int fr, int fq,
                                        PG8_LAS unsigned char* lds, int wid, int lane) const {
    auto& acc = const_cast<pg8::f32x4 (&)[2][2][4][2]>(acc_c);
    PG8_LAS float* rl = (PG8_LAS float*)lds;
    const int tid = wid * 64 + lane;
    if (tid < 256) rl[tid] = 0.f;
    __syncthreads();
#pragma unroll
    for (int ai = 0; ai < 2; ++ai)
#pragma unroll
      for (int m = 0; m < 4; ++m) {
        const int row_l = ai * 128 + wr * 64 + m * 16 + fr;
        const size_t rowoff = ((size_t)u.pm * 256 + row_l) * 1024;
        float ss = 0.f;
#pragma unroll
        for (int bj = 0; bj < 2; ++bj) {
          const int col = u.pn * 256 + bj * 128 + wc * 32 + fq * 8;
          const float4 x0 = *(const float4*)(x + rowoff + col);
          const float4 x1 = *(const float4*)(x + rowoff + col + 4);
          acc[ai][bj][m][0][0] += x0.x; acc[ai][bj][m][0][1] += x0.y; acc[ai][bj][m][0][2] += x0.z; acc[ai][bj][m][0][3] += x0.w;
          acc[ai][bj][m][1][0] += x1.x; acc[ai][bj][m][1][1] += x1.y; acc[ai][bj][m][1][2] += x1.z; acc[ai][bj][m][1][3] += x1.w;
#pragma unroll
          for (int n = 0; n < 2; ++n)
#pragma unroll
            for (int j = 0; j < 4; ++j) ss += acc[ai][bj][m][n][j] * acc[ai][bj][m][n][j];
        }
        ss += shx(ss, 16, lane);
        ss += shx(ss, 32, lane);
        if (fq == 0) __hip_atomic_fetch_add(rl + row_l, ss, __ATOMIC_RELAXED, __HIP_MEMORY_SCOPE_WORKGROUP);
      }
    __syncthreads();
    if (tid < 256) __hip_atomic_fetch_add(rowss + (size_t)u.pm * 256 + tid, rl[tid], __ATOMIC_RELAXED, __HIP_MEMORY_SCOPE_AGENT);
    asm volatile("s_waitcnt vmcnt(0)" ::: "memory");
    __syncthreads();
    if (tid == 0) {
      __builtin_amdgcn_fence(__ATOMIC_RELEASE, "agent");
      asm volatile("s_waitcnt vmcnt(0)" ::: "memory");
      __hip_atomic_fetch_add(pcnt + u.pm, 1u, __ATOMIC_RELAXED, __HIP_MEMORY_SCOPE_AGENT);
      unsigned spins = 0;
      while (__hip_atomic_load(pcnt + u.pm, __ATOMIC_RELAXED, __HIP_MEMORY_SCOPE_AGENT) < 4u && ++spins < (1u << 22)) __builtin_amdgcn_s_sleep(2);
      __builtin_amdgcn_fence(__ATOMIC_ACQUIRE, "agent");
      asm volatile("s_waitcnt vmcnt(0)" ::: "memory");
    }
    __syncthreads();
    if (tid < 256) {
      const float rs = __hip_atomic_load(rowss + (size_t)u.pm * 256 + tid, __ATOMIC_RELAXED, __HIP_MEMORY_SCOPE_AGENT);
      rl[256 + tid] = rsqrtf(rs * (1.f / 1024.f) + 1e-6f);
    }
    __syncthreads();
    float4 g0[2], g1[2];
#pragma unroll
    for (int bj = 0; bj < 2; ++bj) {
      const int col = u.pn * 256 + bj * 128 + wc * 32 + fq * 8;
      g0[bj] = *(const float4*)(gvec + col);
      g1[bj] = *(const float4*)(gvec + col + 4);
    }
#pragma unroll
    for (int ai = 0; ai < 2; ++ai)
#pragma unroll
      for (int m = 0; m < 4; ++m) {
        const int row_l = ai * 128 + wr * 64 + m * 16 + fr;
        const size_t rowoff = ((size_t)u.pm * 256 + row_l) * 1024;
        const float rstd = rl[256 + row_l];
#pragma unroll
        for (int bj = 0; bj < 2; ++bj) {
          const int col = u.pn * 256 + bj * 128 + wc * 32 + fq * 8;
          float4 o0, o1;
          o0.x = acc[ai][bj][m][0][0] * rstd * g0[bj].x; o0.y = acc[ai][bj][m][0][1] * rstd * g0[bj].y;
          o0.z = acc[ai][bj][m][0][2] * rstd * g0[bj].z; o0.w = acc[ai][bj][m][0][3] * rstd * g0[bj].w;
          o1.x = acc[ai][bj][m][1][0] * rstd * g1[bj].x; o1.y = acc[ai][bj][m][1][1] * rstd * g1[bj].y;
          o1.z = acc[ai][bj][m][1][2] * rstd * g1[bj].z; o1.w = acc[ai][bj][m][1][3] * rstd * g1[bj].w;
          *(float4*)(out + rowoff + col) = o0;
          *(float4*)(out + rowoff + col + 4) = o1;
        }
      }
    __syncthreads();
  }
};

DI void phase4_fused(const Params& p, unsigned char* smem, const int wid_s) {
  pg8::Gemm g;
  g.A = (const bf16_t*)(p.ws + OFF_MIX); g.Bt = (const bf16_t*)(p.ws + OFF_WTOUT); g.M = NTOK; g.N = 1024; g.K = 1024;
  pg8::StaticOrder S; S.init(NTOK, 1024, (int)gridDim.x, (int)blockIdx.x);
  EpiP4F E; E.x = p.x; E.out = p.out; E.rowss = (float*)(p.ws + OFF_ROWSS); E.pcnt = (unsigned*)(p.ws + OFF_PCNT);
  E.gvec = (const float*)(p.ws + OFF_SMALL) + SM_NFG;
  for (int i = 0; i < 4; ++i) {
    OneUnit O1;
    if (!S.next(i, O1.u0)) break;
    pg8::gemm_phase<EpiP4F, OneUnit, false>((PG8_LAS unsigned char*)smem, g, O1, E, nullptr, opaque_tid_w(wid_s));
    __syncthreads();
  }
}

DI void phase4(const Params& p, unsigned char* smem, const int wid_s) {
  pg8::Gemm g;
  g.A = (const bf16_t*)(p.ws + OFF_MIX); g.Bt = (const bf16_t*)(p.ws + OFF_WTOUT); g.M = NTOK; g.N = 1024; g.K = 1024;
  pg8::StaticOrder S; S.init(NTOK, 1024, (int)gridDim.x, (int)blockIdx.x);
  EpiP4 E; E.x = p.x; E.hb = (bf16_t*)(p.ws + OFF_HN); E.rowss = (float*)(p.ws + OFF_ROWSS);
  pg8::gemm_phase<EpiP4, pg8::StaticOrder, false>((PG8_LAS unsigned char*)smem, g, S, E, nullptr, opaque_tid_w(wid_s));
  __syncthreads();
}

DI void phase5(const Params& p, const int wid_s) {
  const int t2 = opaque_tid_w(wid_s), lane = t2 & 63, wave = t2 >> 6;
  const bf16_t* HB = (const bf16_t*)(p.ws + OFF_HN);
  const float* RS = (const float*)(p.ws + OFF_ROWSS);
  float4 gf[2][2];
#pragma unroll
  for (int ch = 0; ch < 2; ++ch)
#pragma unroll
    for (int q = 0; q < 2; ++q) gf[ch][q] = *(const float4*)(p.ws + OFF_SMALL + (size_t)(SM_NFG + ch * 512 + lane * 8 + q * 4) * 4);
  const int gw = blockIdx.x * 8 + wave, ngw = gridDim.x * 8;
  for (int r0 = gw * 4; r0 < NTOK; r0 += ngw * 4) {
    u32x4 hv[4][2];
    float rs[4];
#pragma unroll
    for (int k = 0; k < 4; ++k) {
      const bf16_t* hrow = HB + (size_t)(r0 + k) * 1024;
#pragma unroll
      for (int ch = 0; ch < 2; ++ch) hv[k][ch] = *(const u32x4*)(hrow + ch * 512 + lane * 8);
      rs[k] = RS[r0 + k];
    }
#pragma unroll
    for (int k = 0; k < 4; ++k) {
      const float rstd = rsqrtf(rs[k] * (1.f / 1024.f) + 1e-6f);
      float* orow = p.out + (size_t)(r0 + k) * 1024;
#pragma unroll
      for (int ch = 0; ch < 2; ++ch) {
        float4 o0, o1;
        o0.x = bflo(hv[k][ch][0]) * rstd * gf[ch][0].x; o0.y = bfhi(hv[k][ch][0]) * rstd * gf[ch][0].y;
        o0.z = bflo(hv[k][ch][1]) * rstd * gf[ch][0].z; o0.w = bfhi(hv[k][ch][1]) * rstd * gf[ch][0].w;
        o1.x = bflo(hv[k][ch][2]) * rstd * gf[ch][1].x; o1.y = bfhi(hv[k][ch][2]) * rstd * gf[ch][1].y;
        o1.z = bflo(hv[k][ch][3]) * rstd * gf[ch][1].z; o1.w = bfhi(hv[k][ch][3]) * rstd * gf[ch][1].w;
        *(float4*)(orow + ch * 512 + lane * 8) = o0;
        *(float4*)(orow + ch * 512 + lane * 8 + 4) = o1;
      }
    }
  }
}

#ifndef REP0
#define REP0 1
#endif
#ifndef REP1
#define REP1 1
#endif
#ifndef REP2
#define REP2 1
#endif
#ifndef REP3
#define REP3 1
#endif
#ifndef REP4
#define REP4 1
#endif
__global__ void __launch_bounds__(NTHR, 2) nsa_gmlp_megakernel(Params p) {
  __shared__ __attribute__((aligned(16))) unsigned char smem[SMEM_BYTES];
  cg::grid_group grid = cg::this_grid();
  volatile XB_LAS unsigned* xst = (volatile XB_LAS unsigned*)((XB_LAS unsigned char*)smem + 134144);
  if (threadIdx.x == 0) { xst[0] = 0u; xst[1] = 0u; }
  __syncthreads();
  const XcdBarrier xb = xcd_barrier_post((unsigned*)(p.ws + OFF_XBAR), xst);
  if (p.ws == nullptr) grid.sync();
  const int wid_s = __builtin_amdgcn_readfirstlane((int)(threadIdx.x >> 6));
  for (int rep = 0; rep < REP0; ++rep) phase0(p, (char*)smem);
  xcd_barrier(xb);
  unsigned* const barp = (unsigned*)(p.ws + OFF_BAR);
  const unsigned nblk = gridDim.x;
  const bool leader = threadIdx.x == 0;
  for (int rep = 0; rep < REP1; ++rep) {
    pg8::Gemm g;
    g.A = (const bf16_t*)(p.ws + OFF_HN); g.Bt = (const bf16_t*)(p.ws + OFF_WTIN); g.M = NTOK; g.N = NPAD; g.K = 1024;
    pg8::StaticOrder S; S.init(NTOK, NPAD, (int)gridDim.x, (int)blockIdx.x);
    EpiP1 E; E.ws = p.ws;
    pg8::gemm_phase<EpiP1, pg8::StaticOrder, false>((PG8_LAS unsigned char*)smem, g, S, E, nullptr, opaque_tid());
    __syncthreads();
  }
  xcd_barrier(xb);
  for (int rep = 0; rep < REP2; ++rep) {
    const int vb = blockIdx.x * 2 + (threadIdx.x >> 8), nvb = gridDim.x * 2;
    char* sh = (char*)smem + (threadIdx.x >> 8) * 52224;
    for (int it0 = 0; it0 < 512; it0 += nvb) compress_item(p, sh, it0 + vb, it0 + vb < 512);
  }
  xcd_barrier(xb);
  for (int rep = 0; rep < REP3; ++rep) phase3(p, (char*)smem);
  xcd_barrier(xb);
  if (gridDim.x == 256) {
    phase4_fused(p, smem, wid_s);
  } else {
    for (int rep = 0; rep < REP4; ++rep) phase4(p, smem, wid_s);
    xcd_barrier(xb);
    phase5(p, wid_s);
  }
}

extern "C" void kernel_launch(void* const* d_in, const int* in_sizes, int n_in, void* d_out, int out_size, void* d_ws,
                              size_t ws_size, hipStream_t stream) {
  static int grid_blocks = 0;
  if (!grid_blocks) {
    int dev = 0, cus = 0, per_cu = 0;
    (void)hipGetDevice(&dev);
    (void)hipDeviceGetAttribute(&cus, hipDeviceAttributeMultiprocessorCount, dev);
    (void)hipOccupancyMaxActiveBlocksPerMultiprocessor(&per_cu, nsa_gmlp_megakernel, NTHR, 0);
    if (per_cu < 1) per_cu = 1;
    grid_blocks = cus;
  }
  Params p{};
  p.x = (const float*)d_in[0];
  p.norm_in_g = (const float*)d_in[1];
  p.w_in = (const float*)d_in[2];
  p.w_k1 = (const float*)d_in[3];
  p.w_k2 = (const float*)d_in[4];
  p.pe_k = (const float*)d_in[5];
  p.w_v1 = (const float*)d_in[6];
  p.w_v2 = (const float*)d_in[7];
  p.pe_v = (const float*)d_in[8];
  p.ln_g = (const float*)d_in[9];
  p.ln_b = (const float*)d_in[10];
  p.w_sp = (const float*)d_in[11];
  p.b_sp = (const float*)d_in[12];
  p.w_out = (const float*)d_in[13];
  p.norm_f_g = (const float*)d_in[14];
  p.out = (float*)d_out;
  p.ws = (char*)d_ws;
  void* args[] = {&p};
  (void)hipMemsetAsync((char*)d_ws + OFF_XBAR, 0, 3456 * 4, stream);
  hipError_t e = hipLaunchCooperativeKernel((void*)nsa_gmlp_megakernel, dim3(grid_blocks), dim3(NTHR), args, 0, stream);
  if (e != hipSuccess) fprintf(stderr, "cooperative launch failed: %s (grid %d)\n", hipGetErrorString(e), grid_blocks);
}
```

```cpp
#include <hip/hip_runtime.h>
#include <hip/hip_cooperative_groups.h>
#include <cstdio>
namespace cg = cooperative_groups;

#define DI __device__ __forceinline__
typedef unsigned short bf16_t;
typedef unsigned long long u64;
typedef __attribute__((ext_vector_type(8))) short s16x8;
typedef __attribute__((ext_vector_type(4))) short s16x4;
typedef __attribute__((ext_vector_type(16))) float f32x16;
typedef __attribute__((ext_vector_type(4))) unsigned u32x4;
typedef __attribute__((ext_vector_type(2))) unsigned u32x2;
typedef __bf16 bf2_t __attribute__((ext_vector_type(2)));
typedef float f2_t __attribute__((ext_vector_type(2)));

#define MFMA32(a, b, c) __builtin_amdgcn_mfma_f32_32x32x16_bf16((a), (b), (c), 0, 0, 0)

constexpr int NTOK = 65536;
constexpr int NTHR = 512;
constexpr int NPAD = 3584;
constexpr float L2E = 1.4426950408889634f;

constexpr size_t OFF_HN    = 0;
constexpr size_t OFF_WTIN  = OFF_HN    + (size_t)NTOK * 1024 * 2;
constexpr size_t OFF_WTOUT = OFF_WTIN  + (size_t)NPAD * 1024 * 2;
constexpr size_t OFF_W1TK  = OFF_WTOUT + (size_t)1024 * 1024 * 2;
constexpr size_t OFF_W1TV  = OFF_W1TK  + (size_t)128 * 2048 * 2;
constexpr size_t OFF_BIAS  = OFF_W1TV  + (size_t)128 * 2048 * 2;
constexpr size_t OFF_WSP   = OFF_BIAS  + 1024;
constexpr size_t OFF_Q     = OFF_WSP   + (size_t)8 * 128 * 128 * 2;
constexpr size_t OFF_KC    = OFF_Q     + (size_t)NTOK * 512 * 2;
constexpr size_t OFF_VC    = OFF_KC    + (size_t)NTOK * 128 * 2;
constexpr size_t OFF_KS    = OFF_VC    + (size_t)NTOK * 128 * 2;
constexpr size_t OFF_KW    = OFF_KS    + (size_t)NTOK * 128 * 2;
constexpr size_t OFF_VST   = OFF_KW    + (size_t)NTOK * 128 * 2;
constexpr size_t OFF_VWT   = OFF_VST   + (size_t)NTOK * 128 * 2;
constexpr size_t OFF_ZN    = OFF_VWT   + (size_t)NTOK * 128 * 2;
constexpr size_t OFF_U     = OFF_ZN    + (size_t)NTOK * 512 * 2;
constexpr size_t OFF_V     = OFF_U     + (size_t)NTOK * 512 * 2;
constexpr size_t OFF_ZG    = OFF_V     + (size_t)NTOK * 512 * 2;
constexpr size_t OFF_GATES = OFF_ZG    + (size_t)NTOK * 512 * 2;
constexpr size_t OFF_KCMP  = OFF_GATES + (size_t)NTOK * 24 * 4;
constexpr size_t OFF_VCMPT = OFF_KCMP  + (size_t)32 * 256 * 64 * 2;
constexpr size_t OFF_MIX   = OFF_VCMPT + (size_t)32 * 256 * 64 * 2;
constexpr size_t OFF_SMALL = OFF_MIX   + (size_t)NTOK * 1024 * 2;
constexpr int SM_LNG = 0, SM_LNB = 512, SM_BSP = 1024, SM_W2K = 2048, SM_W2V = 2048 + 8192, SM_NFG = 2048 + 16384, SM_TOTAL = 2048 + 16384 + 1024;
constexpr size_t OFF_ROWSS = OFF_SMALL + (size_t)SM_TOTAL * 4;
constexpr size_t OFF_BAR   = OFF_ROWSS + (size_t)NTOK * 4;
constexpr size_t OFF_XBAR  = OFF_BAR + 256;
constexpr size_t OFF_PCNT  = OFF_XBAR + 3456 * 4;
constexpr size_t OFF_QCTR  = OFF_PCNT + 256 * 4;
constexpr size_t WS_END    = OFF_QCTR + 256;

constexpr int SMEM_BYTES = 135168;

struct Params {
  const float *x, *norm_in_g, *w_in, *w_k1, *w_k2, *pe_k, *w_v1, *w_v2, *pe_v, *ln_g, *ln_b, *w_sp, *b_sp, *w_out, *norm_f_g;
  float* out;
  char* ws;
};

DI unsigned pack2(float a, float b) {
  f2_t v = {a, b};
  bf2_t r = __builtin_convertvector(v, bf2_t);
  return __builtin_bit_cast(unsigned, r);
}
DI bf16_t f2bf(float a) { return (bf16_t)(pack2(a, 0.f) & 0xffffu); }
DI float bflo(unsigned u) { return __uint_as_float(u << 16); }
DI float bfhi(unsigned u) { return __uint_as_float(u & 0xffff0000u); }
DI float shx(float v, int mask, int lane) {
  return __builtin_bit_cast(float, __builtin_amdgcn_ds_bpermute((lane ^ mask) << 2, __builtin_bit_cast(int, v)));
}
DI unsigned shxu(unsigned v, int mask, int lane) {
  return (unsigned)__builtin_amdgcn_ds_bpermute((lane ^ mask) << 2, (int)v);
}
DI float wave_sum(float v, int lane) {
#pragma unroll
  for (int o = 32; o >= 1; o >>= 1) v += shx(v, o, lane);
  return v;
}
DI float gelu_t(float x) {
  const float y2 = x * __builtin_fmaf(0.044715f, x * x, 1.0f) * (-2.0f * 0.7978845608028654f * 1.4426950408889634f);
  return x * __builtin_amdgcn_rcpf(1.0f + __builtin_amdgcn_exp2f(y2));
}
DI float sigmoid_f(float x) { return __builtin_amdgcn_rcpf(1.0f + __builtin_amdgcn_exp2f(-1.4426950408889634f * x)); }
DI float silu_f(float x) { return x * __builtin_amdgcn_rcpf(1.0f + __builtin_amdgcn_exp2f(-1.4426950408889634f * x)); }
typedef float f2a __attribute__((ext_vector_type(2)));
DI f2a gelu2(f2a x) {
  const f2a t = x * x * 0.044715f + 1.0f;
  const f2a y2 = x * t * (-2.0f * 0.7978845608028654f * 1.4426950408889634f);
  f2a e = {__builtin_amdgcn_exp2f(y2.x), __builtin_amdgcn_exp2f(y2.y)};
  e = e + 1.0f;
  const f2a rinv = {__builtin_amdgcn_rcpf(e.x), __builtin_amdgcn_rcpf(e.y)};
  return x * rinv;
}
DI f2a silu2(f2a x) {
  const f2a a = x * (-1.4426950408889634f);
  f2a e = {__builtin_amdgcn_exp2f(a.x), __builtin_amdgcn_exp2f(a.y)};
  e = e + 1.0f;
  const f2a rinv = {__builtin_amdgcn_rcpf(e.x), __builtin_amdgcn_rcpf(e.y)};
  return x * rinv;
}
DI f2a gelu_silu2(f2a u, f2a z) {
  const f2a t = u * u * 0.044715f + 1.0f;
  const f2a y2 = u * t * (-2.0f * 0.7978845608028654f * 1.4426950408889634f);
  const f2a a = z * (-1.4426950408889634f);
  f2a ea = {__builtin_amdgcn_exp2f(y2.x), __builtin_amdgcn_exp2f(y2.y)};
  f2a eb = {__builtin_amdgcn_exp2f(a.x), __builtin_amdgcn_exp2f(a.y)};
  const f2a den = (ea + 1.0f) * (eb + 1.0f);
  const f2a rinv = {__builtin_amdgcn_rcpf(den.x), __builtin_amdgcn_rcpf(den.y)};
  return u * z * rinv;
}
DI unsigned pack2v(f2a v) { return pack2(v.x, v.y); }
DI float xhalf_max(float v) {
  const auto r_ = __builtin_amdgcn_permlane32_swap(__float_as_uint(v), __float_as_uint(v), false, false);
  return fmaxf(__uint_as_float(r_[0]), __uint_as_float(r_[1]));
}
DI float xhalf_sum(float v) {
  const auto r_ = __builtin_amdgcn_permlane32_swap(__float_as_uint(v), __float_as_uint(v), false, false);
  return __uint_as_float(r_[0]) + __uint_as_float(r_[1]);
}
DI int crow(int i, int h) { return (i & 3) + 8 * (i >> 2) + 4 * h; }
DI int opaque_tid() { int t = threadIdx.x; asm volatile("" : "+v"(t)); return t; }
DI int opaque_tid_w(int wid_s) {
  int t = (wid_s << 6) | (int)__builtin_amdgcn_mbcnt_hi(~0u, __builtin_amdgcn_mbcnt_lo(~0u, 0u));
  asm volatile("" : "+v"(t));
  return t;
}

#define XB_TMO      128
#define XB_XCNT(j)  (256  + 64 * (j))
#define XB_XSUB(j)  (1280 + 64 * (j))
#define XB_XGEN(j)  (2304 + 64 * (j))
#define XB_TOP      3328
#define XB_TOPGEN   3392
#define XCD_BAR_WORDS 3456
#define XB_SPIN_CAP (1u << 18)
#define XB_LAS __attribute__((address_space(3)))

__device__ __forceinline__ unsigned xb_ld(unsigned* p)              { return __hip_atomic_load(p, __ATOMIC_RELAXED, __HIP_MEMORY_SCOPE_AGENT); }
__device__ __forceinline__ unsigned xb_add(unsigned* p, unsigned v) { return __hip_atomic_fetch_add(p, v, __ATOMIC_RELAXED, __HIP_MEMORY_SCOPE_AGENT); }
__device__ __forceinline__ unsigned xb_xcc_id() { return (unsigned)__builtin_amdgcn_s_getreg((3 << 11) | 20) & 0xFu; }
#define XB_SPIN(cond, bar) do { unsigned _sp = 0; while (cond) { __builtin_amdgcn_s_sleep(1); \
    if ((++_sp & 255u) == 0u) { if (xb_ld(&(bar)[XB_TMO])) break; if (_sp > XB_SPIN_CAP) { atomicAdd(&(bar)[XB_TMO], 1u); break; } } } } while (0)

struct XcdBarrier {
    unsigned* bar; unsigned x;
    volatile XB_LAS unsigned* st;
};

__device__ __forceinline__ XcdBarrier xcd_barrier_post(unsigned* bar, volatile XB_LAS unsigned* st) {
    XcdBarrier b; b.bar = bar; b.x = xb_xcc_id(); b.st = st;
    if (threadIdx.x == 0) (void)xb_add(&bar[XB_XCNT(b.x)], 1u);
    return b;
}
__device__ __forceinline__ void xcd_barrier_complete(unsigned* bar, unsigned x, unsigned& nloc, unsigned& nx) {
    const unsigned G = gridDim.x * gridDim.y * gridDim.z;
    unsigned sum, cnt, mine, sp = 0u;
    for (;;) {
        sum = 0u; cnt = 0u; mine = 0u;
#pragma unroll
        for (unsigned j = 0; j < 16; ++j) { const unsigned c = xb_ld(&bar[XB_XCNT(j)]); sum += c; cnt += (c > 0u) ? 1u : 0u; mine = (j == x) ? c : mine; }
        if (sum == G) break;
        __builtin_amdgcn_s_sleep(1);
        if ((++sp & 255u) == 0u) { if (xb_ld(&bar[XB_TMO])) break; if (sp > XB_SPIN_CAP) { atomicAdd(&bar[XB_TMO], 1u); break; } }
    }
    nloc = mine > 0u ? mine : 1u; nx = cnt > 0u ? cnt : 1u;
}

__device__ __forceinline__ void xcd_barrier(const XcdBarrier& b) {
    asm volatile("s_waitcnt vmcnt(0)" ::: "memory");
    __syncthreads();
    if (threadIdx.x == 0) {
        unsigned* bar = b.bar;
        __builtin_amdgcn_s_waitcnt(0);
        unsigned nloc = b.st[0], nx = b.st[1];
        if (nloc == 0u) { xcd_barrier_complete(bar, b.x, nloc, nx); b.st[0] = nloc; b.st[1] = nx; }
        const unsigned old = xb_add(&bar[XB_XSUB(b.x)], 1u);
        const unsigned gen = old / nloc;
        if (old + 1u == (gen + 1u) * nloc) {
            __builtin_amdgcn_fence(__ATOMIC_RELEASE, "agent");
            asm volatile("s_waitcnt vmcnt(0)" ::: "memory");
            const unsigned og = xb_add(&bar[XB_TOP], 1u);
            const unsigned tg = og / nx;
            if (og + 1u == (tg + 1u) * nx) xb_add(&bar[XB_TOPGEN], 1u);
            else XB_SPIN(xb_ld(&bar[XB_TOPGEN]) == tg, bar);
            __builtin_amdgcn_fence(__ATOMIC_ACQUIRE, "agent");
            xb_add(&bar[XB_XGEN(b.x)], 1u);
            asm volatile("s_waitcnt vmcnt(0)" ::: "memory");
        } else {
            XB_SPIN(xb_ld(&bar[XB_XGEN(b.x)]) == gen, bar);
            __builtin_amdgcn_fence(__ATOMIC_ACQUIRE, "agent");
            asm volatile("s_waitcnt vmcnt(0)" ::: "memory");
        }
    }
    __syncthreads();
}

DI void grid_bar(unsigned* ctr, unsigned target, bool leader) {
  asm volatile("s_waitcnt vmcnt(0) lgkmcnt(0)" ::: "memory");
  __syncthreads();
  if (leader) {
    __builtin_amdgcn_fence(__ATOMIC_RELEASE, "agent");
    asm volatile("s_waitcnt vmcnt(0)" ::: "memory");
    __hip_atomic_fetch_add(ctr, 1u, __ATOMIC_RELAXED, __HIP_MEMORY_SCOPE_AGENT);
    while (__hip_atomic_load(ctr, __ATOMIC_RELAXED, __HIP_MEMORY_SCOPE_AGENT) < target) __builtin_amdgcn_s_sleep(2);
    __builtin_amdgcn_fence(__ATOMIC_ACQUIRE, "agent");
    asm volatile("s_waitcnt vmcnt(0)" ::: "memory");
  }
  __syncthreads();
}

DI void transpose_w(const float* __restrict__ src, int src_ld, bf16_t* __restrict__ dst, int Np, int K, int mode,
                    int gtid, int gthreads) {
  const int nchunks = K >> 3;
  const long total = (long)nchunks * Np;
  for (long id = gtid; id < total; id += gthreads) {
    const int n = (int)(id % Np), kc = (int)(id / Np);
    int sn = n;
    if (mode == 1) {
      if (n < 1280) sn = n;
      else if (n < 3328) sn = n + 24;
      else if (n < 3352) sn = n - 3328 + 1280;
      else sn = -1;
    }
    u32x4 o = {0u, 0u, 0u, 0u};
    if (sn >= 0) {
      float f[8];
#pragma unroll
      for (int j = 0; j < 8; ++j) f[j] = src[(size_t)(kc * 8 + j) * src_ld + sn];
      o[0] = pack2(f[0], f[1]); o[1] = pack2(f[2], f[3]); o[2] = pack2(f[4], f[5]); o[3] = pack2(f[6], f[7]);
    }
    *(u32x4*)(dst + (size_t)n * K + kc * 8) = o;
  }
}

DI void phase0(const Params& p) {
  const int tid = opaque_tid(), lane = tid & 63, wave = tid >> 6;
  const int gthreads = gridDim.x * NTHR, gtid = blockIdx.x * NTHR + tid;
  const int gwaves = gridDim.x * 8, gwave = blockIdx.x * 8 + wave;
  bf16_t* HN = (bf16_t*)(p.ws + OFF_HN);
  for (int row = gwave; row < NTOK; row += gwaves) {
    const float4* xr = (const float4*)(p.x + (size_t)row * 1024);
    float4 v[4];
    float ss = 0.f;
#pragma unroll
    for (int i = 0; i < 4; ++i) {
      v[i] = xr[i * 64 + lane];
      ss += v[i].x * v[i].x + v[i].y * v[i].y + v[i].z * v[i].z + v[i].w * v[i].w;
    }
    ss = wave_sum(ss, lane);
    const float rstd = rsqrtf(ss * (1.f / 1024.f) + 1e-6f);
#pragma unroll
    for (int i = 0; i < 4; ++i) {
      const float4 g = ((const float4*)p.norm_in_g)[i * 64 + lane];
      u32x2 o;
      o[0] = pack2(v[i].x * rstd * g.x, v[i].y * rstd * g.y);
      o[1] = pack2(v[i].z * rstd * g.z, v[i].w * rstd * g.w);
      *(u32x2*)(HN + (size_t)row * 1024 + (i * 64 + lane) * 4) = o;
    }
  }
  transpose_w(p.w_in, 3352, (bf16_t*)(p.ws + OFF_WTIN), NPAD, 1024, 1, gtid, gthreads);
  transpose_w(p.w_out, 1024, (bf16_t*)(p.ws + OFF_WTOUT), 1024, 1024, 0, gtid, gthreads);
  transpose_w(p.w_k1, 128, (bf16_t*)(p.ws + OFF_W1TK), 128, 2048, 0, gtid, gthreads);
  transpose_w(p.w_v1, 128, (bf16_t*)(p.ws + OFF_W1TV), 128, 2048, 0, gtid, gthreads);
  float* BIAS = (float*)(p.ws + OFF_BIAS);
  for (int it = gwave; it < 256; it += gwaves) {
    const int kv = it >> 7, e = it & 127;
    const float* w1 = kv ? p.w_v1 : p.w_k1;
    const float* pe = kv ? p.pe_v : p.pe_k;
    float s = 0.f;
    for (int kk = lane; kk < 2048; kk += 64) s += pe[kk] * w1[(size_t)kk * 128 + e];
    s = wave_sum(s, lane);
    if (lane == 0) BIAS[it] = s;
  }
  if (gtid == 0) { *(unsigned*)(p.ws + OFF_BAR) = 0u; *(unsigned*)(p.ws + OFF_QCTR) = 0u; }
  {
    float* RS = (float*)(p.ws + OFF_ROWSS);
    for (int id = gtid; id < NTOK; id += gthreads) RS[id] = 0.f;
    if (gtid < 256) ((unsigned*)(p.ws + OFF_PCNT))[gtid] = 0u;
  }
  {
    float* SMALL = (float*)(p.ws + OFF_SMALL);
    for (int id = gtid; id < SM_TOTAL; id += gthreads) {
      float v;
      if (id < SM_LNB) v = p.ln_g[id - SM_LNG];
      else if (id < SM_BSP) v = p.ln_b[id - SM_LNB];
      else if (id < SM_W2K) v = p.b_sp[id - SM_BSP];
      else if (id < SM_W2V) v = p.w_k2[id - SM_W2K];
      else if (id < SM_NFG) v = p.w_v2[id - SM_W2V];
      else v = p.norm_f_g[id - SM_NFG];
      SMALL[id] = v;
    }
  }
  bf16_t* WSP = (bf16_t*)(p.ws + OFF_WSP);
  for (int id = gtid; id < 8 * 128 * 128; id += gthreads) {
    const int t = (id >> 7) & 127, s = id & 127;
    WSP[id] = (s <= t) ? f2bf(p.w_sp[id]) : (bf16_t)0;
  }
}

namespace pg8 {
#define PG8_LAS __attribute__((address_space(3)))
typedef unsigned short bf16_t;
typedef short bf16x8 __attribute__((ext_vector_type(8)));
typedef float f32x4 __attribute__((ext_vector_type(4)));
typedef unsigned u32x4 __attribute__((ext_vector_type(4)));
constexpr int BM = 256, BK = 64, HALF = 128, HTB = HALF * BK * 2  , STAGE_BYTES = 8 * HTB, NXCD = 8, WGM = 4;

__host__ __device__ __forceinline__ int lds_byte(int r, int c) { const int st = (r >> 4) * 2 + (c >> 5), rr = r & 15, cc = c & 31, ob = rr * 64 + cc * 2; return st * 1024 + (ob ^ (((ob >> 9) & 1) << 5)); }
__host__ __device__ __forceinline__ void stage_rc(int b, int& R, int& C) { const int st = b / 1024, sb = b % 1024, swz = sb ^ (((sb >> 9) & 1) << 5); R = (st >> 1) * 16 + swz / 64; C = (st & 1) * 32 + (swz % 64) / 2; }
__host__ __device__ __forceinline__ int perm32(int rho) { const int n = rho >> 4, i = rho & 15; return 8 * (i >> 2) + 4 * n + (i & 3); }

struct Unit { int pm, pn; };
struct Gemm { const bf16_t* A; const bf16_t* Bt; int M, N, K; };

struct StaticOrder {
    int nM, nN, nwg, G, c;
    __host__ __device__ void init(int M, int N, int G_, int c_) { nM = M / BM; nN = N / BM; nwg = nM * nN; G = G_; c = c_; }
    __host__ __device__ bool next(int i, Unit& u) const {
        const long L = (long)i * G + c; if (L >= nwg) return false;
        int wgid = (int)L; { const int q = nwg / NXCD, r = nwg % NXCD, xcd = wgid % NXCD, off = wgid / NXCD; wgid = (xcd < r ? xcd * (q + 1) : r * (q + 1) + (xcd - r) * q) + off; }
        const int nig = WGM * nN, gid = wgid / nig, fm = gid * WGM, gsz = (nM - fm) < WGM ? (nM - fm) : WGM;
        u.pm = fm + ((wgid % nig) % gsz); u.pn = (wgid % nig) / gsz; return true;
    }
    __device__ __forceinline__ void a_ready(const Unit&) const {}
    __device__ __forceinline__ void done(const Unit&) const {}
};

template <class Epi, class Sched, bool STAMP = false>
__device__ __forceinline__ void gemm_phase(PG8_LAS unsigned char* lds, const Gemm g, const Sched& S, const Epi& E, unsigned long long* stamps, const int tid_in) {
    const int tid = tid_in, wid = __builtin_amdgcn_readfirstlane(tid >> 6), lane = tid & 63, wr = wid >> 2, wc = wid & 3, fr = lane & 15, fq = lane >> 4;
    const int K = g.K, nt = K / BK;
    int ts_lo = 0, ts_hi = 0, nts = 0; const unsigned long long rt_entry = STAMP ? (unsigned long long)wall_clock64() : 0ull;
#define PG8_STAMP() do { if (STAMP && wid == 0 && nts < 64) { const unsigned long long _c = (unsigned long long)clock64(); \
        ts_lo = (lane == nts) ? (int)(unsigned)_c : ts_lo; ts_hi = (lane == nts) ? (int)(unsigned)(_c >> 32) : ts_hi; ++nts; } } while (0)
    PG8_STAMP();
    unsigned voffA[2], voffB[2];
#pragma unroll
    for (int i = 0; i < 2; ++i) { int R, C; stage_rc(tid * 16 + i * 8192, R, C); const int Rb = Epi::PERM ? ((R & ~31) + perm32(R & 31)) : R;
        voffA[i] = (unsigned)(R * K + C) * 2u; voffB[i] = (unsigned)(Rb * K + C) * 2u; }
    const size_t kstep = (size_t)(BK * 2);
    const size_t hstep = (size_t)HALF * K * 2;
    const size_t tstep = 2 * hstep;
    const unsigned ldsw = (unsigned)wid * 1024u;
    const int aoff = lds_byte(wr * 64 + fr, fq * 8), boff = lds_byte(wc * 32 + fr, fq * 8);
#define PG8_SA(b, h) (((b) * 2 + (h)) * HTB)
#define PG8_SB(b, h) ((4 + (b) * 2 + (h)) * HTB)
#define PG8_STAGE(bufoff, gbase, voff) do { _Pragma("unroll") for (int _i = 0; _i < 2; ++_i) \
        __builtin_amdgcn_global_load_lds((const unsigned*)((const char*)(gbase) + (voff)[_i]), (PG8_LAS unsigned*)(lds + (bufoff) + ldsw + _i * 8192), 16, 0, 0); } while (0)
#define PG8_LDA(dst, b, h) do { _Pragma("unroll") for (int m = 0; m < 4; ++m) _Pragma("unroll") for (int k = 0; k < 2; ++k) dst[m][k] = *(const PG8_LAS bf16x8*)(lds + PG8_SA(b, h) + aoff + m * 2048 + k * 1024); } while (0)
#define PG8_LDB(dst, b, h) do { _Pragma("unroll") for (int n = 0; n < 2; ++n) _Pragma("unroll") for (int k = 0; k < 2; ++k) dst[n][k] = *(const PG8_LAS bf16x8*)(lds + PG8_SB(b, h) + boff + n * 2048 + k * 1024); } while (0)
#define PG8_MMA(ai, bj, At, Bt) do { __builtin_amdgcn_s_setprio(1); _Pragma("unroll") for (int m = 0; m < 4; ++m) _Pragma("unroll") for (int n = 0; n < 2; ++n) _Pragma("unroll") for (int k = 0; k < 2; ++k) \
        acc[ai][bj][m][n] = __builtin_amdgcn_mfma_f32_16x16x32_bf16(Bt[n][k], At[m][k], acc[ai][bj][m][n], 0, 0, 0); __builtin_amdgcn_s_setprio(0); } while (0)
#define PG8_WAIT_V(n) asm volatile("s_waitcnt vmcnt(" #n ")" ::: "memory")
#define PG8_WAIT_L(n) asm volatile("s_waitcnt lgkmcnt(" #n ")" ::: "memory")
#define PG8_BAR __builtin_amdgcn_s_barrier()
#define PG8_SCHED __builtin_amdgcn_sched_barrier(0)
    Unit cur, nxt; int ui = 0;
    if (!S.next(0, cur)) return;
    f32x4 acc[2][2][4][2];
#pragma unroll
    for (int a = 0; a < 2; ++a)
#pragma unroll
        for (int b = 0; b < 2; ++b)
#pragma unroll
            for (int m = 0; m < 4; ++m)
#pragma unroll
                for (int n = 0; n < 2; ++n) acc[a][b][m][n] = (f32x4){0.f, 0.f, 0.f, 0.f};
    bf16x8 At[4][2], B0[2][2], B1[2][2];
    const char* cA = (const char*)g.A + (size_t)cur.pm * tstep; const char* cB = (const char*)g.Bt + (size_t)cur.pn * tstep;
    S.a_ready(cur);
    PG8_STAGE(PG8_SB(0, 0), cB, voffB); PG8_STAGE(PG8_SA(0, 0), cA, voffA); PG8_STAGE(PG8_SB(0, 1), cB + hstep, voffB); PG8_STAGE(PG8_SA(0, 1), cA + hstep, voffA);
    if (wr == 1) PG8_BAR;
    PG8_WAIT_V(4); PG8_BAR;
    PG8_STAGE(PG8_SB(1, 0), cB + kstep, voffB); PG8_STAGE(PG8_SA(1, 0), cA + kstep, voffA); PG8_STAGE(PG8_SB(1, 1), cB + hstep + kstep, voffB);
    PG8_WAIT_V(6); PG8_BAR;
    PG8_STAMP();
    for (;;) {
        const bool has_next = S.next(ui + 1, nxt);
        const char* nA = has_next ? (const char*)g.A + (size_t)nxt.pm * tstep : cA; const char* nB = has_next ? (const char*)g.Bt + (size_t)nxt.pn * tstep : cB;
        for (int t = 0; t < nt; t += 2) {
            const bool last = (t == nt - 2);
            const char* a1 = cA + (size_t)(t + 1) * kstep;
            const char* a2 = last ? nA : cA + (size_t)(t + 2) * kstep; const char* b2 = last ? nB : cB + (size_t)(t + 2) * kstep;
            const char* a3 = a2 + kstep; const char* b3 = b2 + kstep;
            if (last && has_next) S.a_ready(nxt);
            PG8_LDB(B0, 0, 0); PG8_SCHED; PG8_LDA(At, 0, 0); PG8_STAGE(PG8_SA(1, 1), a1 + hstep, voffA);
            PG8_WAIT_L(8); PG8_BAR; PG8_WAIT_L(0); PG8_MMA(0, 0, At, B0); PG8_BAR; PG8_SCHED;
            PG8_LDB(B1, 0, 1); PG8_STAGE(PG8_SB(0, 0), b2, voffB);
            PG8_BAR; PG8_WAIT_L(0); PG8_MMA(0, 1, At, B1); PG8_BAR;
            PG8_LDA(At, 0, 1); PG8_STAGE(PG8_SA(0, 0), a2, voffA);
            PG8_BAR; PG8_WAIT_L(0); PG8_MMA(1, 0, At, B0); PG8_BAR; PG8_SCHED;
            PG8_STAGE(PG8_SB(0, 1), b2 + hstep, voffB);
            PG8_WAIT_V(6); PG8_BAR; PG8_MMA(1, 1, At, B1); PG8_BAR;
            PG8_LDB(B0, 1, 0); PG8_SCHED; PG8_LDA(At, 1, 0); PG8_STAGE(PG8_SA(0, 1), a2 + hstep, voffA);
            PG8_WAIT_L(8); PG8_BAR; PG8_WAIT_L(0); PG8_MMA(0, 0, At, B0); PG8_BAR; PG8_SCHED;
            PG8_LDB(B1, 1, 1); PG8_STAGE(PG8_SB(1, 0), b3, voffB);
            PG8_BAR; PG8_WAIT_L(0); PG8_MMA(0, 1, At, B1); PG8_BAR;
            PG8_LDA(At, 1, 1); PG8_STAGE(PG8_SA(1, 0), a3, voffA);
            PG8_BAR; PG8_WAIT_L(0); PG8_MMA(1, 0, At, B0); PG8_BAR; PG8_SCHED;
            PG8_STAGE(PG8_SB(1, 1), b3 + hstep, voffB);
            PG8_WAIT_V(6); PG8_BAR; PG8_MMA(1, 1, At, B1); PG8_BAR;
        }
        PG8_STAMP();
        if constexpr (!Epi::AFTER_DRAIN) { E(acc, cur, wr, wc, fr, fq); S.done(cur); }
        PG8_STAMP();
        if (!has_next) break;
#pragma unroll
        for (int a = 0; a < 2; ++a)
#pragma unroll
            for (int b = 0; b < 2; ++b)
#pragma unroll
                for (int m = 0; m < 4; ++m)
#pragma unroll
                    for (int n = 0; n < 2; ++n) acc[a][b][m][n] = (f32x4){0.f, 0.f, 0.f, 0.f};
        cur = nxt; cA = nA; cB = nB; ++ui;
    }
    PG8_WAIT_V(0);
    if (wr == 0) PG8_BAR;
    PG8_BAR;
    if constexpr (Epi::AFTER_DRAIN) { E.fused(acc, cur, wr, wc, fr, fq, lds, wid, lane); S.done(cur); }
    PG8_STAMP();
    if (STAMP && wid == 0) { stamps[lane] = lane < nts ? (((unsigned long long)(unsigned)ts_hi << 32) | (unsigned)ts_lo) : 0ull;
        if (lane == 62) stamps[62] = rt_entry; if (lane == 63) stamps[63] = (unsigned long long)wall_clock64(); }
#undef PG8_STAMP
#undef PG8_SA
#undef PG8_SB
#undef PG8_STAGE
#undef PG8_LDA
#undef PG8_LDB
#undef PG8_MMA
#undef PG8_WAIT_V
#undef PG8_WAIT_L
#undef PG8_BAR
#undef PG8_SCHED
}
}

struct PanelOrder {
  int c, npn;
  __device__ bool next(int i, pg8::Unit& u) const { if (i >= npn) return false; u.pm = c; u.pn = i; return true; }
  __device__ __forceinline__ void a_ready(const pg8::Unit&) const {}
  __device__ __forceinline__ void done(const pg8::Unit&) const {}
};

struct EpiP1 {
  static constexpr bool PERM = true, AFTER_DRAIN = false;
  char* ws;
  __device__ __forceinline__ void operator()(const pg8::f32x4 (&acc)[2][2][4][2], const pg8::Unit& u, int wr, int wc, int fr, int fq) const {
#pragma unroll
    for (int bj = 0; bj < 2; ++bj) {
      const int nt = u.pn * 2 + bj;
      if (nt >= 27) continue;
      const int cn0 = wc * 32 + fq * 8;
      bf16_t* dst = nullptr;
      int ld = 512, colbase = 0, act = 0;
      bool transposed = false;
      if (nt < 4) { dst = (bf16_t*)(ws + OFF_Q); colbase = nt * 128; act = 1; }
      else if (nt == 4) { dst = (bf16_t*)(ws + OFF_KC); ld = 128; }
      else if (nt == 5) { dst = (bf16_t*)(ws + OFF_VC); ld = 128; }
      else if (nt == 6) { dst = (bf16_t*)(ws + OFF_KS); ld = 128; }
      else if (nt == 7) { dst = (bf16_t*)(ws + OFF_VST); transposed = true; }
      else if (nt == 8) { dst = (bf16_t*)(ws + OFF_KW); ld = 128; }
      else if (nt == 9) { dst = (bf16_t*)(ws + OFF_VWT); transposed = true; }
      else if (nt < 14) { dst = (bf16_t*)(ws + OFF_ZN); colbase = (nt - 10) * 128; }
      else if (nt < 18) { dst = (bf16_t*)(ws + OFF_U); colbase = (nt - 14) * 128; }
      else if (nt < 22) { dst = (bf16_t*)(ws + OFF_V); colbase = (nt - 18) * 128; }
      else if (nt < 26) { dst = (bf16_t*)(ws + OFF_ZG); colbase = (nt - 22) * 128; }
#pragma unroll
      for (int ai = 0; ai < 2; ++ai)
#pragma unroll
        for (int m = 0; m < 4; ++m) {
          const int row = u.pm * 256 + ai * 128 + wr * 64 + m * 16 + fr;
          float v[8];
#pragma unroll
          for (int j = 0; j < 4; ++j) { v[j] = acc[ai][bj][m][0][j]; v[4 + j] = acc[ai][bj][m][1][j]; }
          if (nt == 26) {
            if (cn0 < 24) {
              float* G = (float*)(ws + OFF_GATES) + (size_t)row * 24 + cn0;
              float4 g0, g1;
              g0.x = sigmoid_f(v[0]); g0.y = sigmoid_f(v[1]); g0.z = sigmoid_f(v[2]); g0.w = sigmoid_f(v[3]);
              g1.x = sigmoid_f(v[4]); g1.y = sigmoid_f(v[5]); g1.z = sigmoid_f(v[6]); g1.w = sigmoid_f(v[7]);
              *(float4*)G = g0;
              *(float4*)(G + 4) = g1;
            }
          } else if (transposed) {
            const int b = row >> 12, t = row & 4095;
            bf16_t* dp = dst + ((size_t)((b * 2 + (cn0 >> 6)) * 64 + (cn0 & 63))) * 4096 + t;
#pragma unroll
            for (int j = 0; j < 8; ++j) dp[(size_t)j * 4096] = f2bf(v[j]);
          } else {
            if (act == 1) {
#pragma unroll
              for (int j = 0; j < 8; ++j) v[j] *= 0.125f;
            } else if (act == 2) {
#pragma unroll
              for (int j = 0; j < 8; ++j) v[j] = silu_f(v[j]);
            } else if (act == 3) {
#pragma unroll
              for (int j = 0; j < 8; ++j) v[j] = gelu_t(v[j]);
            }
            u32x4 o;
            o[0] = pack2(v[0], v[1]); o[1] = pack2(v[2], v[3]); o[2] = pack2(v[4], v[5]); o[3] = pack2(v[6], v[7]);
            *(u32x4*)(dst + (size_t)row * ld + colbase + cn0) = o;
          }
          __builtin_amdgcn_sched_barrier(0);
        }
    }
  }
};

struct EpiP4 {
  static constexpr bool PERM = true, AFTER_DRAIN = false;
  const float* x;
  bf16_t* hb;
  float* rowss;
  __device__ __forceinline__ void operator()(const pg8::f32x4 (&acc)[2][2][4][2], const pg8::Unit& u, int wr, int wc, int fr_in, int fq) const {
    int fr = fr_in;
    asm volatile("" : "+v"(fr));
    int pm_ = u.pm;
    asm volatile("" : "+s"(pm_));
#pragma unroll
    for (int ai = 0; ai < 2; ++ai)
#pragma unroll
      for (int m = 0; m < 4; ++m) {
        const int rl = ai * 128 + wr * 64 + m * 16 + fr;
        const size_t rowoff = ((size_t)pm_ * 256 + rl) * 1024;
        float4 xv[2][2];
#pragma unroll
        for (int bj = 0; bj < 2; ++bj) {
          const int col = u.pn * 256 + bj * 128 + wc * 32 + fq * 8;
          xv[bj][0] = *(const float4*)(x + rowoff + col);
          xv[bj][1] = *(const float4*)(x + rowoff + col + 4);
        }
        float ss = 0.f;
#pragma unroll
        for (int bj = 0; bj < 2; ++bj) {
          const int col = u.pn * 256 + bj * 128 + wc * 32 + fq * 8;
          float v[8];
          v[0] = acc[ai][bj][m][0][0] + xv[bj][0].x; v[1] = acc[ai][bj][m][0][1] + xv[bj][0].y;
          v[2] = acc[ai][bj][m][0][2] + xv[bj][0].z; v[3] = acc[ai][bj][m][0][3] + xv[bj][0].w;
          v[4] = acc[ai][bj][m][1][0] + xv[bj][1].x; v[5] = acc[ai][bj][m][1][1] + xv[bj][1].y;
          v[6] = acc[ai][bj][m][1][2] + xv[bj][1].z; v[7] = acc[ai][bj][m][1][3] + xv[bj][1].w;
#pragma unroll
          for (int j = 0; j < 8; ++j) ss += v[j] * v[j];
          u32x4 o;
          o[0] = pack2(v[0], v[1]); o[1] = pack2(v[2], v[3]); o[2] = pack2(v[4], v[5]); o[3] = pack2(v[6], v[7]);
          *(u32x4*)(hb + rowoff + col) = o;
        }
        ss += shx(ss, 16, fq * 16 + fr);
        ss += shx(ss, 32, fq * 16 + fr);
        if (fq == 0) __hip_atomic_fetch_add(rowss + (size_t)pm_ * 256 + rl, ss, __ATOMIC_RELAXED, __HIP_MEMORY_SCOPE_AGENT);
      }
  }
};

DI void compress_item(const Params& p, char* smem, int it, bool active) {
  const int tid = opaque_tid() & 255, lane = tid & 63, wave = tid >> 6;
  const int r = lane & 31, h = lane >> 5;
  const int kv = it >> 8, b = (it >> 4) & 15, g = (it >> 3) & 1, n0 = (it & 7) * 32;
  float* hidL = (float*)smem;
  if (active) {
    const bf16_t* src = (const bf16_t*)(p.ws + (kv ? OFF_VC : OFF_KC));
    const bf16_t* w1t = (const bf16_t*)(p.ws + (kv ? OFF_W1TV : OFF_W1TK));
    const float* bias = (const float*)(p.ws + OFF_BIAS) + kv * 128;
    f32x16 acc;
#pragma unroll
    for (int i = 0; i < 16; ++i) acc[i] = 0.f;
    const int n = n0 + r;
    const bf16_t* brow = w1t + (size_t)(32 * wave + r) * 2048 + h * 8;
#pragma unroll 8
    for (int l = 0; l < 32; ++l) {
      int tok = 16 * n + l;
      tok = tok > 4095 ? 4095 : tok;
      const bf16_t* arow = src + ((size_t)b * 4096 + tok) * 128 + g * 64 + h * 8;
#pragma unroll
      for (int s = 0; s < 4; ++s) {
        const s16x8 af = *(const s16x8*)(arow + s * 16);
        const s16x8 bfr = *(const s16x8*)(brow + l * 64 + s * 16);
        acc = MFMA32(af, bfr, acc);
      }
    }
    const int e = 32 * wave + r;
    const float be = bias[e];
#pragma unroll
    for (int i = 0; i < 16; ++i) hidL[crow(i, h) * 132 + e] = gelu_t(acc[i] + be);
  }
  __syncthreads();
  if (active) {
    const float* w2 = (const float*)(p.ws + OFF_SMALL) + (kv ? SM_W2V : SM_W2K);
    const int f = tid & 63, ng = tid >> 6;
    float o[8];
#pragma unroll
    for (int k = 0; k < 8; ++k) o[k] = 0.f;
    for (int e0 = 0; e0 < 128; e0 += 16) {
      float wv[16];
#pragma unroll
      for (int j = 0; j < 16; ++j) wv[j] = w2[(e0 + j) * 64 + f];
#pragma unroll
      for (int j = 0; j < 16; ++j)
#pragma unroll
        for (int k = 0; k < 8; ++k) o[k] += hidL[(ng * 8 + k) * 132 + e0 + j] * wv[j];
    }
    const int bg = b * 2 + g;
#pragma unroll
    for (int k = 0; k < 8; ++k) {
      const int nn = n0 + ng * 8 + k;
      const float val = (nn < 255) ? o[k] : 0.f;
      if (kv == 0) ((bf16_t*)(p.ws + OFF_KCMP))[((size_t)bg * 256 + nn) * 64 + f] = f2bf(val);
      else ((bf16_t*)(p.ws + OFF_VCMPT))[((size_t)bg * 64 + f) * 256 + nn] = f2bf(val);
    }
  }
  __syncthreads();
}

DI void gmlp_item(const Params& p, char* smem, int it, bool active) {
  const int tid = opaque_tid() & 255, lane = tid & 63, wave = tid >> 6;
  const int r = lane & 31, h = lane >> 5;
  const int gg = it & 7, ck = (it >> 3) & 31, b = it >> 8;
  const size_t tokbase = (size_t)b * 4096 + ck * 128;
  const bf16_t* V = (const bf16_t*)(p.ws + OFF_V);
  const bf16_t* U = (const bf16_t*)(p.ws + OFF_U);
  const bf16_t* ZG = (const bf16_t*)(p.ws + OFF_ZG);
  const bf16_t* WSP = (const bf16_t*)(p.ws + OFF_WSP);
  bf16_t* MIX = (bf16_t*)(p.ws + OFF_MIX);
  const float* SMALLP = (const float*)(p.ws + OFF_SMALL);
  char* vnT = smem;
  float* mxl = (float*)(smem + 17408);
  const int tl = tid >> 1, half = tid & 1, d0 = half * 32;
  u32x4 uu4[4], zz4[4];
  if (active) {
    const size_t off0 = (tokbase + tl) * 512 + gg * 64 + d0;
#pragma unroll
    for (int q = 0; q < 4; ++q) { uu4[q] = *(const u32x4*)(U + off0 + q * 8); zz4[q] = *(const u32x4*)(ZG + off0 + q * 8); }
  }
  if (active) {
    float v[32];
    const bf16_t* vp = V + (tokbase + tl) * 512 + gg * 64 + d0;
#pragma unroll
    for (int q = 0; q < 4; ++q) {
      const u32x4 w = *(const u32x4*)(vp + q * 8);
#pragma unroll
      for (int k = 0; k < 4; ++k) { const f2a g2 = gelu2((f2a){bflo(w[k]), bfhi(w[k])}); v[q * 8 + 2 * k] = g2.x; v[q * 8 + 2 * k + 1] = g2.y; }
    }
    float s1 = 0.f;
#pragma unroll
    for (int j = 0; j < 32; ++j) s1 += v[j];
    s1 += shx(s1, 1, lane);
    const float mu = s1 * (1.f / 64.f);
    float s2 = 0.f;
#pragma unroll
    for (int j = 0; j < 32; ++j) { const float d = v[j] - mu; s2 += d * d; }
    s2 += shx(s2, 1, lane);
    const float rstd = rsqrtf(s2 * (1.f / 64.f) + 1e-6f);
#pragma unroll
    for (int j = 0; j < 32; ++j) {
      const float vn = (v[j] - mu) * rstd * SMALLP[SM_LNG + gg * 64 + d0 + j] + SMALLP[SM_LNB + gg * 64 + d0 + j];
      *(bf16_t*)(vnT + (d0 + j) * 272 + tl * 2) = f2bf(vn);
    }
  }
  __syncthreads();
  if (active) {
    f32x16 acc[2];
#pragma unroll
    for (int c = 0; c < 2; ++c)
#pragma unroll
      for (int i = 0; i < 16; ++i) acc[c][i] = 0.f;
    const bf16_t* arow = WSP + ((size_t)gg * 128 + 32 * wave + r) * 128 + h * 8;
    const int nks = 2 * (wave + 1);
    for (int ks = 0; ks < nks; ++ks) {
      const s16x8 af = *(const s16x8*)(arow + ks * 16);
#pragma unroll
      for (int c = 0; c < 2; ++c) {
        const s16x8 bfr = *(const s16x8*)(vnT + (c * 32 + r) * 272 + (ks * 16 + h * 8) * 2);
        acc[c] = MFMA32(af, bfr, acc[c]);
      }
    }
#pragma unroll
    for (int i = 0; i < 16; ++i) {
      const int t = 32 * wave + crow(i, h);
      const float bs = SMALLP[SM_BSP + gg * 128 + t];
#pragma unroll
      for (int c = 0; c < 2; ++c) mxl[t * 68 + c * 32 + r] = acc[c][i] + bs;
    }
  }
  __syncthreads();
  if (active) {
    const size_t off = (tokbase + tl) * 512 + gg * 64 + d0;
    bf16_t* op = MIX + (tokbase + tl) * 1024 + 512 + gg * 64 + d0;
#pragma unroll
    for (int q = 0; q < 4; ++q) {
      const u32x4 uu = uu4[q];
      const u32x4 zz = zz4[q];
      const float4 m0 = *(const float4*)(mxl + tl * 68 + d0 + q * 8);
      const float4 m1 = *(const float4*)(mxl + tl * 68 + d0 + q * 8 + 4);
      u32x4 o;
#define GM2_(uw, zw, ma, mb) pack2v(gelu_silu2((f2a){bflo(uw), bfhi(uw)}, (f2a){bflo(zw), bfhi(zw)}) * (f2a){(ma), (mb)})
      o[0] = GM2_(uu[0], zz[0], m0.x, m0.y);
      o[1] = GM2_(uu[1], zz[1], m0.z, m0.w);
      o[2] = GM2_(uu[2], zz[2], m1.x, m1.y);
      o[3] = GM2_(uu[3], zz[3], m1.z, m1.w);
#undef GM2_
      *(u32x4*)(op + q * 8) = o;
    }
  }
  __syncthreads();
}

DI void qk1(const char* Kl, const s16x8 (&qf)[4], f32x16 (&S)[2], int r, int h) {
#pragma unroll
  for (int a = 0; a < 2; ++a)
#pragma unroll
    for (int i = 0; i < 16; ++i) S[a][i] = 0.f;
#pragma unroll
  for (int kt2 = 0; kt2 < 2; ++kt2)
#pragma unroll
    for (int s = 0; s < 4; ++s) {
      const s16x8 kf = *(const s16x8*)(Kl + (kt2 * 32 + r) * 144 + s * 32 + h * 16);
      S[kt2] = MFMA32(kf, qf[s], S[kt2]);
    }
}
DI void pv1(const char* Vl, const f32x16 (&S)[2], f32x16 (&O)[2], int r, int h) {
#pragma unroll
  for (int kt2 = 0; kt2 < 2; ++kt2)
#pragma unroll
    for (int s2 = 0; s2 < 2; ++s2) {
      u32x4 pk;
      pk[0] = pack2(S[kt2][8 * s2 + 0], S[kt2][8 * s2 + 1]);
      pk[1] = pack2(S[kt2][8 * s2 + 2], S[kt2][8 * s2 + 3]);
      pk[2] = pack2(S[kt2][8 * s2 + 4], S[kt2][8 * s2 + 5]);
      pk[3] = pack2(S[kt2][8 * s2 + 6], S[kt2][8 * s2 + 7]);
      const s16x8 pf = __builtin_bit_cast(s16x8, pk);
#pragma unroll
      for (int dt = 0; dt < 2; ++dt) {
        const char* vp = Vl + (dt * 32 + r) * 144 + (kt2 * 32 + 16 * s2 + 4 * h) * 2;
        const s16x4 lo = *(const s16x4*)(vp);
        const s16x4 hi = *(const s16x4*)(vp + 16);
        const s16x8 vf = __builtin_shufflevector(lo, hi, 0, 1, 2, 3, 4, 5, 6, 7);
        O[dt] = MFMA32(vf, pf, O[dt]);
      }
    }
}
DI float max3f(float a, float b, float c) {
  float d;
  asm("v_max3_f32 %0, %1, %2, %3" : "=v"(d) : "v"(a), "v"(b), "v"(c));
  return d;
}
typedef float f2v __attribute__((ext_vector_type(2)));
DI float max17f(float a, const f32x16& x) {
  float d;
  asm("v_max3_f32 %0, %1, %2, %3\n\t"
      "v_max3_f32 %0, %0, %4, %5\n\t"
      "v_max3_f32 %0, %0, %6, %7\n\t"
      "v_max3_f32 %0, %0, %8, %9\n\t"
      "v_max3_f32 %0, %0, %10, %11\n\t"
      "v_max3_f32 %0, %0, %12, %13\n\t"
      "v_max3_f32 %0, %0, %14, %15\n\t"
      "v_max3_f32 %0, %0, %16, %17"
      : "=&v"(d)
      : "v"(a), "v"(x[0]), "v"(x[1]), "v"(x[2]), "v"(x[3]), "v"(x[4]), "v"(x[5]), "v"(x[6]), "v"(x[7]), "v"(x[8]), "v"(x[9]),
        "v"(x[10]), "v"(x[11]), "v"(x[12]), "v"(x[13]), "v"(x[14]), "v"(x[15]));
  return d;
}

DI void softmax1(f32x16 (&S)[2], int kbase, int lo, int hi, bool fast, bool rowok, float& m, float& l,
                 f32x16 (&O)[2], int h, int lane) {
  float mx = -1e30f;
  const int lo2 = lo - kbase - 4 * h, hi2 = hi - kbase - 4 * h;
  if (fast) {
#pragma unroll
    for (int kt2 = 0; kt2 < 2; ++kt2) mx = max17f(mx, S[kt2]);
    mx = rowok ? mx : -1e30f;
  } else {
#pragma unroll
    for (int kt2 = 0; kt2 < 2; ++kt2)
#pragma unroll
      for (int i = 0; i < 16; ++i) {
        const int ci = kt2 * 32 + (i & 3) + 8 * (i >> 2);
        mx = (ci >= lo2 && ci <= hi2) ? fmaxf(mx, S[kt2][i]) : mx;
      }
  }
  mx = xhalf_max(mx);
  const float mnew = fmaxf(m, mx);
  const float alpha = __builtin_amdgcn_exp2f((m - mnew) * L2E);
  const float mL = mnew * L2E;
  float sum = 0.f;
  if (fast) {
    const float mLe = rowok ? mL : 3.0e38f;
    f2v sumv = {0.f, 0.f};
#pragma unroll
    for (int kt2 = 0; kt2 < 2; ++kt2)
#pragma unroll
      for (int i = 0; i < 16; i += 2) {
        f2v t = {S[kt2][i], S[kt2][i + 1]};
        t = __builtin_elementwise_fma(t, (f2v){L2E, L2E}, (f2v){-mLe, -mLe});
        f2v pv2 = {__builtin_amdgcn_exp2f(t.x), __builtin_amdgcn_exp2f(t.y)};
        S[kt2][i] = pv2.x;
        S[kt2][i + 1] = pv2.y;
        sumv += pv2;
      }
    sum = sumv.x + sumv.y;
  } else {
#pragma unroll
    for (int kt2 = 0; kt2 < 2; ++kt2)
#pragma unroll
      for (int i = 0; i < 16; ++i) {
        const int ci = kt2 * 32 + (i & 3) + 8 * (i >> 2);
        const float pv = (ci >= lo2 && ci <= hi2) ? __builtin_amdgcn_exp2f(__builtin_fmaf(S[kt2][i], L2E, -mL)) : 0.f;
        S[kt2][i] = pv;
        sum += pv;
      }
  }
  l = l * alpha + sum;
  if (__builtin_amdgcn_ballot_w64(mnew > m) != 0ull) {
#pragma unroll
    for (int dt = 0; dt < 2; ++dt)
#pragma unroll
      for (int i = 0; i < 16; ++i) O[dt][i] *= alpha;
  }
  m = mnew;
}

DI void attn_item(const Params& p, char* smem, int c, int b, int g) {
  const int tid = opaque_tid(), lane = tid & 63, wave = tid >> 6;
  const int r = lane & 31, h = lane >> 5;
  const int hl = wave & 3, qt = wave >> 2;
  const int hd = g * 4 + hl, bg = b * 2 + g;
  const int ql = qt * 32 + r;
  const size_t tok = (size_t)b * 4096 + c * 64 + ql;
  const int tq = c * 64 + ql;
  float* imp = (float*)(smem + 36864);
  unsigned char* selm = (unsigned char*)(smem + 53248);
  const bf16_t* KCMP = (const bf16_t*)(p.ws + OFF_KCMP) + (size_t)bg * 256 * 64;
  const bf16_t* VCMPT = (const bf16_t*)(p.ws + OFF_VCMPT) + (size_t)bg * 64 * 256;
  const bf16_t* KS = (const bf16_t*)(p.ws + OFF_KS) + (size_t)b * 4096 * 128 + g * 64;
  const bf16_t* KW = (const bf16_t*)(p.ws + OFF_KW) + (size_t)b * 4096 * 128 + g * 64;
  const bf16_t* VST = (const bf16_t*)(p.ws + OFF_VST) + (size_t)bg * 64 * 4096;
  const bf16_t* VWT = (const bf16_t*)(p.ws + OFF_VWT) + (size_t)bg * 64 * 4096;

  s16x8 qf[4];
  {
    const bf16_t* qp = (const bf16_t*)(p.ws + OFF_Q) + tok * 512 + hd * 64 + h * 8;
#pragma unroll
    for (int s = 0; s < 4; ++s) qf[s] = *(const s16x8*)(qp + s * 16);
  }
  const float* gp = (const float*)(p.ws + OFF_GATES) + tok * 24 + hd * 3;
  const float gate0 = gp[0], gate1 = gp[1], gate2 = gp[2];

  const int nct = ((4 * c + 2) >> 6) + 1, nsel = c + 1, j0 = c >= 8 ? c - 8 : 0, nwin = c - j0 + 1;
  const int total = 2 * nct + nsel + nwin;
  const int srow = tid >> 3, scc = tid & 7;
  u32x4 kreg, vreg;
#define ATT_ISSUE(sidx)                                                                          \
  do {                                                                                           \
    const int s_ = (sidx);                                                                       \
    const bf16_t *kp_, *vp_;                                                                     \
    int kpi_, vpi_;                                                                              \
    if (s_ < 2 * nct) { const int ct_ = s_ < nct ? s_ : s_ - nct; kp_ = KCMP + ct_ * 4096; kpi_ = 64; vp_ = VCMPT + ct_ * 64; vpi_ = 256; } \
    else if (s_ < 2 * nct + nsel) { const int j_ = s_ - 2 * nct; kp_ = KS + (size_t)j_ * 8192; kpi_ = 128; vp_ = VST + j_ * 64; vpi_ = 4096; } \
    else { const int j_ = j0 + s_ - 2 * nct - nsel; kp_ = KW + (size_t)j_ * 8192; kpi_ = 128; vp_ = VWT + j_ * 64; vpi_ = 4096; } \
    kreg = *(const u32x4*)(kp_ + srow * kpi_ + scc * 8);                                         \
    vreg = *(const u32x4*)(vp_ + (size_t)srow * vpi_ + scc * 8);                                 \
  } while (0)
#define ATT_COMMIT(buf)                                                                          \
  do {                                                                                           \
    *(u32x4*)(smem + (buf) * 9216 + srow * 144 + scc * 16) = kreg;                               \
    *(u32x4*)(smem + 18432 + (buf) * 9216 + srow * 144 + scc * 16) = vreg;                       \
  } while (0)
#define ATT_PRE(s)  do { if ((s) + 1 < total) ATT_ISSUE((s) + 1); } while (0)
#define ATT_POST(s) do { if ((s) + 1 < total) ATT_COMMIT(((s) + 1) & 1); __syncthreads(); } while (0)

  ATT_ISSUE(0);
  ATT_COMMIT(0);
  for (int i = tid; i < 4096; i += NTHR) imp[i] = 0.f;
  __syncthreads();

  f32x16 S[2], O[2], Oout[2];
  float m, l;
  int s = 0;
  const int hic = (tq - 31) >> 4;
  m = -1e30f; l = 0.f;
  for (int ct = 0; ct < nct; ++ct, ++s) {
    ATT_PRE(s);
    qk1(smem + (s & 1) * 9216, qf, S, r, h);
    float mx = -1e30f;
    const int hi2 = hic - ct * 64 - 4 * h;
#pragma unroll
    for (int kt2 = 0; kt2 < 2; ++kt2)
#pragma unroll
      for (int i = 0; i < 16; ++i) {
        const int ci = kt2 * 32 + (i & 3) + 8 * (i >> 2);
        mx = (ci <= hi2) ? fmaxf(mx, S[kt2][i]) : mx;
      }
    mx = xhalf_max(mx);
    const float mnew = fmaxf(m, mx);
    const float alpha = __builtin_amdgcn_exp2f((m - mnew) * L2E);
    const float mL = mnew * L2E;
    float sum = 0.f;
#pragma unroll
    for (int kt2 = 0; kt2 < 2; ++kt2)
#pragma unroll
      for (int i = 0; i < 16; ++i) {
        const int ci = kt2 * 32 + (i & 3) + 8 * (i >> 2);
        sum += (ci <= hi2) ? __builtin_amdgcn_exp2f(__builtin_fmaf(S[kt2][i], L2E, -mL)) : 0.f;
      }
    l = l * alpha + sum;
    m = mnew;
    ATT_POST(s);
  }
  {
    const float lt = xhalf_sum(l);
    const float inv = (hic >= 0 && lt > 0.f) ? 1.f / lt : 0.f;
    const float mL = m * L2E;
#pragma unroll
    for (int a = 0; a < 2; ++a)
#pragma unroll
      for (int i = 0; i < 16; ++i) O[a][i] = 0.f;
    for (int ct = 0; ct < nct; ++ct, ++s) {
      ATT_PRE(s);
      qk1(smem + (s & 1) * 9216, qf, S, r, h);
      const int hi2 = hic - ct * 64 - 4 * h;
#pragma unroll
      for (int kt2 = 0; kt2 < 2; ++kt2)
#pragma unroll
        for (int i = 0; i < 16; ++i) {
          const int ci = kt2 * 32 + (i & 3) + 8 * (i >> 2);
          S[kt2][i] = (ci <= hi2) ? __builtin_amdgcn_exp2f(__builtin_fmaf(S[kt2][i], L2E, -mL)) * inv : 0.f;
        }
      if (c >= 16) {
        float* irow = imp + ql * 64;
#pragma unroll
        for (int kt2 = 0; kt2 < 2; ++kt2)
#pragma unroll
          for (int gi = 0; gi < 4; ++gi) {
            const int jb = ct * 16 + kt2 * 8 + 2 * gi + h;
            const float a4 = (S[kt2][4 * gi] + S[kt2][4 * gi + 1]) + (S[kt2][4 * gi + 2] + S[kt2][4 * gi + 3]);
            __hip_atomic_fetch_add(irow + jb, a4, __ATOMIC_RELAXED, __HIP_MEMORY_SCOPE_WORKGROUP);
            if (jb + 1 < 64)
              __hip_atomic_fetch_add(irow + jb + 1, S[kt2][4 * gi + 3], __ATOMIC_RELAXED, __HIP_MEMORY_SCOPE_WORKGROUP);
          }
      }
      pv1(smem + 18432 + (s & 1) * 9216, S, O, r, h);
      ATT_POST(s);
    }
#pragma unroll
    for (int dt = 0; dt < 2; ++dt)
#pragma unroll
      for (int i = 0; i < 16; ++i) Oout[dt][i] = gate0 * O[dt][i];
  }
  {
    const int tr_ = opaque_tid();
    const int q = tr_ >> 3, part = tr_ & 7;
    unsigned bits = 0;
    if (c >= 16) {
      unsigned key[8];
#pragma unroll
      for (int k = 0; k < 8; ++k) {
        const int j = part * 8 + k;
        const unsigned u = __float_as_uint(imp[q * 64 + j]);
        key[k] = (j >= 1 && j <= c - 2) ? ((u & ~63u) | (unsigned)(63 - j)) : 0u;
      }
      for (int rd = 0; rd < 13; ++rd) {
        unsigned lm = key[0];
#pragma unroll
        for (int k = 1; k < 8; ++k) lm = lm > key[k] ? lm : key[k];
#pragma unroll
        for (int o = 1; o <= 4; o <<= 1) {
          const unsigned ot = shxu(lm, o, tr_ & 63);
          lm = lm > ot ? lm : ot;
        }
#pragma unroll
        for (int k = 0; k < 8; ++k) {
          const bool hit = (key[k] == lm) && (lm != 0u);
          bits |= hit ? (1u << k) : 0u;
          key[k] = hit ? 0u : key[k];
        }
      }
#pragma unroll
      for (int k = 0; k < 8; ++k) {
        const int j = part * 8 + k;
        if (j == 0 || j == c || j == c - 1) bits |= (1u << k);
      }
    } else {
#pragma unroll
      for (int k = 0; k < 8; ++k) {
        const int j = part * 8 + k;
        if (j <= c) bits |= (1u << k);
      }
    }
    selm[q * 8 + part] = (unsigned char)bits;
  }
  __syncthreads();
  const u64 sm = *(const u64*)(selm + ql * 8);

  m = -1e30f; l = 0.f;
#pragma unroll
  for (int a = 0; a < 2; ++a)
#pragma unroll
    for (int i = 0; i < 16; ++i) O[a][i] = 0.f;
  for (int j = 0; j <= c; ++j, ++s) {
    {
      const bool more_ = j < c;
      const bf16_t* kp_ = more_ ? KS + (size_t)(j + 1) * 8192 : KW + (size_t)j0 * 8192;
      const bf16_t* vp_ = more_ ? VST + (j + 1) * 64 : VWT + j0 * 64;
      kreg = *(const u32x4*)(kp_ + srow * 128 + scc * 8);
      vreg = *(const u32x4*)(vp_ + (size_t)srow * 4096 + scc * 8);
    }
    qk1(smem + (s & 1) * 9216, qf, S, r, h);
    const bool selq = ((sm >> j) & 1ull) != 0ull;
    softmax1(S, j * 64, 0, selq ? tq : -1, j < c, selq, m, l, O, h, lane);
    pv1(smem + 18432 + (s & 1) * 9216, S, O, r, h);
    ATT_POST(s);
  }
  {
    const float lt = xhalf_sum(l);
    const float sc = gate1 / lt;
#pragma unroll
    for (int dt = 0; dt < 2; ++dt)
#pragma unroll
      for (int i = 0; i < 16; ++i) Oout[dt][i] += sc * O[dt][i];
  }
  m = -1e30f; l = 0.f;
#pragma unroll
  for (int a = 0; a < 2; ++a)
#pragma unroll
    for (int i = 0; i < 16; ++i) O[a][i] = 0.f;
  for (int j = j0; j <= c; ++j, ++s) {
    if (j < c) {
      kreg = *(const u32x4*)(KW + (size_t)(j + 1) * 8192 + srow * 128 + scc * 8);
      vreg = *(const u32x4*)(VWT + (j + 1) * 64 + (size_t)srow * 4096 + scc * 8);
    }
    qk1(smem + (s & 1) * 9216, qf, S, r, h);
    softmax1(S, j * 64, tq - 511, tq, (j >= c - 7) && (j < c), true, m, l, O, h, lane);
    pv1(smem + 18432 + (s & 1) * 9216, S, O, r, h);
    ATT_POST(s);
  }
  {
    const float lt = xhalf_sum(l);
    const float sc = gate2 / lt;
#pragma unroll
    for (int dt = 0; dt < 2; ++dt)
#pragma unroll
      for (int i = 0; i < 16; ++i) Oout[dt][i] += sc * O[dt][i];
  }
  {
    const bf16_t* ZN = (const bf16_t*)(p.ws + OFF_ZN) + tok * 512 + hd * 64;
    bf16_t* MIX = (bf16_t*)(p.ws + OFF_MIX) + tok * 1024 + hd * 64;
#pragma unroll
    for (int dt = 0; dt < 2; ++dt)
#pragma unroll
      for (int gi = 0; gi < 4; ++gi) {
        const int d = dt * 32 + 8 * gi + 4 * h;
        const u32x2 z = *(const u32x2*)(ZN + d);
        u32x2 o;
        o[0] = pack2(Oout[dt][4 * gi + 0] * silu_f(bflo(z[0])), Oout[dt][4 * gi + 1] * silu_f(bfhi(z[0])));
        o[1] = pack2(Oout[dt][4 * gi + 2] * silu_f(bflo(z[1])), Oout[dt][4 * gi + 3] * silu_f(bfhi(z[1])));
        *(u32x2*)(MIX + d) = o;
      }
  }
  __syncthreads();
#undef ATT_ISSUE
#undef ATT_COMMIT
#undef ATT_PRE
#undef ATT_POST
}

DI void phase3(const Params& p, char* smem) {
  unsigned* qctr = (unsigned*)(p.ws + OFF_QCTR);
  volatile int* qw = (volatile int*)(smem + 134160);
  const bool t0 = threadIdx.x == 0;
  int nxt = 0;
  if (t0) nxt = (int)__hip_atomic_fetch_add(qctr, 1u, __ATOMIC_RELAXED, __HIP_MEMORY_SCOPE_AGENT);
  for (;;) {
    if (t0) *qw = nxt;
    __syncthreads();
    const int idx = *qw;
    __syncthreads();
    if (idx >= 4096) break;
    if (t0) nxt = (int)__hip_atomic_fetch_add(qctr, 1u, __ATOMIC_RELAXED, __HIP_MEMORY_SCOPE_AGENT);
    if (idx < 2048) {
      const int c = 63 - (idx >> 5), bgi = idx & 31;
      attn_item(p, smem, c, bgi >> 1, bgi & 1);
    } else {
      const int half = (int)(threadIdx.x >> 8);
      gmlp_item(p, smem + half * 52224, (idx - 2048) * 2 + half, true);
    }
  }
}

struct OneUnit {
  pg8::Unit u0;
  __device__ bool next(int i, pg8::Unit& u) const { if (i != 0) return false; u = u0; return true; }
  __device__ __forceinline__ void a_ready(const pg8::Unit&) const {}
  __device__ __forceinline__ void done(const pg8::Unit&) const {}
};
struct EpiP4F {
  static constexpr bool PERM = true, AFTER_DRAIN = true;
  const float* x;
  float* out;
  float* rowss;
  unsigned* pcnt;
  const float* gvec;
  __device__ __forceinline__ void operator()(const pg8::f32x4 (&)[2][2][4][2], const pg8::Unit&, int, int, int, int) const {}
  __device__ __forceinline__ void fused(const pg8::f32x4 (&acc_c)[2][2][4][2], const pg8::Unit& u, int wr, int wc, int fr, int fq,
                                        PG8_LAS unsigned char* lds, int wid, int lane) const {
    auto& acc = const_cast<pg8::f32x4 (&)[2][2][4][2]>(acc_c);
    PG8_LAS float* rl = (PG8_LAS float*)lds;
    const int tid = wid * 64 + lane;
    if (tid < 256) rl[tid] = 0.f;
    __syncthreads();
#pragma unroll
    for (int ai = 0; ai < 2; ++ai)
#pragma unroll
      for (int m = 0; m < 4; ++m) {
        const int row_l = ai * 128 + wr * 64 + m * 16 + fr;
        const size_t rowoff = ((size_t)u.pm * 256 + row_l) * 1024;
        float ss = 0.f;
#pragma unroll
        for (int bj = 0; bj < 2; ++bj) {
          const int col = u.pn * 256 + bj * 128 + wc * 32 + fq * 8;
          const float4 x0 = *(const float4*)(x + rowoff + col);
          const float4 x1 = *(const float4*)(x + rowoff + col + 4);
          acc[ai][bj][m][0][0] += x0.x; acc[ai][bj][m][0][1] += x0.y; acc[ai][bj][m][0][2] += x0.z; acc[ai][bj][m][0][3] += x0.w;
          acc[ai][bj][m][1][0] += x1.x; acc[ai][bj][m][1][1] += x1.y; acc[ai][bj][m][1][2] += x1.z; acc[ai][bj][m][1][3] += x1.w;
#pragma unroll
          for (int n = 0; n < 2; ++n)
#pragma unroll
            for (int j = 0; j < 4; ++j) ss += acc[ai][bj][m][n][j] * acc[ai][bj][m][n][j];
        }
        ss += shx(ss, 16, lane);
        ss += shx(ss, 32, lane);
        if (fq == 0) __hip_atomic_fetch_add(rl + row_l, ss, __ATOMIC_RELAXED, __HIP_MEMORY_SCOPE_WORKGROUP);
      }
    __syncthreads();
    if (tid < 256) __hip_atomic_fetch_add(rowss + (size_t)u.pm * 256 + tid, rl[tid], __ATOMIC_RELAXED, __HIP_MEMORY_SCOPE_AGENT);
    asm volatile("s_waitcnt vmcnt(0)" ::: "memory");
    __syncthreads();
    if (tid == 0) {
      __builtin_amdgcn_fence(__ATOMIC_RELEASE, "agent");
      asm volatile("s_waitcnt vmcnt(0)" ::: "memory");
      __hip_atomic_fetch_add(pcnt + u.pm, 1u, __ATOMIC_RELAXED, __HIP_MEMORY_SCOPE_AGENT);
      unsigned spins = 0;
      while (__hip_atomic_load(pcnt + u.pm, __ATOMIC_RELAXED, __HIP_MEMORY_SCOPE_AGENT) < 4u && ++spins < (1u << 22)) __builtin_amdgcn_s_sleep(2);
      __builtin_amdgcn_fence(__ATOMIC_ACQUIRE, "agent");
      asm volatile("s_waitcnt vmcnt(0)" ::: "memory");
    }
    __syncthreads();
    if (tid < 256) {
      const float rs = __hip_atomic_load(rowss + (size_t)u.pm * 256 + tid, __ATOMIC_RELAXED, __HIP_MEMORY_SCOPE_AGENT);
      rl[256 + tid] = rsqrtf(rs * (1.f / 1024.f) + 1e-6f);
    }
    __syncthreads();
    float4 g0[2], g1[2];
#pragma unroll
    for (int bj = 0; bj < 2; ++bj) {
      const int col = u.pn * 256 + bj * 128 + wc * 32 + fq * 8;
      g0[bj] = *(const float4*)(gvec + col);
      g1[bj] = *(const float4*)(gvec + col + 4);
    }
#pragma unroll
    for (int ai = 0; ai < 2; ++ai)
#pragma unroll
      for (int m = 0; m < 4; ++m) {
        const int row_l = ai * 128 + wr * 64 + m * 16 + fr;
        const size_t rowoff = ((size_t)u.pm * 256 + row_l) * 1024;
        const float rstd = rl[256 + row_l];
#pragma unroll
        for (int bj = 0; bj < 2; ++bj) {
          const int col = u.pn * 256 + bj * 128 + wc * 32 + fq * 8;
          float4 o0, o1;
          o0.x = acc[ai][bj][m][0][0] * rstd * g0[bj].x; o0.y = acc[ai][bj][m][0][1] * rstd * g0[bj].y;
          o0.z = acc[ai][bj][m][0][2] * rstd * g0[bj].z; o0.w = acc[ai][bj][m][0][3] * rstd * g0[bj].w;
          o1.x = acc[ai][bj][m][1][0] * rstd * g1[bj].x; o1.y = acc[ai][bj][m][1][1] * rstd * g1[bj].y;
          o1.z = acc[ai][bj][m][1][2] * rstd * g1[bj].z; o1.w = acc[ai][bj][m][1][3] * rstd * g1[bj].w;
          *(float4*)(out + rowoff + col) = o0;
          *(float4*)(out + rowoff + col + 4) = o1;
        }
      }
    __syncthreads();
  }
};

DI void phase4_fused(const Params& p, unsigned char* smem, const int wid_s) {
  pg8::Gemm g;
  g.A = (const bf16_t*)(p.ws + OFF_MIX); g.Bt = (const bf16_t*)(p.ws + OFF_WTOUT); g.M = NTOK; g.N = 1024; g.K = 1024;
  pg8::StaticOrder S; S.init(NTOK, 1024, (int)gridDim.x, (int)blockIdx.x);
  EpiP4F E; E.x = p.x; E.out = p.out; E.rowss = (float*)(p.ws + OFF_ROWSS); E.pcnt = (unsigned*)(p.ws + OFF_PCNT);
  E.gvec = (const float*)(p.ws + OFF_SMALL) + SM_NFG;
  for (int i = 0; i < 4; ++i) {
    OneUnit O1;
    if (!S.next(i, O1.u0)) break;
    pg8::gemm_phase<EpiP4F, OneUnit, false>((PG8_LAS unsigned char*)smem, g, O1, E, nullptr, opaque_tid_w(wid_s));
    __syncthreads();
  }
}

DI void phase4(const Params& p, unsigned char* smem, const int wid_s) {
  pg8::Gemm g;
  g.A = (const bf16_t*)(p.ws + OFF_MIX); g.Bt = (const bf16_t*)(p.ws + OFF_WTOUT); g.M = NTOK; g.N = 1024; g.K = 1024;
  pg8::StaticOrder S; S.init(NTOK, 1024, (int)gridDim.x, (int)blockIdx.x);
  EpiP4 E; E.x = p.x; E.hb = (bf16_t*)(p.ws + OFF_HN); E.rowss = (float*)(p.ws + OFF_ROWSS);
  pg8::gemm_phase<EpiP4, pg8::StaticOrder, false>((PG8_LAS unsigned char*)smem, g, S, E, nullptr, opaque_tid_w(wid_s));
  __syncthreads();
}

DI void phase5(const Params& p, const int wid_s) {
  const int t2 = opaque_tid_w(wid_s), lane = t2 & 63, wave = t2 >> 6;
  const bf16_t* HB = (const bf16_t*)(p.ws + OFF_HN);
  const float* RS = (const float*)(p.ws + OFF_ROWSS);
  float4 gf[2][2];
#pragma unroll
  for (int ch = 0; ch < 2; ++ch)
#pragma unroll
    for (int q = 0; q < 2; ++q) gf[ch][q] = *(const float4*)(p.ws + OFF_SMALL + (size_t)(SM_NFG + ch * 512 + lane * 8 + q * 4) * 4);
  const int gw = blockIdx.x * 8 + wave, ngw = gridDim.x * 8;
  for (int r0 = gw * 4; r0 < NTOK; r0 += ngw * 4) {
    u32x4 hv[4][2];
    float rs[4];
#pragma unroll
    for (int k = 0; k < 4; ++k) {
      const bf16_t* hrow = HB + (size_t)(r0 + k) * 1024;
#pragma unroll
      for (int ch = 0; ch < 2; ++ch) hv[k][ch] = *(const u32x4*)(hrow + ch * 512 + lane * 8);
      rs[k] = RS[r0 + k];
    }
#pragma unroll
    for (int k = 0; k < 4; ++k) {
      const float rstd = rsqrtf(rs[k] * (1.f / 1024.f) + 1e-6f);
      float* orow = p.out + (size_t)(r0 + k) * 1024;
#pragma unroll
      for (int ch = 0; ch < 2; ++ch) {
        float4 o0, o1;
        o0.x = bflo(hv[k][ch][0]) * rstd * gf[ch][0].x; o0.y = bfhi(hv[k][ch][0]) * rstd * gf[ch][0].y;
        o0.z = bflo(hv[k][ch][1]) * rstd * gf[ch][0].z; o0.w = bfhi(hv[k][ch][1]) * rstd * gf[ch][0].w;
        o1.x = bflo(hv[k][ch][2]) * rstd * gf[ch][1].x; o1.y = bfhi(hv[k][ch][2]) * rstd * gf[ch][1].y;
        o1.z = bflo(hv[k][ch][3]) * rstd * gf[ch][1].z; o1.w = bfhi(hv[k][ch][3]) * rstd * gf[ch][1].w;
        *(float4*)(orow + ch * 512 + lane * 8) = o0;
        *(float4*)(orow + ch * 512 + lane * 8 + 4) = o1;
      }
    }
  }
}

#ifndef REP0
#define REP0 1
#endif
#ifndef REP1
#define REP1 1
#endif
#ifndef REP2
#define REP2 1
#endif
#ifndef REP3
#define REP3 1
#endif
#ifndef REP4
#define REP4 1
#endif
__global__ void __launch_bounds__(NTHR, 2) nsa_gmlp_megakernel(Params p) {
  __shared__ __attribute__((aligned(16))) unsigned char smem[SMEM_BYTES];
  cg::grid_group grid = cg::this_grid();
  volatile XB_LAS unsigned* xst = (volatile XB_LAS unsigned*)((XB_LAS unsigned char*)smem + 134144);
  if (threadIdx.x == 0) { xst[0] = 0u; xst[1] = 0u; }
  __syncthreads();
  const XcdBarrier xb = xcd_barrier_post((unsigned*)(p.ws + OFF_XBAR), xst);
  if (p.ws == nullptr) grid.sync();
  const int wid_s = __builtin_amdgcn_readfirstlane((int)(threadIdx.x >> 6));
  for (int rep = 0; rep < REP0; ++rep) phase0(p);
  xcd_barrier(xb);
  unsigned* const barp = (unsigned*)(p.ws + OFF_BAR);
  const unsigned nblk = gridDim.x;
  const bool leader = threadIdx.x == 0;
  for (int rep = 0; rep < REP1; ++rep) {
    pg8::Gemm g;
    g.A = (const bf16_t*)(p.ws + OFF_HN); g.Bt = (const bf16_t*)(p.ws + OFF_WTIN); g.M = NTOK; g.N = NPAD; g.K = 1024;
    pg8::StaticOrder S; S.init(NTOK, NPAD, (int)gridDim.x, (int)blockIdx.x);
    EpiP1 E; E.ws = p.ws;
    pg8::gemm_phase<EpiP1, pg8::StaticOrder, false>((PG8_LAS unsigned char*)smem, g, S, E, nullptr, opaque_tid());
    __syncthreads();
  }
  xcd_barrier(xb);
  for (int rep = 0; rep < REP2; ++rep) {
    const int vb = blockIdx.x * 2 + (threadIdx.x >> 8), nvb = gridDim.x * 2;
    char* sh = (char*)smem + (threadIdx.x >> 8) * 52224;
    for (int it0 = 0; it0 < 512; it0 += nvb) compress_item(p, sh, it0 + vb, it0 + vb < 512);
  }
  xcd_barrier(xb);
  for (int rep = 0; rep < REP3; ++rep) phase3(p, (char*)smem);
  xcd_barrier(xb);
  if (gridDim.x == 256) {
    phase4_fused(p, smem, wid_s);
  } else {
    for (int rep = 0; rep < REP4; ++rep) phase4(p, smem, wid_s);
    xcd_barrier(xb);
    phase5(p, wid_s);
  }
}

extern "C" void kernel_launch(void* const* d_in, const int* in_sizes, int n_in, void* d_out, int out_size, void* d_ws,
                              size_t ws_size, hipStream_t stream) {
  static int grid_blocks = 0;
  if (!grid_blocks) {
    int dev = 0, cus = 0, per_cu = 0;
    (void)hipGetDevice(&dev);
    (void)hipDeviceGetAttribute(&cus, hipDeviceAttributeMultiprocessorCount, dev);
    (void)hipOccupancyMaxActiveBlocksPerMultiprocessor(&per_cu, nsa_gmlp_megakernel, NTHR, 0);
    if (per_cu < 1) per_cu = 1;
    grid_blocks = cus;
  }
  Params p{};
  p.x = (const float*)d_in[0];
  p.norm_in_g = (const float*)d_in[1];
  p.w_in = (const float*)d_in[2];
  p.w_k1 = (const float*)d_in[3];
  p.w_k2 = (const float*)d_in[4];
  p.pe_k = (const float*)d_in[5];
  p.w_v1 = (const float*)d_in[6];
  p.w_v2 = (const float*)d_in[7];
  p.pe_v = (const float*)d_in[8];
  p.ln_g = (const float*)d_in[9];
  p.ln_b = (const float*)d_in[10];
  p.w_sp = (const float*)d_in[11];
  p.b_sp = (const float*)d_in[12];
  p.w_out = (const float*)d_in[13];
  p.norm_f_g = (const float*)d_in[14];
  p.out = (float*)d_out;
  p.ws = (char*)d_ws;
  void* args[] = {&p};
  (void)hipMemsetAsync((char*)d_ws + OFF_XBAR, 0, 3456 * 4, stream);
  hipError_t e = hipLaunchCooperativeKernel((void*)nsa_gmlp_megakernel, dim3(grid_blocks), dim3(NTHR), args, 0, stream);
  if (e != hipSuccess) fprintf(stderr, "cooperative launch failed: %s (grid %d)\n", hipGetErrorString(e), grid_blocks);
}
```
